# Optimizing an MI355X kernel written in HIP

```python
import jax
import jax.numpy as jnp
from jax import lax
import numpy as np

D_MODEL = 1024
BATCH = 4
SEQ = 8192
DEPTH = 4

GRID_W = 64
CTX_LEN = 256
N_MIXERS = 3
EPS = 1e-6

GLA_HEADS = 4
GLA_DK = D_MODEL // 2
GLA_DV = D_MODEL
GLA_HK = GLA_DK // GLA_HEADS
GLA_HV = GLA_DV // GLA_HEADS
GLA_GATE_RANK = 16
GLA_TAU = 16.0
GLA_CHUNK = 64

ATT_HEAD_DIM = 64
ATT_Q_HEADS = D_MODEL // ATT_HEAD_DIM
ATT_KV_HEADS = 4
ATT_GROUP = ATT_Q_HEADS // ATT_KV_HEADS
ATT_Q_WIDTH = ATT_Q_HEADS * ATT_HEAD_DIM
ATT_KV_WIDTH = ATT_KV_HEADS * ATT_HEAD_DIM
ATT_SCALE = ATT_HEAD_DIM ** -0.5
WINDOW = 128
ATT_BLOCK = 128
ROPE_PAIRS = ATT_HEAD_DIM // 4
ROPE_BASE = 10000.0

RNN_WIDTH = 1280
RNN_HEADS = 10
RNN_HD = RNN_WIDTH // RNN_HEADS
CONV_W = 4
CONV_LEFT = 2
LRU_C = 8.0

kernel_name = 'hybrid_gla_swa_rglru_prefix_dit'


def rmsnorm(x, g):
    xf = x.astype(jnp.float32)
    y = xf * lax.rsqrt(jnp.mean(xf * xf, axis=-1, keepdims=True) + EPS)
    return (y * g.astype(jnp.float32)).astype(x.dtype)


def split_heads(a, n):
    b, t, w = a.shape
    return a.reshape(b, t, n, w // n).transpose(0, 2, 1, 3)


def merge_heads(a):
    b, n, t, d = a.shape
    return a.transpose(0, 2, 1, 3).reshape(b, t, n * d)


def flip_t(a):
    return jnp.flip(a, axis=2)


def gla_chunked(q, k, v, log_a, s0):
    b, h, t, _ = q.shape
    n = t // GLA_CHUNK

    def to_chunks(a):
        return jnp.moveaxis(a.reshape(b, h, n, GLA_CHUNK, a.shape[-1]), 2, 0)

    cum = jnp.cumsum(to_chunks(log_a), axis=-2)
    lower = jnp.tril(jnp.ones((GLA_CHUNK, GLA_CHUNK), dtype=bool))[:, :, None]

    def step(s, inp):
        q_n, k_n, v_n, b_n = inp
        rel = b_n[:, :, :, None, :] - b_n[:, :, None, :, :]
        decay = jnp.exp(jnp.where(lower, rel, -jnp.inf))
        scores = jnp.einsum('bhtd,bhsd,bhtsd->bhts', q_n, k_n, decay)
        o = scores @ v_n + (q_n * jnp.exp(b_n)) @ s
        b_last = b_n[:, :, -1:, :]
        s = jnp.exp(b_last)[:, :, 0, :, None] * s + jnp.swapaxes(k_n * jnp.exp(b_last - b_n), -1, -2) @ v_n
        return s, o

    s_fin, o = lax.scan(step, s0, (to_chunks(q), to_chunks(k), to_chunks(v), cum))
    return jnp.moveaxis(o, 0, 2).reshape(b, h, t, v.shape[-1]), s_fin


def gla_final_state(k, v, log_a):
    cum = jnp.cumsum(log_a, axis=2)
    return jnp.swapaxes(k * jnp.exp(cum[:, :, -1:, :] - cum), -1, -2) @ v


def gla_bidir(q, k, v, la_f, la_b, s0_f, s0_b):
    o_f, s_f = gla_chunked(q, k, v, la_f, s0_f)
    o_b, s_b = gla_chunked(flip_t(q), flip_t(k), flip_t(v), flip_t(la_b), s0_b)
    return o_f + flip_t(o_b), s_f, s_b


def mixer_gla(h_lat, h_ctx, w_in, w_g1, w_g2, b_g, g_head, w_out, ctx_out):
    def project(h):
        q, k, v, z = jnp.split(h @ w_in, [GLA_DK, 2 * GLA_DK, 2 * GLA_DK + GLA_DV], axis=-1)
        la_f, la_b = [split_heads(jax.nn.log_sigmoid(((h @ w_g1[d]) @ w_g2[d] + b_g[d]).astype(jnp.float32)) / GLA_TAU, GLA_HEADS)
                      for d in range(2)]
        q = split_heads(q, GLA_HEADS).astype(jnp.float32) * GLA_HK ** -0.5
        k = split_heads(k, GLA_HEADS).astype(jnp.float32)
        v = split_heads(v, GLA_HEADS).astype(jnp.float32)
        return q, k, v, z, la_f, la_b

    def finish(o, z):
        o = merge_heads(rmsnorm(o, g_head[:, None, :]))
        return (o.astype(z.dtype) * jax.nn.silu(z)) @ w_out

    q_c, k_c, v_c, z_c, la_cf, la_cb = project(h_ctx)
    q_l, k_l, v_l, z_l, la_lf, la_lb = project(h_lat)
    if ctx_out:
        zero = jnp.zeros((h_ctx.shape[0], GLA_HEADS, GLA_HK, GLA_HV), jnp.float32)
        o_c, s_f, s_b = gla_bidir(q_c, k_c, v_c, la_cf, la_cb, zero, zero)
        y_ctx = finish(o_c, z_c)
    else:
        s_f = gla_final_state(k_c, v_c, la_cf)
        s_b = gla_final_state(flip_t(k_c), flip_t(v_c), flip_t(la_cb))
        y_ctx = None
    o_l, _, _ = gla_bidir(q_l, k_l, v_l, la_lf, la_lb, s_f, s_b)
    return finish(o_l, z_l), y_ctx


def rope_1d(x, cos, sin):
    x1, x2 = jnp.split(x, 2, axis=-1)
    return jnp.concatenate([x1 * cos - x2 * sin, x2 * cos + x1 * sin], axis=-1)


def rope_axial(x, rope):
    cos_r, sin_r, cos_c, sin_c = rope
    half = ATT_HEAD_DIM // 2
    return jnp.concatenate([rope_1d(x[..., :half], cos_r, sin_r), rope_1d(x[..., half:], cos_c, sin_c)], axis=-1)


def attn_project(h, w_in):
    b, t, _ = h.shape
    q, k, v, z = jnp.split(h @ w_in, [ATT_Q_WIDTH, ATT_Q_WIDTH + ATT_KV_WIDTH, ATT_Q_WIDTH + 2 * ATT_KV_WIDTH], axis=-1)
    q = q.reshape(b, t, ATT_KV_HEADS, ATT_GROUP, ATT_HEAD_DIM).transpose(0, 2, 3, 1, 4)
    k = k.reshape(b, t, ATT_KV_HEADS, ATT_HEAD_DIM).transpose(0, 2, 1, 3)
    v = v.reshape(b, t, ATT_KV_HEADS, ATT_HEAD_DIM).transpose(0, 2, 1, 3)
    return q, k, v, z


def sink_column(sink, lead_shape):
    return jnp.broadcast_to(sink.astype(jnp.float32)[None, :, :, None, None], lead_shape + (1,))


def context_attention(q, k, v, sink):
    s = jnp.einsum('bkgqd,bksd->bkgqs', q, k).astype(jnp.float32) * ATT_SCALE
    p = jax.nn.softmax(jnp.concatenate([s, sink_column(sink, s.shape[:-1])], axis=-1), axis=-1)[..., :-1]
    return jnp.einsum('bkgqs,bksd->bkgqd', p.astype(v.dtype), v)


def banded_attention(q, k, v, k_ctx, v_ctx, sink):
    b, hk, g, t, dh = q.shape
    n = t // ATT_BLOCK
    span = 3 * ATT_BLOCK
    pad = ((0, 0), (0, 0), (ATT_BLOCK, ATT_BLOCK), (0, 0))
    kp, vp = jnp.pad(k, pad), jnp.pad(v, pad)
    q_blocks = jnp.moveaxis(q.reshape(b, hk, g, n, ATT_BLOCK, dh), 3, 0)
    offs = jnp.arange(span) - ATT_BLOCK
    in_window = jnp.abs(offs[None, :] - jnp.arange(ATT_BLOCK)[:, None]) <= WINDOW

    def block(args):
        q_n, idx = args
        start = idx * ATT_BLOCK
        k_n = lax.dynamic_slice_in_dim(kp, start, span, axis=2)
        v_n = lax.dynamic_slice_in_dim(vp, start, span, axis=2)
        kpos = start + offs
        valid = in_window & ((kpos >= 0) & (kpos < t))[None, :]
        s_loc = jnp.einsum('bkgqd,bksd->bkgqs', q_n, k_n).astype(jnp.float32) * ATT_SCALE
        s_loc = jnp.where(valid, s_loc, -jnp.inf)
        s_ctx = jnp.einsum('bkgqd,bksd->bkgqs', q_n, k_ctx).astype(jnp.float32) * ATT_SCALE
        logits = jnp.concatenate([s_loc, s_ctx, sink_column(sink, s_loc.shape[:-1])], axis=-1)
        p = jax.nn.softmax(logits, axis=-1).astype(v.dtype)
        return (jnp.einsum('bkgqs,bksd->bkgqd', p[..., :span], v_n)
                + jnp.einsum('bkgqs,bksd->bkgqd', p[..., span:-1], v_ctx))

    o = lax.map(block, (q_blocks, jnp.arange(n)))
    return jnp.moveaxis(o, 0, 3).reshape(b, hk, g, t, dh)


def mixer_swa(h_lat, h_ctx, w_in, sink, w_out, rope, ctx_out):
    sink = sink.reshape(ATT_KV_HEADS, ATT_GROUP)
    q_c, k_c, v_c, z_c = attn_project(h_ctx, w_in)
    q_l, k_l, v_l, z_l = attn_project(h_lat, w_in)
    q_l, k_l = rope_axial(q_l, rope), rope_axial(k_l, rope)

    def finish(o, z):
        b, hk, g, t, d = o.shape
        o = o.transpose(0, 3, 1, 2, 4).reshape(b, t, hk * g * d)
        return (o * jax.nn.silu(z)) @ w_out

    y_lat = finish(banded_attention(q_l, k_l, v_l, k_c, v_c, sink), z_l)
    y_ctx = finish(context_attention(q_c, k_c, v_c, sink), z_c) if ctx_out else None
    return y_lat, y_ctx


def depthwise_conv(u, w, bias):
    t = u.shape[1]
    up = jnp.pad(u, ((0, 0), (CONV_LEFT, CONV_W - 1 - CONV_LEFT), (0, 0)))
    out = up[:, 0:t] * w[0]
    for j in range(1, CONV_W):
        out = out + up[:, j:j + t] * w[j]
    return out + bias


def block_diag(x, w, bias):
    xh = x.reshape(x.shape[:-1] + (RNN_HEADS, RNN_HD))
    return jnp.einsum('bthi,hij->bthj', xh, w).reshape(x.shape) + bias


def rglru_gates(u, w_a, b_a, w_x, b_x, lam):
    r = jax.nn.sigmoid(block_diag(u, w_a, b_a).astype(jnp.float32))
    i = jax.nn.sigmoid(block_diag(u, w_x, b_x).astype(jnp.float32))
    log_a = -LRU_C * r * jax.nn.softplus(-lam.astype(jnp.float32))
    x = jnp.sqrt(-jnp.expm1(2.0 * log_a)) * i * u.astype(jnp.float32)
    return jnp.exp(log_a), x


def scan_combine(left, right):
    a_l, h_l = left
    a_r, h_r = right
    return a_l * a_r, a_r * h_l + h_r


def linear_scan(a, x, h0, reverse):
    edge = -1 if reverse else 0
    x = x.at[:, edge].add(a[:, edge] * h0)
    return lax.associative_scan(scan_combine, (a, x), reverse=reverse, axis=1)[1]


def mixer_rglru(h_lat, h_ctx, w_in, conv_w, conv_b, w_ra, b_ra, w_ri, b_ri, lam, w_out, ctx_out):
    def branch(h):
        u, z = jnp.split(h @ w_in, 2, axis=-1)
        return depthwise_conv(u, conv_w, conv_b), z

    u_c, z_c = branch(h_ctx)
    u_l, z_l = branch(h_lat)
    h0 = jnp.zeros((h_ctx.shape[0], RNN_WIDTH), jnp.float32)
    hs_c, hs_l = [], []
    for d, reverse in ((0, False), (1, True)):
        a_c, x_c = rglru_gates(u_c, w_ra[d], b_ra[d], w_ri[d], b_ri[d], lam[d])
        h_c = linear_scan(a_c, x_c, h0, reverse)
        a_l, x_l = rglru_gates(u_l, w_ra[d], b_ra[d], w_ri[d], b_ri[d], lam[d])
        hs_l.append(linear_scan(a_l, x_l, h_c[:, 0 if reverse else -1], reverse))
        hs_c.append(h_c)

    def finish(hs, z):
        return ((hs[0] + hs[1]).astype(z.dtype) * jax.nn.silu(z)) @ w_out

    return finish(hs_l, z_l), (finish(hs_c, z_c) if ctx_out else None)


def setup_inputs(seed: int = 0) -> dict:
    key = jax.random.key(seed)
    keys = iter(jax.random.split(key, 32))

    def normal(shape, scale):
        return jax.random.normal(next(keys), shape, jnp.float32) * scale

    d = D_MODEL
    n_a = len(range(0, DEPTH, N_MIXERS))
    n_b = len(range(1, DEPTH, N_MIXERS))
    n_c = len(range(2, DEPTH, N_MIXERS))
    a_pow_c = jax.random.uniform(next(keys), (n_c, 2, RNN_WIDTH), jnp.float32, 0.9, 0.999)
    s = a_pow_c ** (1.0 / LRU_C)
    c_lam = jnp.log(s) - jnp.log1p(-s)
    return {
        'x': normal((BATCH, SEQ, d), 1.0),
        'c': normal((BATCH, d), 1.0),
        'ctx': normal((BATCH, CTX_LEN, d), 1.0),
        'c_ctx': normal((d,), 1.0),
        'w_mod': normal((DEPTH, d, 3 * d), 0.5 * d ** -0.5),
        'b_mod': normal((DEPTH, 3 * d), 0.02),
        'g_pre': 1.0 + normal((DEPTH, d), 0.05),
        'g_post': 1.0 + normal((DEPTH, d), 0.05),
        'a_w_in': normal((n_a, d, 2 * GLA_DK + 2 * GLA_DV), d ** -0.5),
        'a_w_g1': normal((n_a, 2, d, GLA_GATE_RANK), d ** -0.5),
        'a_w_g2': normal((n_a, 2, GLA_GATE_RANK, GLA_DK), GLA_GATE_RANK ** -0.5),
        'a_b_g': normal((n_a, 2, GLA_DK), 0.1),
        'a_g_head': 1.0 + normal((n_a, GLA_HEADS, GLA_HV), 0.05),
        'a_w_out': normal((n_a, GLA_DV, d), GLA_DV ** -0.5),
        'b_w_in': normal((n_b, d, 2 * ATT_Q_WIDTH + 2 * ATT_KV_WIDTH), d ** -0.5),
        'b_sink': normal((n_b, ATT_Q_HEADS), 0.5),
        'b_w_out': normal((n_b, ATT_Q_WIDTH, d), ATT_Q_WIDTH ** -0.5),
        'c_w_in': normal((n_c, d, 2 * RNN_WIDTH), d ** -0.5),
        'c_conv_w': normal((n_c, CONV_W, RNN_WIDTH), CONV_W ** -0.5),
        'c_conv_b': normal((n_c, RNN_WIDTH), 0.02),
        'c_w_ra': normal((n_c, 2, RNN_HEADS, RNN_HD, RNN_HD), RNN_HD ** -0.5),
        'c_b_ra': normal((n_c, 2, RNN_WIDTH), 0.02),
        'c_w_ri': normal((n_c, 2, RNN_HEADS, RNN_HD, RNN_HD), RNN_HD ** -0.5),
        'c_b_ri': normal((n_c, 2, RNN_WIDTH), 0.02),
        'c_lam': c_lam,
        'c_w_out': normal((n_c, RNN_WIDTH, d), RNN_WIDTH ** -0.5),
    }


def reference(x, c, ctx, c_ctx, w_mod, b_mod, g_pre, g_post,
              a_w_in, a_w_g1, a_w_g2, a_b_g, a_g_head, a_w_out,
              b_w_in, b_sink, b_w_out,
              c_w_in, c_conv_w, c_conv_b, c_w_ra, c_b_ra, c_w_ri, c_b_ri, c_lam, c_w_out):
    t = x.shape[1]
    rows = t // GRID_W
    row = jnp.repeat(jnp.arange(rows, dtype=jnp.float32), GRID_W)
    col = jnp.tile(jnp.arange(GRID_W, dtype=jnp.float32), rows)
    freqs = ROPE_BASE ** (-jnp.arange(ROPE_PAIRS, dtype=jnp.float32) / ROPE_PAIRS)
    ang_r = row[:, None] * freqs
    ang_c = col[:, None] * freqs
    rope = (jnp.cos(ang_r).astype(x.dtype), jnp.sin(ang_r).astype(x.dtype),
            jnp.cos(ang_c).astype(x.dtype), jnp.sin(ang_c).astype(x.dtype))

    s_lat = jax.nn.silu(c)
    s_ctx = jax.nn.silu(c_ctx)
    xc = ctx
    for i in range(DEPTH):
        kind, j = i % N_MIXERS, i // N_MIXERS
        ctx_out = i < DEPTH - 1
        shift, scale, gate = jnp.split(s_lat @ w_mod[i] + b_mod[i], 3, axis=-1)
        shift_c, scale_c, gate_c = jnp.split(s_ctx @ w_mod[i] + b_mod[i], 3, axis=-1)
        h = rmsnorm(x, g_pre[i]) * (1.0 + scale[:, None, :]) + shift[:, None, :]
        hc = rmsnorm(xc, g_pre[i]) * (1.0 + scale_c) + shift_c
        if kind == 0:
            y, yc = mixer_gla(h, hc, a_w_in[j], a_w_g1[j], a_w_g2[j], a_b_g[j], a_g_head[j], a_w_out[j], ctx_out)
        elif kind == 1:
            y, yc = mixer_swa(h, hc, b_w_in[j], b_sink[j], b_w_out[j], rope, ctx_out)
        else:
            y, yc = mixer_rglru(h, hc, c_w_in[j], c_conv_w[j], c_conv_b[j], c_w_ra[j], c_b_ra[j],
                                c_w_ri[j], c_b_ri[j], c_lam[j], c_w_out[j], ctx_out)
        x = x + gate[:, None, :] * rmsnorm(y, g_post[i])
        if ctx_out:
            xc = xc + gate_c * rmsnorm(yc, g_post[i])
    return x
```

```cpp
#include <hip/hip_runtime.h>
#include <hip/hip_cooperative_groups.h>
#include <cstdio>
namespace cg = cooperative_groups;

typedef unsigned short bf16_t;
typedef short bf16x8 __attribute__((ext_vector_type(8)));
typedef short s16x4 __attribute__((ext_vector_type(4)));
typedef float f32x4 __attribute__((ext_vector_type(4)));
typedef float f32x2 __attribute__((ext_vector_type(2)));
typedef unsigned u32x2 __attribute__((ext_vector_type(2)));
typedef unsigned u32x4 __attribute__((ext_vector_type(4)));

#ifndef REP_G
#define REP_G 1
#endif
#ifndef REP_GLA
#define REP_GLA 1
#endif
#ifndef REP_ATT
#define REP_ATT 1
#endif
#ifndef REP_R
#define REP_R 1
#endif
#ifndef REP_PRO
#define REP_PRO 1
#endif
#ifndef ONE_LAUNCH
#define ONE_LAUNCH 1
#endif

constexpr int NTHR = 512;
constexpr int DM = 1024;
constexpr int ML = 32768;
constexpr int MC = 1024;
constexpr int MT = ML + MC;
constexpr int NA_IN = 3328;
constexpr int LDS_BYTES = 159808;
constexpr int NPH = 24;
constexpr float EPS = 1e-6f;

struct Params {
  const float *x, *c, *ctx, *c_ctx, *w_mod, *b_mod, *g_pre, *g_post;
  const float *a_w_in, *a_w_g1, *a_w_g2, *a_b_g, *a_g_head, *a_w_out;
  const float *b_w_in, *b_sink, *b_w_out;
  const float *c_w_in, *c_conv_w, *c_conv_b, *c_w_ra, *c_b_ra, *c_w_ri, *c_b_ri, *c_lam, *c_w_out;
  float* out;
  char* ws;
};


constexpr size_t al256(size_t x) { return (x + 255) & ~(size_t)255; }
constexpr size_t O_WT_A_IN = 0;
constexpr size_t O_WT_A_OUT = O_WT_A_IN + al256((size_t)2 * NA_IN * 1024 * 2);
constexpr size_t O_WT_B_IN = O_WT_A_OUT + al256((size_t)2 * 1024 * 1024 * 2);
constexpr size_t O_WT_B_OUT = O_WT_B_IN + al256((size_t)2560 * 1024 * 2);
constexpr size_t O_WT_C_IN = O_WT_B_OUT + al256((size_t)1024 * 1024 * 2);
constexpr size_t O_WT_C_OUT = O_WT_C_IN + al256((size_t)2560 * 1024 * 2);
constexpr size_t O_WT_GATE = O_WT_C_OUT + al256((size_t)1024 * 1280 * 2);
constexpr size_t O_MOD = O_WT_GATE + al256((size_t)40 * 128 * 128 * 2);
constexpr size_t O_ROPE = O_MOD + al256((size_t)4 * 5 * 3072 * 4);
constexpr size_t O_G1 = O_ROPE + al256((size_t)128 * 16 * 2 * 4);
constexpr size_t O_XC = O_G1 + al256((size_t)MT * 32 * 4);
constexpr size_t O_H = O_XC + al256((size_t)MC * 1024 * 4);
constexpr size_t O_Y = O_H + al256((size_t)MT * 1024 * 2);
constexpr size_t O_PROJ = O_Y + al256((size_t)MT * 1024 * 2);
constexpr size_t O_OG = O_PROJ + al256((size_t)MT * 3072 * 2);
constexpr size_t O_BAR = O_OG + al256((size_t)MT * 1280 * 2);
constexpr size_t WS_NEED = O_BAR + 16384;
constexpr size_t O_OF = O_H;
constexpr size_t O_SEG_E = O_Y;
constexpr size_t O_SEG_D = O_Y + (size_t)512 * 16 * 512 * 16;
constexpr size_t O_TC = O_Y;
constexpr size_t O_CI = O_Y + (size_t)16 * 1024 * 1024;
static_assert(WS_NEED <= (size_t)512 * 1024 * 1024, "workspace map exceeds 512 MiB");
#define WSP(T, off) ((T*)(p.ws + (off)))

__device__ __forceinline__ unsigned short f2bf(float f) { unsigned u = __float_as_uint(f); u += 0x7fffu + ((u >> 16) & 1u); return (unsigned short)(u >> 16); }
__device__ __forceinline__ float bf2f(unsigned short h) { return __uint_as_float(((unsigned)h) << 16); }
typedef __bf16 bf16v2_t __attribute__((ext_vector_type(2)));
__device__ __forceinline__ unsigned pk2(float a, float b) {
  f32x2 v = {a, b}; bf16v2_t r = __builtin_convertvector(v, bf16v2_t); return __builtin_bit_cast(unsigned, r);
}
__device__ __forceinline__ float bflo(unsigned u) { return __uint_as_float(u << 16); }
__device__ __forceinline__ float bfhi(unsigned u) { return __uint_as_float(u & 0xffff0000u); }
__device__ __forceinline__ float silu_f(float x) { return x * __builtin_amdgcn_rcpf(1.f + __expf(-x)); }
__device__ __forceinline__ float sigm_f(float x) { return __builtin_amdgcn_rcpf(1.f + __expf(-x)); }
__device__ __forceinline__ f32x4 mfma16(bf16x8 a, bf16x8 b, f32x4 c) { return __builtin_amdgcn_mfma_f32_16x16x32_bf16(a, b, c, 0, 0, 0); }
__device__ __forceinline__ s16x4 tr_read(const bf16_t* p) {
  return __builtin_amdgcn_ds_read_tr16_b64_v4i16((__attribute__((address_space(3))) s16x4*)p);
}
__device__ __forceinline__ bf16x8 frag_tr(const bf16_t* tile, int pitch, int krow0, int col0, int lane) {
  const int g = lane >> 4, q = (lane & 15) >> 2, pp = lane & 3;
  const bf16_t* a = tile + (krow0 + 8 * g + q) * pitch + col0 + 4 * pp;
  s16x4 r0 = tr_read(a), r1 = tr_read(a + 4 * pitch);
  bf16x8 o; o[0] = r0[0]; o[1] = r0[1]; o[2] = r0[2]; o[3] = r0[3]; o[4] = r1[0]; o[5] = r1[1]; o[6] = r1[2]; o[7] = r1[3];
  return o;
}
__device__ __forceinline__ bf16x8 pack8(f32x4 a, f32x4 b) {
  union { bf16x8 v; unsigned u[4]; } r;
  r.u[0] = pk2(a[0], a[1]); r.u[1] = pk2(a[2], a[3]); r.u[2] = pk2(b[0], b[1]); r.u[3] = pk2(b[2], b[3]);
  return r.v;
}
template <class T> __device__ __forceinline__ T* sb_ptr(T* v) {
  const unsigned long long u = (unsigned long long)v;
  const unsigned lo = __builtin_amdgcn_readfirstlane((unsigned)u), hi = __builtin_amdgcn_readfirstlane((unsigned)(u >> 32));
  typedef __attribute__((address_space(1))) T GT;
  GT* g = (GT*)(((unsigned long long)hi << 32) | lo);
  return (T*)g;
}
__device__ __forceinline__ float wave_sum(float v) {
#pragma unroll
  for (int o = 32; o > 0; o >>= 1) v += __shfl_xor(v, o);
  return v;
}

__device__ __forceinline__ void conv_tile_wave(const float* __restrict__ src, int K, int N, bf16_t* __restrict__ dst, int ldk, int tk, int tn, float* T, int lane, float wscale) {
  const int k0 = tk * 64, n0 = tn * 64;
  const int c4 = (lane & 15) * 4, r0 = lane >> 4;
  f32x4 v[16];
#pragma unroll
  for (int i = 0; i < 16; ++i) {
    const int k = k0 + r0 + 4 * i, n = n0 + c4;
    v[i] = (f32x4){0.f, 0.f, 0.f, 0.f};
    if (n + 3 < N) v[i] = *(const f32x4*)(src + (size_t)k * N + n);
  }
#pragma unroll
  for (int i = 0; i < 16; ++i) { float* t = T + (r0 + 4 * i) * 65 + c4; t[0] = v[i][0] * wscale; t[1] = v[i][1] * wscale; t[2] = v[i][2] * wscale; t[3] = v[i][3] * wscale; }
  const int k8 = (lane & 7) * 8;
#pragma unroll
  for (int i = 0; i < 8; ++i) {
    const int n = (lane >> 3) + 8 * i;
    if (n0 + n < N) {
      u32x4 o;
      o[0] = pk2(T[(k8 + 0) * 65 + n], T[(k8 + 1) * 65 + n]);
      o[1] = pk2(T[(k8 + 2) * 65 + n], T[(k8 + 3) * 65 + n]);
      o[2] = pk2(T[(k8 + 4) * 65 + n], T[(k8 + 5) * 65 + n]);
      o[3] = pk2(T[(k8 + 6) * 65 + n], T[(k8 + 7) * 65 + n]);
      *(u32x4*)(dst + (size_t)(n0 + n) * ldk + k0 + k8) = o;
    }
  }
}

__device__ __forceinline__ void prologue_phase(const Params& p, char* lds) {
  const int tid = threadIdx.x;
  constexpr int NJ = 12 + 40;
  float* Tw = (float*)lds + (tid >> 6) * (64 * 65);
  for (int t = blockIdx.x * 8 + (tid >> 6); t < 4128; t += gridDim.x * 8) {
    int r = t;
    const float* src; bf16_t* dst; int K, N, ldk; float wscale = 1.0f;
    if (r < 1536) { int j = r / 768; r %= 768; K = 1024; N = 3072; src = p.a_w_in + (size_t)j * 1024 * 3072; dst = WSP(bf16_t, O_WT_A_IN) + (size_t)j * NA_IN * 1024; ldk = 1024; }
    else if ((r -= 1536) < 64) { int jd = r / 16; r %= 16; K = 1024; N = 16; src = p.a_w_g1 + (size_t)jd * 1024 * 16; dst = WSP(bf16_t, O_WT_A_IN) + (size_t)(jd >> 1) * NA_IN * 1024 + (size_t)(3072 + 16 * (jd & 1)) * 1024; ldk = 1024; }
    else if ((r -= 64) < 512) { int j = r / 256; r %= 256; K = 1024; N = 1024; src = p.a_w_out + (size_t)j * 1024 * 1024; dst = WSP(bf16_t, O_WT_A_OUT) + (size_t)j * 1024 * 1024; ldk = 1024; }
    else if ((r -= 512) < 640) { K = 1024; N = 2560; src = p.b_w_in; dst = WSP(bf16_t, O_WT_B_IN); ldk = 1024; }
    else if ((r -= 640) < 256) { K = 1024; N = 1024; src = p.b_w_out; dst = WSP(bf16_t, O_WT_B_OUT); ldk = 1024; }
    else if ((r -= 256) < 640) { K = 1024; N = 2560; src = p.c_w_in; dst = WSP(bf16_t, O_WT_C_IN); ldk = 1024; }
    else if ((r -= 640) < 320) { K = 1280; N = 1024; src = p.c_w_out; dst = WSP(bf16_t, O_WT_C_OUT); ldk = 1280; }
    else { r -= 320; int m = r / 4; r %= 4; K = 128; N = 128; ldk = 128; wscale = -1.4426950408889634f;
      src = (m < 20 ? p.c_w_ra + (size_t)m * 16384 : p.c_w_ri + (size_t)(m - 20) * 16384); dst = WSP(bf16_t, O_WT_GATE) + (size_t)m * 16384; }
    const int tnn = (N + 63) / 64;
    conv_tile_wave(src, K, N, dst, ldk, r / tnn, r % tnn, Tw, tid & 63, wscale);
  }
  (void)NJ;
  for (int i = blockIdx.x * NTHR + tid; i < 2 * 224 * 1024 / 8; i += gridDim.x * NTHR) {
    const int j = i / (224 * 128), r = i % (224 * 128);
    *(u32x4*)(WSP(bf16_t, O_WT_A_IN) + (size_t)j * NA_IN * 1024 + (size_t)3104 * 1024 + (size_t)r * 8) = (u32x4){0u, 0u, 0u, 0u};
  }
  for (int i = blockIdx.x * NTHR + tid; i < 2048; i += gridDim.x * NTHR) {
    const int pos = i >> 4, k = i & 15;
    const float f = powf(10000.0f, -(float)k / 16.0f);
    const float ang = (float)pos * f;
    float s, c; sincosf(ang, &s, &c);
    WSP(float, O_ROPE)[2 * i] = c; WSP(float, O_ROPE)[2 * i + 1] = s;
  }
  {
    float* sv = (float*)lds;
    float* red = (float*)(lds + 20480);
    __syncthreads();
    for (int i = tid; i < 5 * 1024; i += NTHR) {
      const int r = i >> 10, k = i & 1023;
      const float v = (r < 4) ? p.c[r * 1024 + k] : p.c_ctx[k];
      sv[i] = silu_f(v);
    }
    __syncthreads();
    const int lane = tid & 63, w = tid >> 6;
    for (int it = blockIdx.x; it < 4 * 48; it += gridDim.x) {
      const int layer = it / 48, n0 = (it % 48) * 64;
      const float* W = p.w_mod + (size_t)layer * 1024 * 3072 + n0 + lane;
      float a0 = 0.f, a1 = 0.f, a2 = 0.f, a3 = 0.f, a4 = 0.f;
#pragma unroll 8
      for (int k = w * 128; k < w * 128 + 128; ++k) {
        const float wv = W[(size_t)k * 3072];
        a0 += sv[k] * wv; a1 += sv[1024 + k] * wv; a2 += sv[2048 + k] * wv; a3 += sv[3072 + k] * wv; a4 += sv[4096 + k] * wv;
      }
      red[(w * 5 + 0) * 64 + lane] = a0; red[(w * 5 + 1) * 64 + lane] = a1; red[(w * 5 + 2) * 64 + lane] = a2;
      red[(w * 5 + 3) * 64 + lane] = a3; red[(w * 5 + 4) * 64 + lane] = a4;
      __syncthreads();
      if (tid < 320) {
        const int r = tid >> 6, l = tid & 63;
        float s = p.b_mod[layer * 3072 + n0 + l];
#pragma unroll
        for (int ww = 0; ww < 8; ++ww) s += red[(ww * 5 + r) * 64 + l];
        WSP(float, O_MOD)[((size_t)layer * 5 + r) * 3072 + n0 + l] = s;
      }
      __syncthreads();
    }
  }
}

__device__ __forceinline__ void post_rows(const Params& p, int layer, int m_first, int stride, int nrows) {
  const int tid = threadIdx.x, lane = tid & 63;
  const int nl = layer + 1;
  float gpv[16], gprev[16], gatev[16], scv[16], shv[16];
#pragma unroll
  for (int hh = 0; hh < 2; ++hh)
#pragma unroll
    for (int q4 = 0; q4 < 2; ++q4) {
      const int e0 = hh * 512 + lane * 8 + 4 * q4;
      if (layer >= 0) { const f32x4 t = *(const f32x4*)(p.g_post + layer * DM + e0); gpv[hh * 8 + 4 * q4] = t[0]; gpv[hh * 8 + 4 * q4 + 1] = t[1]; gpv[hh * 8 + 4 * q4 + 2] = t[2]; gpv[hh * 8 + 4 * q4 + 3] = t[3]; }
      if (layer < 3) { const f32x4 t = *(const f32x4*)(p.g_pre + nl * DM + e0); gprev[hh * 8 + 4 * q4] = t[0]; gprev[hh * 8 + 4 * q4 + 1] = t[1]; gprev[hh * 8 + 4 * q4 + 2] = t[2]; gprev[hh * 8 + 4 * q4 + 3] = t[3]; }
    }
  int cur_mb = -1;
  f32x4 xr[4]; u32x4 yr[2];
#define POST_LOAD(mm) { const float* xin_ = ((mm) < ML) ? ((layer <= 0) ? p.x + (size_t)(mm) * DM : p.out + (size_t)(mm) * DM) \
                                                     : ((layer <= 0) ? p.ctx + (size_t)((mm) - ML) * DM : WSP(float, O_XC) + (size_t)((mm) - ML) * DM); \
    xr[0] = *(const f32x4*)(xin_ + lane * 8); xr[1] = *(const f32x4*)(xin_ + lane * 8 + 4); xr[2] = *(const f32x4*)(xin_ + 512 + lane * 8); xr[3] = *(const f32x4*)(xin_ + 512 + lane * 8 + 4); \
    if (layer >= 0) { yr[0] = *(const u32x4*)(WSP(bf16_t, O_Y) + (size_t)(mm) * DM + lane * 8); yr[1] = *(const u32x4*)(WSP(bf16_t, O_Y) + (size_t)(mm) * DM + 512 + lane * 8); } }
  int m = m_first;
  if (m < nrows) POST_LOAD(m)
  while (m < nrows) {
    const int mn = m + stride;
    float xv[16], yv[16];
#pragma unroll
    for (int hh = 0; hh < 2; ++hh)
#pragma unroll
      for (int i = 0; i < 4; ++i) {
        xv[hh * 8 + i] = xr[2 * hh][i]; xv[hh * 8 + 4 + i] = xr[2 * hh + 1][i];
        if (layer >= 0) { yv[hh * 8 + 2 * i] = bflo(yr[hh][i]); yv[hh * 8 + 2 * i + 1] = bfhi(yr[hh][i]); }
      }
    if (mn < nrows) POST_LOAD(mn)
    const int mb = (m < ML) ? (m >> 13) : 4;
    if (mb != cur_mb) {
      cur_mb = mb;
#pragma unroll
      for (int hh = 0; hh < 2; ++hh)
#pragma unroll
        for (int q4 = 0; q4 < 2; ++q4) {
          const int e0 = hh * 512 + lane * 8 + 4 * q4, o = hh * 8 + 4 * q4;
          if (layer >= 0) { const f32x4 t = *(const f32x4*)(WSP(float, O_MOD) + ((size_t)layer * 5 + mb) * 3072 + 2048 + e0); gatev[o] = t[0]; gatev[o + 1] = t[1]; gatev[o + 2] = t[2]; gatev[o + 3] = t[3]; }
          if (layer < 3) {
            const float* sh = WSP(float, O_MOD) + ((size_t)nl * 5 + mb) * 3072 + e0;
            const f32x4 t = *(const f32x4*)sh, u = *(const f32x4*)(sh + 1024);
            shv[o] = t[0]; shv[o + 1] = t[1]; shv[o + 2] = t[2]; shv[o + 3] = t[3];
            scv[o] = 1.0f + u[0]; scv[o + 1] = 1.0f + u[1]; scv[o + 2] = 1.0f + u[2]; scv[o + 3] = 1.0f + u[3];
          }
        }
    }
    float* xout = (m < ML) ? p.out + (size_t)m * DM : WSP(float, O_XC) + (size_t)(m - ML) * DM;
    if (layer >= 0) {
      float ss = 0.f;
#pragma unroll
      for (int i = 0; i < 16; ++i) ss += yv[i] * yv[i];
      ss = wave_sum(ss);
      const float r = rsqrtf(ss * (1.0f / 1024.0f) + EPS);
#pragma unroll
      for (int hh = 0; hh < 2; ++hh) {
        const int e0 = hh * 512 + lane * 8;
        f32x4 o0, o1;
#pragma unroll
        for (int i = 0; i < 8; ++i) {
          const float v = xv[hh * 8 + i] + gatev[hh * 8 + i] * (yv[hh * 8 + i] * r * gpv[hh * 8 + i]);
          xv[hh * 8 + i] = v;
          if (i < 4) o0[i] = v; else o1[i - 4] = v;
        }
        *(f32x4*)(xout + e0) = o0; *(f32x4*)(xout + e0 + 4) = o1;
      }
    }
    if (layer < 3) {
      float ss = 0.f;
#pragma unroll
      for (int i = 0; i < 16; ++i) ss += xv[i] * xv[i];
      ss = wave_sum(ss);
      const float r = rsqrtf(ss * (1.0f / 1024.0f) + EPS);
#pragma unroll
      for (int hh = 0; hh < 2; ++hh) {
        const int e0 = hh * 512 + lane * 8;
        float hv[8];
#pragma unroll
        for (int i = 0; i < 8; ++i) hv[i] = xv[hh * 8 + i] * r * gprev[hh * 8 + i] * scv[hh * 8 + i] + shv[hh * 8 + i];
        u32x4 o; o[0] = pk2(hv[0], hv[1]); o[1] = pk2(hv[2], hv[3]); o[2] = pk2(hv[4], hv[5]); o[3] = pk2(hv[6], hv[7]);
        *(u32x4*)(WSP(bf16_t, O_H) + (size_t)m * DM + e0) = o;
      }
    }
    m = mn;
  }
#undef POST_LOAD
}

template <int EPI>
__device__ __forceinline__ void gemm_phase(const Params& p, const bf16_t* __restrict__ A, int lda, const bf16_t* __restrict__ Bt, int N, int K,
                           bf16_t* __restrict__ C, int ldc, int mtiles, char* lds, int vb) {
  const int tid = threadIdx.x, lane = tid & 63, w = tid >> 6, l15 = lane & 15, quad = lane >> 4;
  const int wm = w >> 1, wn = w & 1;
  const int ntn = N / 128, ntiles = mtiles * ntn, nk = K / 64;
  bf16_t* As0 = (bf16_t*)lds; bf16_t* Bs0 = As0 + 256 * 64;
  bf16_t* As1 = (bf16_t*)(lds + 49152); bf16_t* Bs1 = As1 + 256 * 64;
  const int lrow = tid >> 3, lch = (tid & 7) * 8;
  const int wsw = (((tid & 7) ^ (lrow & 7)) * 8);
  const int rsw = l15 & 7;
  u32x4 s0a0, s0a1, s0a2, s0a3, s0b0, s0b1, s1a0, s1a1, s1a2, s1a3, s1b0, s1b1, s2a0, s2a1, s2a2, s2a3, s2b0, s2b1;
  const bf16_t* Ag = A; const bf16_t* Bg = Bt;
  int m0 = 0, n0 = 0;
#define G_TILE_PTRS(t_) { const int band_ = (t_) / (4 * ntn), qq_ = (t_) % (4 * ntn); \
      m0 = (4 * band_ + (qq_ & 3)) * 256; n0 = (qq_ >> 2) * 128; \
      Ag = A + (size_t)(m0 + lrow) * lda + lch; Bg = Bt + (size_t)(n0 + lrow) * K + lch; }
#define G_LOAD(S, kt_) { const int ko_ = (kt_) * 64; \
      S##a0 = *(const u32x4*)(Ag + ko_); S##a1 = *(const u32x4*)(Ag + (size_t)64 * lda + ko_); S##a2 = *(const u32x4*)(Ag + (size_t)128 * lda + ko_); S##a3 = *(const u32x4*)(Ag + (size_t)192 * lda + ko_); \
      S##b0 = *(const u32x4*)(Bg + ko_); S##b1 = *(const u32x4*)(Bg + (size_t)64 * K + ko_); }
#define G_WRITE(S, buf_) { bf16_t* a_ = ((buf_) ? As1 : As0) + lrow * 64 + wsw; bf16_t* b_ = ((buf_) ? Bs1 : Bs0) + lrow * 64 + wsw; \
      *(u32x4*)a_ = S##a0; *(u32x4*)(a_ + 64 * 64) = S##a1; *(u32x4*)(a_ + 128 * 64) = S##a2; *(u32x4*)(a_ + 192 * 64) = S##a3; \
      *(u32x4*)b_ = S##b0; *(u32x4*)(b_ + 64 * 64) = S##b1; }
#define G_COMP(ks) { \
        bf16x8 xf[4], wf[4]; \
        _Pragma("unroll") for (int i = 0; i < 4; ++i) { \
          xf[i] = *(const bf16x8*)(as + (wm * 64 + i * 16 + l15) * 64 + ((((ks) * 4 + quad) ^ rsw) * 8)); \
          wf[i] = *(const bf16x8*)(bs + (wn * 64 + i * 16 + l15) * 64 + ((((ks) * 4 + quad) ^ rsw) * 8)); } \
        _Pragma("unroll") for (int mi = 0; mi < 4; ++mi) \
          _Pragma("unroll") for (int ni = 0; ni < 4; ++ni) acc[mi][ni] = mfma16(wf[ni], xf[mi], acc[mi][ni]); }
#define G_BODY(kt_, S) { \
      if ((kt_) + 1 < nk) { G_WRITE(S, ((kt_) + 1) & 1) if ((kt_) + 4 < nk) G_LOAD(S, (kt_) + 4) } \
      const bf16_t* as = ((kt_) & 1) ? As1 : As0; const bf16_t* bs = ((kt_) & 1) ? Bs1 : Bs0; \
      G_COMP(0) \
      G_COMP(1) \
      __syncthreads(); }
  int t = vb;
  if (t < ntiles) { G_TILE_PTRS(t) G_LOAD(s0, 0) G_LOAD(s1, 1) G_LOAD(s2, 2) }
  while (t < ntiles) {
    f32x4 acc[4][4];
#pragma unroll
    for (int i = 0; i < 4; ++i)
#pragma unroll
      for (int j = 0; j < 4; ++j) acc[i][j] = (f32x4){0.f, 0.f, 0.f, 0.f};
    G_WRITE(s0, 0)
    G_LOAD(s0, 3)
    __syncthreads();
    for (int kt = 0; kt < nk; kt += 3) {
      G_BODY(kt, s1)
      if (kt + 1 < nk) G_BODY(kt + 1, s2)
      if (kt + 2 < nk) G_BODY(kt + 2, s0)
    }
    const int m0c = m0, n0c = n0;
    t += gridDim.x;
    if (t < ntiles) { G_TILE_PTRS(t) G_LOAD(s0, 0) G_LOAD(s1, 1) G_LOAD(s2, 2) }
    const int nw = n0c + wn * 64;
    if (EPI == 2) {
      if (nw < 1280 && m0c < ML) {
#pragma unroll
        for (int mi = 0; mi < 4; ++mi) {
          const int m = m0c + wm * 64 + mi * 16 + l15;
          const int tt = m & 8191;
#pragma unroll
          for (int pr = 0; pr < 2; ++pr) {
            const int pos = pr ? (tt & 63) : (tt >> 6);
            const float* rp = WSP(float, O_ROPE) + (size_t)(pos * 16 + quad * 4) * 2;
            const f32x4 r0 = *(const f32x4*)rp, r1 = *(const f32x4*)(rp + 4);
            const float cs[4] = {r0[0], r0[2], r1[0], r1[2]}, sn[4] = {r0[1], r0[3], r1[1], r1[3]};
#pragma unroll
            for (int j = 0; j < 4; ++j) {
              const float x1 = acc[mi][2 * pr][j], x2 = acc[mi][2 * pr + 1][j];
              acc[mi][2 * pr][j] = x1 * cs[j] - x2 * sn[j];
              acc[mi][2 * pr + 1][j] = x2 * cs[j] + x1 * sn[j];
            }
          }
        }
      }
    }
#pragma unroll
    for (int mi = 0; mi < 4; ++mi) {
      const int m = m0c + wm * 64 + mi * 16 + l15;
#pragma unroll
      for (int ni = 0; ni < 4; ++ni) {
        const int n = nw + ni * 16 + quad * 4;
        const f32x4 v = acc[mi][ni];
        if (EPI == 1) {
          if (n < 3072) { u32x2 o; o[0] = pk2(v[0], v[1]); o[1] = pk2(v[2], v[3]); *(u32x2*)(C + (size_t)m * ldc + n) = o; }
          else if (n < 3104) { *(f32x4*)(WSP(float, O_G1) + (size_t)m * 32 + (n - 3072)) = v; }
        } else {
          u32x2 o; o[0] = pk2(v[0], v[1]); o[1] = pk2(v[2], v[3]); *(u32x2*)(C + (size_t)m * ldc + n) = o;
        }
      }
    }
  }
}

#undef G_LOAD
#undef G_WRITE
#undef G_BODY
#undef G_COMP
#undef G_TILE_PTRS
namespace pg8 {
#define PG8_LAS __attribute__((address_space(3)))
typedef unsigned short bf16_t;
typedef short bf16x8 __attribute__((ext_vector_type(8)));
typedef float f32x4 __attribute__((ext_vector_type(4)));
typedef unsigned u32x4 __attribute__((ext_vector_type(4)));
constexpr int BM = 256, BK = 64, HALF = 128, HTB = HALF * BK * 2  , STAGE_BYTES = 8 * HTB, NXCD = 8, WGM = 8;

__host__ __device__ __forceinline__ int lds_byte(int r, int c) { const int st = (r >> 4) * 2 + (c >> 5), rr = r & 15, cc = c & 31, ob = rr * 64 + cc * 2; return st * 1024 + (ob ^ (((ob >> 9) & 1) << 5)); }
__host__ __device__ __forceinline__ void stage_rc(int b, int& R, int& C) { const int st = b / 1024, sb = b % 1024, swz = sb ^ (((sb >> 9) & 1) << 5); R = (st >> 1) * 16 + swz / 64; C = (st & 1) * 32 + (swz % 64) / 2; }
__host__ __device__ __forceinline__ int perm32(int rho) { const int n = rho >> 4, i = rho & 15; return 8 * (i >> 2) + 4 * n + (i & 3); }

struct Unit { int pm, pn; };
struct Gemm { const bf16_t* A; const bf16_t* Bt; int M, N, K; };

struct StaticOrder {
    int nM, nN, nwg, G, c;
    __host__ __device__ void init(int M, int N, int G_, int c_) { nM = M / BM; nN = N / BM; nwg = nM * nN; G = G_; c = c_; }
    __host__ __device__ bool next(int i, Unit& u) const {
        const long L = (long)i * G + c; if (L >= nwg) return false;
        int wgid = (int)L; { const int q = nwg / NXCD, r = nwg % NXCD, xcd = wgid % NXCD, off = wgid / NXCD; wgid = (xcd < r ? xcd * (q + 1) : r * (q + 1) + (xcd - r) * q) + off; }
        const int nig = WGM * nN, gid = wgid / nig, fm = gid * WGM, gsz = (nM - fm) < WGM ? (nM - fm) : WGM;
        u.pm = fm + ((wgid % nig) % gsz); u.pn = (wgid % nig) / gsz; return true;
    }
    __device__ __forceinline__ void a_ready(const Unit&) const {}
    __device__ __forceinline__ void done(const Unit&) const {}
};
template <class Epi, class Sched, bool ALIGN_EPI = false, bool SP2 = false>
__device__ __forceinline__ void gemm_phase(PG8_LAS unsigned char* lds, const Gemm g, const Sched& S, const Epi& E) {
    const int tid = threadIdx.x, wid = __builtin_amdgcn_readfirstlane(tid >> 6), lane = tid & 63, wr = wid >> 2, wc = wid & 3, fr = lane & 15, fq = lane >> 4;
    const int K = g.K, nt = K / BK;
    unsigned voffA[2], voffB[2];
#pragma unroll
    for (int i = 0; i < 2; ++i) { int R, C; stage_rc(tid * 16 + i * 8192, R, C); const int Rb = Epi::PERM ? ((R & ~31) + perm32(R & 31)) : R;
        voffA[i] = (unsigned)(R * K + C) * 2u; voffB[i] = (unsigned)(Rb * K + C) * 2u; }
    const size_t kstep = (size_t)(BK * 2);
    const size_t hstep = (size_t)HALF * K * 2;
    const size_t tstep = 2 * hstep;
    const unsigned ldsw = (unsigned)wid * 1024u;
    const int aoff = lds_byte(wr * 64 + fr, fq * 8), boff = lds_byte(wc * 32 + fr, fq * 8);
#define PG8_SA(b, h) (((b) * 2 + (h)) * HTB)
#define PG8_SB(b, h) ((4 + (b) * 2 + (h)) * HTB)
#define PG8_STAGE(bufoff, gbase, voff) do { _Pragma("unroll") for (int _i = 0; _i < 2; ++_i) \
        __builtin_amdgcn_global_load_lds((const unsigned*)((const char*)(gbase) + (voff)[_i]), (PG8_LAS unsigned*)(lds + (bufoff) + ldsw + _i * 8192), 16, 0, 0); } while (0)
#define PG8_LDA(dst, b, h) do { _Pragma("unroll") for (int m = 0; m < 4; ++m) _Pragma("unroll") for (int k = 0; k < 2; ++k) dst[m][k] = *(const PG8_LAS bf16x8*)(lds + PG8_SA(b, h) + aoff + m * 2048 + k * 1024); } while (0)
#define PG8_LDB(dst, b, h) do { _Pragma("unroll") for (int n = 0; n < 2; ++n) _Pragma("unroll") for (int k = 0; k < 2; ++k) dst[n][k] = *(const PG8_LAS bf16x8*)(lds + PG8_SB(b, h) + boff + n * 2048 + k * 1024); } while (0)
#define PG8_MMA(ai, bj, At, Bt) do { __builtin_amdgcn_s_setprio(1); _Pragma("unroll") for (int m = 0; m < 4; ++m) _Pragma("unroll") for (int n = 0; n < 2; ++n) _Pragma("unroll") for (int k = 0; k < 2; ++k) \
        acc[ai][bj][m][n] = __builtin_amdgcn_mfma_f32_16x16x32_bf16(Bt[n][k], At[m][k], acc[ai][bj][m][n], 0, 0, 0); __builtin_amdgcn_s_setprio(0); } while (0)
#define PG8_WAIT_V(n) asm volatile("s_waitcnt vmcnt(" #n ")" ::: "memory")
#define PG8_WAIT_L(n) asm volatile("s_waitcnt lgkmcnt(" #n ")" ::: "memory")
#define PG8_BAR __builtin_amdgcn_s_barrier()
#define PG8_SCHED __builtin_amdgcn_sched_barrier(0)
    Unit cur, nxt; int ui = 0;
    if (!S.next(0, cur)) return;
    f32x4 acc[2][2][4][2];
#pragma unroll
    for (int a = 0; a < 2; ++a)
#pragma unroll
        for (int b = 0; b < 2; ++b)
#pragma unroll
            for (int m = 0; m < 4; ++m)
#pragma unroll
                for (int n = 0; n < 2; ++n) acc[a][b][m][n] = (f32x4){0.f, 0.f, 0.f, 0.f};
    bf16x8 At[4][2], B0[2][2], B1[2][2];
    const char* cA = (const char*)g.A + (size_t)cur.pm * tstep; const char* cB = (const char*)g.Bt + (size_t)cur.pn * tstep;
    S.a_ready(cur);
    if constexpr (SP2) {
        PG8_STAGE(PG8_SB(0, 0), cB, voffB); PG8_STAGE(PG8_SB(0, 1), cB + hstep, voffB); PG8_STAGE(PG8_SA(0, 0), cA, voffA); PG8_STAGE(PG8_SA(0, 1), cA + hstep, voffA);
        if (wr == 1) PG8_BAR;
        PG8_WAIT_V(2); PG8_BAR;
        PG8_STAGE(PG8_SB(1, 0), cB + kstep, voffB); PG8_STAGE(PG8_SA(1, 0), cA + kstep, voffA); PG8_STAGE(PG8_SB(1, 1), cB + hstep + kstep, voffB);
        PG8_WAIT_V(6); PG8_BAR;
    } else {
        PG8_STAGE(PG8_SB(0, 0), cB, voffB); PG8_STAGE(PG8_SA(0, 0), cA, voffA); PG8_STAGE(PG8_SB(0, 1), cB + hstep, voffB); PG8_STAGE(PG8_SA(0, 1), cA + hstep, voffA);
        if (wr == 1) PG8_BAR;
        PG8_WAIT_V(4); PG8_BAR;
        PG8_STAGE(PG8_SB(1, 0), cB + kstep, voffB); PG8_STAGE(PG8_SA(1, 0), cA + kstep, voffA); PG8_STAGE(PG8_SB(1, 1), cB + hstep + kstep, voffB);
        PG8_WAIT_V(6); PG8_BAR;
    }
    for (;;) {
        const bool has_next = S.next(ui + 1, nxt);
        const char* nA = has_next ? (const char*)g.A + (size_t)nxt.pm * tstep : cA; const char* nB = has_next ? (const char*)g.Bt + (size_t)nxt.pn * tstep : cB;
        for (int t = 0; t < nt; t += 2) {
            const bool last = (t == nt - 2);
            const char* a1 = cA + (size_t)(t + 1) * kstep;
            const char* a2 = last ? nA : cA + (size_t)(t + 2) * kstep; const char* b2 = last ? nB : cB + (size_t)(t + 2) * kstep;
            const char* a3 = a2 + kstep; const char* b3 = b2 + kstep;
            if (last && has_next) S.a_ready(nxt);
            if constexpr (SP2) {
            PG8_LDB(B0, 0, 0); PG8_LDB(B1, 0, 1); PG8_SCHED; PG8_LDA(At, 0, 0); PG8_STAGE(PG8_SA(1, 1), a1 + hstep, voffA);
            PG8_WAIT_V(8); PG8_WAIT_L(0); PG8_BAR; PG8_MMA(0, 0, At, B0); PG8_MMA(0, 1, At, B1); PG8_BAR; PG8_SCHED;
            PG8_LDA(At, 0, 1); PG8_STAGE(PG8_SB(0, 0), b2, voffB); PG8_STAGE(PG8_SB(0, 1), b2 + hstep, voffB); PG8_STAGE(PG8_SA(0, 0), a2, voffA);
            PG8_WAIT_V(8); PG8_WAIT_L(0); PG8_BAR; PG8_MMA(1, 0, At, B0); PG8_MMA(1, 1, At, B1); PG8_BAR; PG8_SCHED;
            PG8_LDB(B0, 1, 0); PG8_LDB(B1, 1, 1); PG8_SCHED; PG8_LDA(At, 1, 0); PG8_STAGE(PG8_SA(0, 1), a2 + hstep, voffA);
            PG8_WAIT_V(8); PG8_WAIT_L(0); PG8_BAR; PG8_MMA(0, 0, At, B0); PG8_MMA(0, 1, At, B1); PG8_BAR; PG8_SCHED;
            PG8_LDA(At, 1, 1); PG8_STAGE(PG8_SB(1, 0), b3, voffB); PG8_STAGE(PG8_SB(1, 1), b3 + hstep, voffB); PG8_STAGE(PG8_SA(1, 0), a3, voffA);
            PG8_WAIT_V(8); PG8_WAIT_L(0); PG8_BAR; PG8_MMA(1, 0, At, B0); PG8_MMA(1, 1, At, B1); PG8_BAR; PG8_SCHED;
            } else {
            PG8_LDB(B0, 0, 0); PG8_SCHED; PG8_LDA(At, 0, 0); PG8_STAGE(PG8_SA(1, 1), a1 + hstep, voffA);
            PG8_WAIT_L(8); PG8_BAR; PG8_WAIT_L(0); PG8_MMA(0, 0, At, B0); PG8_BAR; PG8_SCHED;
            PG8_LDB(B1, 0, 1); PG8_STAGE(PG8_SB(0, 0), b2, voffB);
            PG8_BAR; PG8_WAIT_L(0); PG8_MMA(0, 1, At, B1); PG8_BAR;
            PG8_LDA(At, 0, 1); PG8_STAGE(PG8_SA(0, 0), a2, voffA);
            PG8_BAR; PG8_WAIT_L(0); PG8_MMA(1, 0, At, B0); PG8_BAR; PG8_SCHED;
            PG8_STAGE(PG8_SB(0, 1), b2 + hstep, voffB);
            PG8_WAIT_V(6); PG8_BAR; PG8_MMA(1, 1, At, B1); PG8_BAR;
            PG8_LDB(B0, 1, 0); PG8_SCHED; PG8_LDA(At, 1, 0); PG8_STAGE(PG8_SA(0, 1), a2 + hstep, voffA);
            PG8_WAIT_L(8); PG8_BAR; PG8_WAIT_L(0); PG8_MMA(0, 0, At, B0); PG8_BAR; PG8_SCHED;
            PG8_LDB(B1, 1, 1); PG8_STAGE(PG8_SB(1, 0), b3, voffB);
            PG8_BAR; PG8_WAIT_L(0); PG8_MMA(0, 1, At, B1); PG8_BAR;
            PG8_LDA(At, 1, 1); PG8_STAGE(PG8_SA(1, 0), a3, voffA);
            PG8_BAR; PG8_WAIT_L(0); PG8_MMA(1, 0, At, B0); PG8_BAR; PG8_SCHED;
            PG8_STAGE(PG8_SB(1, 1), b3 + hstep, voffB);
            PG8_WAIT_V(6); PG8_BAR; PG8_MMA(1, 1, At, B1); PG8_BAR;
            }
        }
        if constexpr (ALIGN_EPI) { if (wr == 0) PG8_BAR; }
        if constexpr (!Epi::AFTER_DRAIN) { E(acc, cur, wr, wc, fr, fq); S.done(cur); }
        if (!has_next) break;
#pragma unroll
        for (int a = 0; a < 2; ++a)
#pragma unroll
            for (int b = 0; b < 2; ++b)
#pragma unroll
                for (int m = 0; m < 4; ++m)
#pragma unroll
                    for (int n = 0; n < 2; ++n) acc[a][b][m][n] = (f32x4){0.f, 0.f, 0.f, 0.f};
        cur = nxt; cA = nA; cB = nB; ++ui;
        if constexpr (ALIGN_EPI) { if (wr == 1) PG8_BAR; }
    }
    PG8_WAIT_V(0);
    if constexpr (!ALIGN_EPI) { if (wr == 0) PG8_BAR; }
    PG8_BAR;
    if constexpr (Epi::AFTER_DRAIN) { E.fused(acc, cur, wr, wc, fr, fq, lds, wid, lane); S.done(cur); }
#undef PG8_SA
#undef PG8_SB
#undef PG8_STAGE
#undef PG8_LDA
#undef PG8_LDB
#undef PG8_MMA
#undef PG8_WAIT_V
#undef PG8_WAIT_L
#undef PG8_BAR
#undef PG8_SCHED
}
}

struct GSched {
  int ntn, nunits, G, c;
  __device__ __forceinline__ bool next(int i, pg8::Unit& u) const {
    const long L = (long)i * G + c; if (L >= nunits) return false;
    const int band = (int)(L / (4 * ntn)), q = (int)(L % (4 * ntn)); u.pm = 4 * band + (q & 3); u.pn = q >> 2; return true;
  }
  __device__ __forceinline__ void a_ready(const pg8::Unit&) const {}
  __device__ __forceinline__ void done(const pg8::Unit&) const {}
};
template <int EPI> struct GEpi {
  static constexpr bool PERM = (EPI != 2), AFTER_DRAIN = false;
  bf16_t* C; int ldc; float* g1; const float* rope;
  __device__ __forceinline__ void operator()(f32x4 (&acc)[2][2][4][2], const pg8::Unit& u, int wr, int wc, int fr, int fq) const {
#pragma unroll
    for (int ai = 0; ai < 2; ++ai)
#pragma unroll
      for (int m = 0; m < 4; ++m) {
        const int row = u.pm * 256 + ai * 128 + wr * 64 + m * 16 + fr;
#pragma unroll
        for (int bj = 0; bj < 2; ++bj) {
          const int cb = u.pn * 256 + bj * 128 + wc * 32;
          if (EPI == 2) {
            f32x4 v0 = acc[ai][bj][m][0], v1 = acc[ai][bj][m][1];
            if (cb < 1280 && row < ML) {
              const int tt = row & 8191;
              const int pos = (wc & 1) ? (tt & 63) : (tt >> 6);
              const float* rp = rope + (size_t)(pos * 16 + fq * 4) * 2;
              const f32x4 r0 = *(const f32x4*)rp, r1 = *(const f32x4*)(rp + 4);
              const float cs[4] = {r0[0], r0[2], r1[0], r1[2]}, sn[4] = {r0[1], r0[3], r1[1], r1[3]};
#pragma unroll
              for (int j = 0; j < 4; ++j) { const float x1 = v0[j], x2 = v1[j]; v0[j] = x1 * cs[j] - x2 * sn[j]; v1[j] = x2 * cs[j] + x1 * sn[j]; }
            }
            u32x2 o0, o1; o0[0] = pk2(v0[0], v0[1]); o0[1] = pk2(v0[2], v0[3]); o1[0] = pk2(v1[0], v1[1]); o1[1] = pk2(v1[2], v1[3]);
            bf16_t* cp = C + (size_t)row * ldc + cb + 4 * fq;
            *(u32x2*)cp = o0; *(u32x2*)(cp + 16) = o1;
          } else {
            const int col = cb + 8 * fq;
            const f32x4 v0 = acc[ai][bj][m][0], v1 = acc[ai][bj][m][1];
            if (EPI == 1 && col >= 3072) {
              if (col < 3104) { float* gp = g1 + (size_t)row * 32 + (col - 3072); *(f32x4*)gp = v0; *(f32x4*)(gp + 4) = v1; }
            } else {
              u32x4 o; o[0] = pk2(v0[0], v0[1]); o[1] = pk2(v0[2], v0[3]); o[2] = pk2(v1[0], v1[1]); o[3] = pk2(v1[2], v1[3]);
              *(u32x4*)(C + (size_t)row * ldc + col) = o;
            }
          }
        }
      }
  }
};
template <int EPI>
__device__ __forceinline__ void gemm8(const Params& p, const bf16_t* A, const bf16_t* Bt, int M, int N, int K, bf16_t* C, int ldc, char* lds, int vb) {
  pg8::Gemm g{A, Bt, M, N, K};
  GSched S{N / 256, (M / 256) * (N / 256), (int)gridDim.x, vb};
  GEpi<EPI> E{C, ldc, WSP(float, O_G1), WSP(float, O_ROPE)};
  pg8::gemm_phase<GEpi<EPI>, GSched, true, true>((PG8_LAS unsigned char*)lds, g, S, E);
}

constexpr int G_G1S = 0, G_TOT = 4096, G_BS = 6144, G_QS = 38912, G_KS = 56320, G_KHS = 73728, G_VS = 91136, G_PS = 124928, G_RED = 134144, G_WG2 = 136192;
constexpr int QP = 136, VP = 264, PP = 72;

template <int MODE>
__device__ __forceinline__ void gla_run(const Params& p, int jl, int hd, int dir, int row_first, int row_step, int nch, f32x4 (&S)[8][2], float& logD, char* lds) {
  const int tid = threadIdx.x, lane = tid & 63, w = tid >> 6, l15 = lane & 15, quad = lane >> 4;
  float* g1s = (float*)(lds + G_G1S); float* tot = (float*)(lds + G_TOT); float* bs = (float*)(lds + G_BS);
  bf16_t* qs = (bf16_t*)(lds + G_QS); bf16_t* ks_ = (bf16_t*)(lds + G_KS); bf16_t* khs = (bf16_t*)(lds + G_KHS);
  bf16_t* vs = (bf16_t*)(lds + G_VS); bf16_t* ps = (bf16_t*)(lds + G_PS); float* red = (float*)(lds + G_RED);
  float wb[4];
#pragma unroll
  for (int ks4 = 0; ks4 < 4; ++ks4) wb[ks4] = p.a_w_g2[((size_t)(jl * 2 + dir) * 16 + 4 * ks4 + quad) * 512 + hd * 128 + 16 * w + l15];
  const float bg = p.a_b_g[(jl * 2 + dir) * 512 + hd * 128 + 16 * w + l15];
  const int tl = dir ? 0 : 63;
  constexpr bool PF = (MODE == 0);
  u32x4 rq[2], rk[2], rv[4];
  f32x4 rg1 = {0.f, 0.f, 0.f, 0.f};
  const unsigned g1off = (unsigned)((tid >> 2) * 128 + (tid & 3) * 16);
  const unsigned qkoff = (unsigned)((tid >> 4) * 6144 + (tid & 15) * 16);
  const unsigned vvoff = (unsigned)((tid >> 5) * 6144 + (tid & 31) * 16);
  const unsigned eoff = (unsigned)(l15 * 2048 + (32 * w + 4 * quad) * 2);
  const unsigned zoff = (unsigned)(l15 * 6144 + (32 * w + 4 * quad) * 2);
#define GLA_ISSUE_G1(row0_) { \
    const char* g1b_ = sb_ptr((const char*)WSP(float, O_G1) + (size_t)(row0_) * 128 + dir * 64); \
    if (tid < 256) rg1 = *(const f32x4*)(g1b_ + g1off); }
#define GLA_ISSUE(row0_) { \
    const char* qb_ = sb_ptr((const char*)WSP(bf16_t, O_PROJ) + (size_t)(row0_) * 6144 + hd * 256); \
    _Pragma("unroll") for (int i = 0; i < 2; ++i) { \
      if (MODE != 0) rq[i] = *(const u32x4*)(qb_ + (qkoff + (unsigned)(i * 32 * 6144))); \
      rk[i] = *(const u32x4*)(qb_ + 1024 + (qkoff + (unsigned)(i * 32 * 6144))); } \
    const char* vb_ = sb_ptr((const char*)WSP(bf16_t, O_PROJ) + (size_t)(row0_) * 6144 + 2048 + hd * 512); \
    _Pragma("unroll") for (int i = 0; i < 4; ++i) rv[i] = *(const u32x4*)(vb_ + (vvoff + (unsigned)(i * 16 * 6144))); }
  f32x4 ghv[2];
  u32x2 pof[4][2], pz[4][2];
  float* const g1sA = g1s; float* const g1sB = (float*)(lds + G_KHS); float* const blv = tot;
  GLA_ISSUE_G1(row_first)
  if (tid < 256) *(f32x4*)(g1sA + (tid >> 2) * 16 + (tid & 3) * 4) = rg1;
  if (nch > 1) GLA_ISSUE_G1(row_first + row_step)
  __syncthreads();
  if (PF) GLA_ISSUE(row_first)
  for (int ci = 0; ci < nch; ++ci) {
    const int row0 = row_first + ci * row_step;
    if (!PF) GLA_ISSUE(row0)
    const float* const g1c = (ci & 1) ? g1sB : g1sA;
    {
      float lav[4][4];
      const int arow = 16 * (l15 >> 2) + (l15 & 3);
#pragma unroll
      for (int mt = 0; mt < 4; ++mt) {
        f32x4 acc4 = {0.f, 0.f, 0.f, 0.f};
#pragma unroll
        for (int ks4 = 0; ks4 < 4; ++ks4) acc4 = __builtin_amdgcn_mfma_f32_16x16x4f32(g1c[(arow + 4 * mt) * 16 + 4 * ks4 + quad], wb[ks4], acc4, 0, 0, 0);
#pragma unroll
        for (int j = 0; j < 4; ++j) {
          const float xg = acc4[j] + bg;
          lav[mt][j] = (fminf(xg, 0.f) - 0.6931471805599453f * __builtin_amdgcn_logf(1.0f + __builtin_amdgcn_exp2f(-1.4426950408889634f * fabsf(xg)))) * (1.0f / 16.0f);
        }
      }
      float run = 0.f;
      if (dir == 0) {
#pragma unroll
        for (int mt = 0; mt < 4; ++mt)
#pragma unroll
          for (int j = 0; j < 4; ++j) { run += lav[mt][j]; lav[mt][j] = run; }
      } else {
#pragma unroll
        for (int mt = 3; mt >= 0; --mt)
#pragma unroll
          for (int j = 3; j >= 0; --j) { run += lav[mt][j]; lav[mt][j] = run; }
      }
      const float t0 = __shfl(run, l15), t1 = __shfl(run, l15 + 16), t2 = __shfl(run, l15 + 32), t3 = __shfl(run, l15 + 48);
      float off;
      if (dir == 0) off = (quad > 0 ? t0 : 0.f) + (quad > 1 ? t1 : 0.f) + (quad > 2 ? t2 : 0.f);
      else off = (quad < 3 ? t3 : 0.f) + (quad < 2 ? t2 : 0.f) + (quad < 1 ? t1 : 0.f);
#pragma unroll
      for (int mt = 0; mt < 4; ++mt)
#pragma unroll
        for (int j = 0; j < 4; ++j) bs[(16 * quad + 4 * mt + j) * 128 + 16 * w + l15] = lav[mt][j] + off;
    }
    __syncthreads();
    if (tid < 128) { const float blt = bs[tl * 128 + tid]; logD += blt; blv[(ci & 1) * 128 + tid] = blt; }
    if (ci + 1 < nch) {
      if (tid < 256) *(f32x4*)(((ci & 1) ? g1sA : g1sB) + (tid >> 2) * 16 + (tid & 3) * 4) = rg1;
      if (ci + 2 < nch) GLA_ISSUE_G1(row0 + 2 * row_step)
    }
#pragma unroll
    for (int i = 0; i < 2; ++i) {
      const int cc = tid + 512 * i, t = cc >> 4, ch = cc & 15;
      const f32x4 b0 = *(const f32x4*)(bs + t * 128 + ch * 8), b1 = *(const f32x4*)(bs + t * 128 + ch * 8 + 4);
      float bv[8] = {b0[0], b0[1], b0[2], b0[3], b1[0], b1[1], b1[2], b1[3]};
      float kf[8], qf[8];
#pragma unroll
      for (int e = 0; e < 4; ++e) { kf[2 * e] = bflo(rk[i][e]); kf[2 * e + 1] = bfhi(rk[i][e]); }
      u32x4 ok;
#pragma unroll
      for (int e = 0; e < 4; ++e) ok[e] = pk2(kf[2 * e] * __expf(-bv[2 * e]), kf[2 * e + 1] * __expf(-bv[2 * e + 1]));
      *(u32x4*)(ks_ + t * QP + ch * 8) = ok;
      if (MODE != 0) {
#pragma unroll
        for (int e = 0; e < 4; ++e) { qf[2 * e] = bflo(rq[i][e]); qf[2 * e + 1] = bfhi(rq[i][e]); }
        u32x4 oq;
        const float qsc = 0.08838834764831845f;
#pragma unroll
        for (int e = 0; e < 4; ++e) oq[e] = pk2(qf[2 * e] * (qsc * __expf(bv[2 * e])), qf[2 * e + 1] * (qsc * __expf(bv[2 * e + 1])));
        *(u32x4*)(qs + t * QP + ch * 8) = oq;
      }
    }
#pragma unroll
    for (int i = 0; i < 4; ++i) {
      const int cc = tid + 512 * i, t = cc >> 5, ch = cc & 31;
      *(u32x4*)(vs + t * VP + ch * 8) = rv[i];
    }
    if (PF && ci + 1 < nch) GLA_ISSUE(row0 + row_step)
    const char* ofb = sb_ptr((const char*)WSP(bf16_t, O_OF) + (size_t)row0 * 2048 + hd * 512);
    if (MODE == 2) {
      __builtin_amdgcn_sched_barrier(0);
#pragma unroll
      for (int it = 0; it < 4; ++it)
#pragma unroll
        for (int et = 0; et < 2; ++et)
          pof[it][et] = *(const u32x2*)(ofb + (eoff + (unsigned)(it * 32768 + et * 32)));
      __builtin_amdgcn_sched_barrier(0);
    }
    __syncthreads();
    if (MODE != 0) {
      const int it = w >> 1;
#pragma unroll
      for (int si = 0; si < 2; ++si) {
        const int st = 2 * (w & 1) + si;
        f32x4 sc = {0.f, 0.f, 0.f, 0.f};
#pragma unroll
        for (int kk = 0; kk < 4; ++kk) {
          const bf16x8 a = *(const bf16x8*)(ks_ + (16 * st + l15) * QP + 32 * kk + 8 * quad);
          const bf16x8 b = *(const bf16x8*)(qs + (16 * it + l15) * QP + 32 * kk + 8 * quad);
          sc = mfma16(a, b, sc);
        }
        const int ii = 16 * it + l15;
#pragma unroll
        for (int j = 0; j < 4; ++j) {
          const int s = 16 * st + 4 * quad + j;
          const bool keep = dir ? (s >= ii) : (s <= ii);
          if (!keep) sc[j] = 0.f;
        }
        u32x2 o; o[0] = pk2(sc[0], sc[1]); o[1] = pk2(sc[2], sc[3]);
        *(u32x2*)(ps + ii * PP + 16 * st + 4 * quad) = o;
      }
      __syncthreads();
    }
    f32x4 o[4][2];
    if (MODE != 0) {
      bf16x8 vf[2][2];
#pragma unroll
      for (int et = 0; et < 2; ++et)
#pragma unroll
        for (int kk = 0; kk < 2; ++kk) vf[et][kk] = frag_tr(vs, VP, 32 * kk, 32 * w + 16 * et, lane);
#pragma unroll
      for (int it = 0; it < 4; ++it)
#pragma unroll
        for (int et = 0; et < 2; ++et) o[it][et] = (f32x4){0.f, 0.f, 0.f, 0.f};
#pragma unroll
      for (int it = 0; it < 4; ++it)
#pragma unroll
        for (int kk = 0; kk < 2; ++kk) {
          const bf16x8 pb = *(const bf16x8*)(ps + (16 * it + l15) * PP + 32 * kk + 8 * quad);
#pragma unroll
          for (int et = 0; et < 2; ++et) o[it][et] = mfma16(vf[et][kk], pb, o[it][et]);
        }
#pragma unroll
      for (int m = 0; m < 4; ++m) {
        bf16x8 sf[2];
#pragma unroll
        for (int et = 0; et < 2; ++et) sf[et] = pack8(S[2 * m][et], S[2 * m + 1][et]);
#pragma unroll
        for (int it = 0; it < 4; ++it) {
          const bf16_t* qp = qs + (16 * it + l15) * QP + 32 * m + 4 * quad;
          const s16x4 q0 = *(const s16x4*)qp, q1 = *(const s16x4*)(qp + 16);
          bf16x8 qb; qb[0] = q0[0]; qb[1] = q0[1]; qb[2] = q0[2]; qb[3] = q0[3]; qb[4] = q1[0]; qb[5] = q1[1]; qb[6] = q1[2]; qb[7] = q1[3];
#pragma unroll
          for (int et = 0; et < 2; ++et) o[it][et] = mfma16(sf[et], qb, o[it][et]);
        }
      }
    }
    if (MODE == 1) {
#pragma unroll
      for (int it = 0; it < 4; ++it)
#pragma unroll
        for (int et = 0; et < 2; ++et) {
          u32x2 ov; ov[0] = pk2(o[it][et][0], o[it][et][1]); ov[1] = pk2(o[it][et][2], o[it][et][3]);
          *(u32x2*)((char*)ofb + (eoff + (unsigned)(it * 32768 + et * 32))) = ov;
        }
    }
    if (MODE == 2) {
#pragma unroll
      for (int it = 0; it < 4; ++it)
#pragma unroll
        for (int et = 0; et < 2; ++et)
          pz[it][et] = *(const u32x2*)(sb_ptr((const char*)WSP(bf16_t, O_PROJ) + (size_t)row0 * 6144 + 4096 + hd * 512) + (zoff + (unsigned)(it * 16 * 6144 + et * 32)));
#pragma unroll
      for (int et = 0; et < 2; ++et) ghv[et] = *(const f32x4*)(p.a_g_head + (size_t)(jl * 4 + hd) * 256 + 32 * w + 16 * et + 4 * quad);
#pragma unroll
      for (int it = 0; it < 4; ++it) {
        float s = 0.f;
#pragma unroll
        for (int et = 0; et < 2; ++et) {
          const u32x2 pv = pof[it][et];
          o[it][et][0] += bflo(pv[0]); o[it][et][1] += bfhi(pv[0]); o[it][et][2] += bflo(pv[1]); o[it][et][3] += bfhi(pv[1]);
#pragma unroll
          for (int j = 0; j < 4; ++j) s += o[it][et][j] * o[it][et][j];
        }
        s += __shfl_xor(s, 16); s += __shfl_xor(s, 32);
        if (quad == 0) red[(16 * it + l15) * 8 + w] = s;
      }
      __syncthreads();
#pragma unroll
      for (int it = 0; it < 4; ++it) {
        const f32x4 r0 = *(const f32x4*)(red + (16 * it + l15) * 8), r1 = *(const f32x4*)(red + (16 * it + l15) * 8 + 4);
        const float tot2 = (r0[0] + r0[1]) + (r0[2] + r0[3]) + (r1[0] + r1[1]) + (r1[2] + r1[3]);
        const float rn = rsqrtf(tot2 * (1.0f / 256.0f) + EPS);
        const size_t row = (size_t)(row0 + 16 * it + l15);
#pragma unroll
        for (int et = 0; et < 2; ++et) {
          const int e = 32 * w + 16 * et + 4 * quad;
          const f32x4 gh = ghv[et];
          const u32x2 zv = pz[it][et];
          const float z0 = bflo(zv[0]), z1 = bfhi(zv[0]), z2 = bflo(zv[1]), z3 = bfhi(zv[1]);
          const float v0 = o[it][et][0] * rn * gh[0] * silu_f(z0), v1 = o[it][et][1] * rn * gh[1] * silu_f(z1);
          const float v2 = o[it][et][2] * rn * gh[2] * silu_f(z2), v3 = o[it][et][3] * rn * gh[3] * silu_f(z3);
          u32x2 ov; ov[0] = pk2(v0, v1); ov[1] = pk2(v2, v3);
          *(u32x2*)(sb_ptr((char*)WSP(bf16_t, O_OG) + (size_t)row0 * 2048 + hd * 512) + (eoff + (unsigned)(it * 32768 + et * 32))) = ov;
        }
      }
    }
    bf16x8 vf2[2][2];
#pragma unroll
    for (int et = 0; et < 2; ++et)
#pragma unroll
      for (int kk = 0; kk < 2; ++kk) vf2[et][kk] = frag_tr(vs, VP, 32 * kk, 32 * w + 16 * et, lane);
#pragma unroll
    for (int dt = 0; dt < 8; ++dt) {
#pragma unroll
      for (int kk = 0; kk < 2; ++kk) {
        const bf16x8 ka = frag_tr(ks_, QP, 32 * kk, 16 * dt, lane);
#pragma unroll
        for (int et = 0; et < 2; ++et) S[dt][et] = mfma16(ka, vf2[et][kk], S[dt][et]);
      }
    }
#pragma unroll
    for (int dt = 0; dt < 8; ++dt) {
      const f32x4 bl = *(const f32x4*)(blv + (ci & 1) * 128 + 16 * dt + 4 * quad);
      f32x4 sc; sc[0] = __expf(bl[0]); sc[1] = __expf(bl[1]); sc[2] = __expf(bl[2]); sc[3] = __expf(bl[3]);
#pragma unroll
      for (int et = 0; et < 2; ++et) S[dt][et] = S[dt][et] * sc;
    }
  }
}

#undef GLA_ISSUE
#undef GLA_ISSUE_G1
__device__ __forceinline__ void gla_p1(const Params& p, int jl, int ctx_out, char* lds) {
  const int tid = threadIdx.x;
  for (int item = blockIdx.x; item < 512; item += gridDim.x) {
    const int u = item & 15, rec = item >> 4;
    const int dir = rec & 1, hd = (rec >> 1) & 3, b = rec >> 3;
    f32x4 S[8][2];
#pragma unroll
    for (int i = 0; i < 8; ++i) { S[i][0] = (f32x4){0.f, 0.f, 0.f, 0.f}; S[i][1] = (f32x4){0.f, 0.f, 0.f, 0.f}; }
    float logD = 0.f;
    int row_first, step, nch;
    if (u == 0) { nch = 4; row_first = ML + b * 256 + (dir ? 192 : 0); step = dir ? -64 : 64; }
    else { const int pp = u - 1; const int ts = dir ? 15 - pp : pp; nch = 8; row_first = b * 8192 + ts * 512 + (dir ? 448 : 0); step = dir ? -64 : 64; }
    gla_run<0>(p, jl, hd, dir, row_first, step, nch, S, logD, lds);
    f32x4* E = (f32x4*)WSP(float, O_SEG_E) + (size_t)item * 16 * 512;
#pragma unroll
    for (int dt = 0; dt < 8; ++dt)
#pragma unroll
      for (int et = 0; et < 2; ++et) E[(dt * 2 + et) * 512 + tid] = S[dt][et];
    if (tid < 128) WSP(float, O_SEG_D)[(size_t)item * 128 + tid] = __expf(logD);
    if (ctx_out && u == 0) {
      const int pi = rec >> 1, want = (pi < 8) ? (pi & 1) : 1 - (pi & 1);
      if (dir == want) {
#pragma unroll
        for (int i = 0; i < 8; ++i) { S[i][0] = (f32x4){0.f, 0.f, 0.f, 0.f}; S[i][1] = (f32x4){0.f, 0.f, 0.f, 0.f}; }
        float dummy = 0.f;
        gla_run<1>(p, jl, hd, 0, ML + b * 256, 64, 4, S, dummy, lds);
      }
    }
  }
}

__device__ __forceinline__ void gla_scan_phase(const Params& p, int jl, int ctx_out, char* lds) {
  const int tid = threadIdx.x;
  const int nskip = ctx_out ? 16 : 0;
  if ((int)blockIdx.x < nskip) {
    const int hd = blockIdx.x & 3, b = blockIdx.x >> 2;
    f32x4 S[8][2];
#pragma unroll
    for (int i = 0; i < 8; ++i) { S[i][0] = (f32x4){0.f, 0.f, 0.f, 0.f}; S[i][1] = (f32x4){0.f, 0.f, 0.f, 0.f}; }
    float dummy = 0.f;
    gla_run<2>(p, jl, hd, 1, ML + b * 256 + 192, -64, 4, S, dummy, lds);
    return;
  }
  f32x4* Eall = (f32x4*)WSP(float, O_SEG_E);
  const float* Dall = WSP(float, O_SEG_D);
  for (int slot = ((int)blockIdx.x - nskip) * NTHR + tid; slot < 32 * 8192; slot += ((int)gridDim.x - nskip) * NTHR) {
    const int rec = slot >> 13, q = slot & 8191;
    const int dt = (q >> 9) >> 1, quad = ((q & 511) & 63) >> 4;
    f32x4* E = Eall + (size_t)(rec * 16) * 8192 + q;
    const float* D = Dall + (size_t)(rec * 16) * 128 + 16 * dt + 4 * quad;
    f32x4 ev[16];
#pragma unroll
    for (int u = 0; u < 16; ++u) ev[u] = E[(size_t)u * 8192];
    f32x4 S = ev[0];
#pragma unroll
    for (int u = 1; u < 16; ++u) {
      const f32x4 dv = *(const f32x4*)(D + (size_t)u * 128);
      S = S * dv + ev[u];
      E[(size_t)u * 8192] = S;
    }
  }
}

__device__ __forceinline__ void gla_fold(const Params& p, int rec, int upto, f32x4 (&S)[8][2]) {
  const int tid = threadIdx.x;
  if (upto < 0) {
#pragma unroll
    for (int dt = 0; dt < 8; ++dt) { S[dt][0] = (f32x4){0.f, 0.f, 0.f, 0.f}; S[dt][1] = (f32x4){0.f, 0.f, 0.f, 0.f}; }
    return;
  }
  const f32x4* E = (const f32x4*)WSP(float, O_SEG_E) + (size_t)(rec * 16 + upto) * 16 * 512;
#pragma unroll
  for (int dt = 0; dt < 8; ++dt)
#pragma unroll
    for (int et = 0; et < 2; ++et) S[dt][et] = E[(dt * 2 + et) * 512 + tid];
}

__device__ __forceinline__ void gla_p2(const Params& p, int jl, int ctx_out, char* lds) {
  const int nitems = 256 + (ctx_out ? 16 : 0);
  for (int item0 = blockIdx.x; item0 < nitems; item0 += gridDim.x) {
    int item = item0;
    bool is_ctx = false;
    if (ctx_out) { if (item0 < 16) is_ctx = true; else item = item0 - 16; }
    int hd, b, ts, nch, nch1, rf0, rf1;
    if (is_ctx) { hd = item & 3; b = item >> 2; ts = 0; nch = 4; nch1 = 0; rf0 = ML + b * 256; rf1 = rf0 + 192; }
    else { ts = item & 15; hd = (item >> 4) & 3; b = item >> 6; nch = 8; nch1 = 8; rf0 = b * 8192 + ts * 512; rf1 = rf0 + 448; }
    const int rec0 = (b * 4 + hd) * 2;
    f32x4 S[8][2];
    float logD = 0.f;
    gla_fold(p, rec0, is_ctx ? -1 : ts, S);
    gla_run<1>(p, jl, hd, 0, rf0, 64, nch1, S, logD, lds);
    gla_fold(p, rec0 + 1, is_ctx ? -1 : 15 - ts, S);
    gla_run<2>(p, jl, hd, 1, rf1, -64, nch, S, logD, lds);
  }
}

constexpr int KP = 72;
constexpr float QSC = 0.125f * 1.4426950408889634f;
__device__ __forceinline__ void attn_phase(const Params& p, int ctx_out, char* lds) {
  const int tid = threadIdx.x, lane = tid & 63, w = tid >> 6, l15 = lane & 15, quad = lane >> 4;
  bf16_t* KVb = (bf16_t*)lds;
  const int nitems = 4096 + (ctx_out ? 128 : 0);
  for (int item = blockIdx.x; item < nitems; item += gridDim.x) {
    int b, h, qrow0, nblk, tix0;
    if (item < 4096) {
      nblk = item & 63; h = (item >> 6) & 15; b = item >> 10;
      qrow0 = b * 8192 + nblk * 128; tix0 = 0;
    } else {
      const int it = item - 4096; const int cb = it & 1; h = (it >> 1) & 15; b = it >> 5;
      qrow0 = ML + b * 256 + cb * 128; nblk = 1; tix0 = 3;
    }
    const int hk = h >> 2;
    const int ii = 16 * w + l15;
    const size_t qrow = (size_t)(qrow0 + ii);
    bf16x8 qf[2];
#pragma unroll
    for (int kk = 0; kk < 2; ++kk) {
      const u32x4 u = *(const u32x4*)(WSP(bf16_t, O_PROJ) + qrow * 2560 + h * 64 + 32 * kk + 8 * quad);
      union { bf16x8 v; unsigned uu[4]; } r;
#pragma unroll
      for (int e = 0; e < 4; ++e) r.uu[e] = pk2(bflo(u[e]) * QSC, bfhi(u[e]) * QSC);
      qf[kk] = r.v;
    }
    float m_run = p.b_sink[h] * 1.4426950408889634f;
    float l_part = (quad == 0) ? 1.f : 0.f;
    f32x4 O[4];
#pragma unroll
    for (int d = 0; d < 4; ++d) O[d] = (f32x4){0.f, 0.f, 0.f, 0.f};
    u32x4 pk0, pk1, pv0, pv1;
#define ATT_ISSUE(tix_) { const int kr_ = ((tix_) < 3) ? b * 8192 + (nblk - 1 + (tix_)) * 128 : ML + b * 256 + ((tix_) - 3) * 128; \
      const bf16_t* src_ = WSP(bf16_t, O_PROJ) + (size_t)(kr_ + (tid >> 3)) * 2560 + 1024 + hk * 64 + (tid & 7) * 8; \
      pk0 = *(const u32x4*)src_; pv0 = *(const u32x4*)(src_ + 256); pk1 = *(const u32x4*)(src_ + (size_t)64 * 2560); pv1 = *(const u32x4*)(src_ + (size_t)64 * 2560 + 256); }
#define ATT_TILE(KS_, VS_, MODE_, KLO_, KHI_) { \
      f32x4 sc[8]; float mx = -INFINITY; \
      const int mlo = ((MODE_) == 1) ? ii : -100000, mhi = ((MODE_) == 2) ? ii : 100000; \
      _Pragma("unroll") for (int kt = 0; kt < 8; ++kt) { \
        if (kt >= (KLO_) && kt <= (KHI_)) { \
          f32x4 s_ = {0.f, 0.f, 0.f, 0.f}; \
          _Pragma("unroll") for (int kk = 0; kk < 2; ++kk) { \
            const bf16x8 a_ = *(const bf16x8*)((KS_) + (16 * kt + l15) * KP + 32 * kk + 8 * quad); \
            s_ = mfma16(a_, qf[kk], s_); } \
          if ((MODE_) != 0 && kt == w) { \
            _Pragma("unroll") for (int j = 0; j < 4; ++j) { \
              const int kkey = 16 * kt + 4 * quad + j; \
              const int dneg = min(kkey - mlo, 0) + min(mhi - kkey, 0); \
              s_[j] += (float)dneg * 1e30f; } } \
          mx = fmaxf(mx, fmaxf(fmaxf(s_[0], s_[1]), fmaxf(s_[2], s_[3]))); \
          sc[kt] = s_; \
        } else sc[kt] = (f32x4){0.f, 0.f, 0.f, 0.f}; } \
      mx = fmaxf(mx, __shfl_xor(mx, 16)); mx = fmaxf(mx, __shfl_xor(mx, 32)); \
      const float m_new = fmaxf(m_run, mx); \
      const float alpha = __builtin_amdgcn_exp2f(m_run - m_new); \
      m_run = m_new; l_part *= alpha; \
      _Pragma("unroll") for (int d = 0; d < 4; ++d) O[d] = O[d] * alpha; \
      _Pragma("unroll") for (int kt = 0; kt < 8; ++kt) { \
        if (kt >= (KLO_) && kt <= (KHI_)) { \
          _Pragma("unroll") for (int j = 0; j < 4; ++j) { const float e_ = __builtin_amdgcn_exp2f(sc[kt][j] - m_new); sc[kt][j] = e_; l_part += e_; } } } \
      _Pragma("unroll") for (int kp = 0; kp < 4; ++kp) { \
        if (2 * kp + 1 >= (KLO_) && 2 * kp <= (KHI_)) { \
          const bf16x8 pb = pack8(sc[2 * kp], sc[2 * kp + 1]); \
          _Pragma("unroll") for (int d = 0; d < 4; ++d) { \
            const int q_ = (lane & 15) >> 2, pp_ = lane & 3; \
            const bf16_t* a0 = (VS_) + (32 * kp + 4 * quad + q_) * KP + 16 * d + 4 * pp_; \
            const s16x4 r0 = tr_read(a0), r1 = tr_read(a0 + 16 * KP); \
            bf16x8 va; va[0] = r0[0]; va[1] = r0[1]; va[2] = r0[2]; va[3] = r0[3]; va[4] = r1[0]; va[5] = r1[1]; va[6] = r1[2]; va[7] = r1[3]; \
            O[d] = mfma16(va, pb, O[d]); } } } }
#define ATT_WRITE(KS_, VS_) { const int r_ = tid >> 3, ch_ = tid & 7; \
      *(u32x4*)((KS_) + r_ * KP + ch_ * 8) = pk0; *(u32x4*)((VS_) + r_ * KP + ch_ * 8) = pv0; \
      *(u32x4*)((KS_) + (r_ + 64) * KP + ch_ * 8) = pk1; *(u32x4*)((VS_) + (r_ + 64) * KP + ch_ * 8) = pv1; }
    bf16_t* const K0 = KVb; bf16_t* const V0 = KVb + 128 * KP; bf16_t* const K1 = KVb + 256 * KP; bf16_t* const V1 = K1 + 128 * KP;
    const bool paired = (tix0 == 0 && nblk > 0 && nblk < 63);
    int tix = (tix0 == 0 && nblk == 0) ? 1 : tix0;
    int par = 0;
    __syncthreads();
    if (paired) {
      ATT_ISSUE(0)
      ATT_WRITE(K0, V0)
      ATT_ISSUE(2)
      ATT_WRITE(K1, V1)
      __syncthreads();
      ATT_ISSUE(1)
      ATT_TILE(K0, V0, 1, w, 7)
      ATT_TILE(K1, V1, 2, 0, w)
      __syncthreads();
      tix = 1;
    } else {
      ATT_ISSUE(tix)
    }
#pragma unroll 1
    while (tix < 5) {
      int nx = tix + 1;
      if (nx == 2 && (nblk == 63 || paired)) nx = 3;
      const int mode = tix == 0 ? 1 : (tix == 2 ? 2 : 0);
      bf16_t* Ks = par ? K1 : K0; bf16_t* Vs = par ? V1 : V0; par ^= 1;
      ATT_WRITE(Ks, Vs)
      __syncthreads();
      if (nx < 5) ATT_ISSUE(nx)
      const int klo = (mode == 1) ? w : 0, khi = (mode == 2) ? w : 7;
      ATT_TILE(Ks, Vs, mode, klo, khi)
      tix = nx;
    }
#undef ATT_TILE
#undef ATT_WRITE
#undef ATT_ISSUE
    float l_tot = l_part; l_tot += __shfl_xor(l_tot, 16); l_tot += __shfl_xor(l_tot, 32);
    const float inv = 1.0f / l_tot;
#pragma unroll
    for (int d = 0; d < 4; ++d) {
      const int dd = 16 * d + 4 * quad;
      const u32x2 zv = *(const u32x2*)(WSP(bf16_t, O_PROJ) + qrow * 2560 + 1536 + h * 64 + dd);
      const float v0 = O[d][0] * inv * silu_f(bflo(zv[0])), v1 = O[d][1] * inv * silu_f(bfhi(zv[0]));
      const float v2 = O[d][2] * inv * silu_f(bflo(zv[1])), v3 = O[d][3] * inv * silu_f(bfhi(zv[1]));
      u32x2 ov; ov[0] = pk2(v0, v1); ov[1] = pk2(v2, v3);
      *(u32x2*)(WSP(bf16_t, O_OG) + qrow * 1024 + h * 64 + dd) = ov;
    }
  }
}

constexpr int R_CW = 0, R_UCF = 4096, R_UCS = 37888, R_US = 55296, R_HS = 126016;
constexpr int UFP = 132, USP = 136;
__device__ __forceinline__ int rho_row(int t) { return 16 * ((t >> 2) & 3) + 4 * (t >> 4) + (t & 3); }

template <bool REV, bool WANT_H>
__device__ __forceinline__ float scan16(float (&a)[4][4], float (&x)[4][4], float cin, int l15, int quad, float& A_tile) {
  float A = 1.f, H = 0.f;
#pragma unroll
  for (int mm = 0; mm < 4; ++mm)
#pragma unroll
    for (int jj = 0; jj < 4; ++jj) {
      const int mi = REV ? 3 - mm : mm, j = REV ? 3 - jj : jj;
      H = a[mi][j] * H + x[mi][j]; A *= a[mi][j];
    }
  const float A0 = __shfl(A, l15), A1 = __shfl(A, l15 + 16), A2 = __shfl(A, l15 + 32), A3 = __shfl(A, l15 + 48);
  const float H0 = __shfl(H, l15), H1 = __shfl(H, l15 + 16), H2 = __shfl(H, l15 + 32), H3 = __shfl(H, l15 + 48);
  A_tile = (A0 * A1) * (A2 * A3);
  float cc = cin, cl = cin;
  if (!REV) {
    if (quad == 0) cl = cc; cc = A0 * cc + H0;
    if (quad == 1) cl = cc; cc = A1 * cc + H1;
    if (quad == 2) cl = cc; cc = A2 * cc + H2;
    if (quad == 3) cl = cc; cc = A3 * cc + H3;
  } else {
    if (quad == 3) cl = cc; cc = A3 * cc + H3;
    if (quad == 2) cl = cc; cc = A2 * cc + H2;
    if (quad == 1) cl = cc; cc = A1 * cc + H1;
    if (quad == 0) cl = cc; cc = A0 * cc + H0;
  }
  if (WANT_H) {
    float h = cl;
#pragma unroll
    for (int mm = 0; mm < 4; ++mm)
#pragma unroll
      for (int jj = 0; jj < 4; ++jj) {
        const int mi = REV ? 3 - mm : mm, j = REV ? 3 - jj : jj;
        h = a[mi][j] * h + x[mi][j]; x[mi][j] = h;
      }
  }
  return cc;
}

template <int PASS>
__device__ __forceinline__ void rglru_phase(const Params& p, char* lds) {
  const int tid = threadIdx.x, lane = tid & 63, w = tid >> 6, l15 = lane & 15, quad = lane >> 4;
  float* cw = (float*)(lds + R_CW); float* ucf = (float*)(lds + R_UCF); bf16_t* ucs = (bf16_t*)(lds + R_UCS); bf16_t* us = (bf16_t*)(lds + R_US);
  const int tg_lo = (int)(((long long)blockIdx.x * 5280) / gridDim.x), tg_hi = (int)(((long long)(blockIdx.x + 1) * 5280) / gridDim.x);
  const int it_lo = tg_lo >> 2, it_hi = (tg_hi + 3) >> 2;
  const int cl = 16 * w + l15;
  bf16x8 wf[4][4];
  float bra[2], bri[2], sp[2];
  int cur_hd = -1;
  for (int item = it_lo; item < it_hi; ++item) {
    const int hd = item / 132, rem = item % 132, b = rem / 33, grp = rem % 33;
    const int ch = hd * 128 + cl;
    int idx0, row_base, seq_lo, seq_hi;
    if (grp == 0) { idx0 = 0; row_base = ML + b * 256; seq_lo = row_base; seq_hi = seq_lo + 256; }
    else { idx0 = 4 + 4 * (grp - 1); row_base = b * 8192 + 256 * (grp - 1); seq_lo = b * 8192; seq_hi = seq_lo + 8192; }
    __syncthreads();
    for (int c = tid; c < 259 * 16; c += NTHR) {
      const int r = c >> 4, c8 = (c & 15) * 8;
      const int grow = row_base - 2 + r;
      u32x4 v = {0u, 0u, 0u, 0u};
      if (grow >= seq_lo && grow < seq_hi) v = *(const u32x4*)(WSP(bf16_t, O_PROJ) + (size_t)grow * 2560 + hd * 128 + c8);
      *(u32x4*)(us + r * USP + c8) = v;
    }
    if (hd != cur_hd) {
      cur_hd = hd;
#pragma unroll
      for (int g4 = 0; g4 < 4; ++g4) {
        const int gt = g4 & 1, d = g4 >> 1;
        const bf16_t* wp = WSP(bf16_t, O_WT_GATE) + ((size_t)((gt * 2 + d) * 10 + hd) * 128 + cl) * 128 + 8 * quad;
#pragma unroll
        for (int kk = 0; kk < 4; ++kk) wf[g4][kk] = *(const bf16x8*)(wp + 32 * kk);
      }
#pragma unroll
      for (int d = 0; d < 2; ++d) {
        bra[d] = -1.4426950408889634f * p.c_b_ra[d * 1280 + ch]; bri[d] = -1.4426950408889634f * p.c_b_ri[d * 1280 + ch];
        const float nl = -p.c_lam[d * 1280 + ch];
        sp[d] = (-8.0f * 1.4426950408889634f) * (fmaxf(nl, 0.f) + log1pf(expf(-fabsf(nl))));
      }
      for (int i = tid; i < 640; i += NTHR) {
        const int r = i >> 7, cc = i & 127;
        cw[i] = (r < 4) ? p.c_conv_w[r * 1280 + hd * 128 + cc] : p.c_conv_b[hd * 128 + cc];
      }
    }
    __syncthreads();
    const int tl0 = max(tg_lo - 4 * item, 0), tl1 = min(tg_hi - 4 * item, 4);
    for (int tile = tl0; tile < tl1; ++tile) {
      const int idx = idx0 + tile, row0 = row_base + 64 * tile;
      const int tt = tid >> 3, c0 = (tid & 7) * 16;
      float cin0 = 0.f, cin1 = 0.f; u32x4 z0 = {0u, 0u, 0u, 0u}, z1 = {0u, 0u, 0u, 0u};
      if (PASS == 2) {
        cin0 = WSP(float, O_CI)[((size_t)((0 * 4 + b) * 132 + idx)) * 1280 + ch];
        cin1 = WSP(float, O_CI)[((size_t)((1 * 4 + b) * 132 + idx)) * 1280 + ch];
        const bf16_t* zp = WSP(bf16_t, O_PROJ) + (size_t)(row0 + tt) * 2560 + 1280 + hd * 128 + c0;
        z0 = *(const u32x4*)zp; z1 = *(const u32x4*)(zp + 8);
      }
      {
        float accv[16];
#pragma unroll
        for (int e = 0; e < 4; ++e) { const f32x4 bv = *(const f32x4*)(cw + 512 + c0 + 4 * e); accv[4 * e] = bv[0]; accv[4 * e + 1] = bv[1]; accv[4 * e + 2] = bv[2]; accv[4 * e + 3] = bv[3]; }
#pragma unroll
        for (int j4 = 0; j4 < 4; ++j4) {
          const bf16_t* up = us + (64 * tile + tt + j4) * USP + c0;
          const u32x4 u0 = *(const u32x4*)up, u1 = *(const u32x4*)(up + 8);
          float wv[16];
#pragma unroll
          for (int e = 0; e < 4; ++e) { const f32x4 t4 = *(const f32x4*)(cw + j4 * 128 + c0 + 4 * e); wv[4 * e] = t4[0]; wv[4 * e + 1] = t4[1]; wv[4 * e + 2] = t4[2]; wv[4 * e + 3] = t4[3]; }
#pragma unroll
          for (int e = 0; e < 4; ++e) {
            accv[2 * e] += bflo(u0[e]) * wv[2 * e]; accv[2 * e + 1] += bfhi(u0[e]) * wv[2 * e + 1];
            accv[8 + 2 * e] += bflo(u1[e]) * wv[8 + 2 * e]; accv[8 + 2 * e + 1] += bfhi(u1[e]) * wv[8 + 2 * e + 1];
          }
        }
        const int rr = rho_row(tt);
#pragma unroll
        for (int e = 0; e < 4; ++e) *(f32x4*)(ucf + rr * UFP + c0 + 4 * e) = (f32x4){accv[4 * e], accv[4 * e + 1], accv[4 * e + 2], accv[4 * e + 3]};
        u32x4 o0, o1;
#pragma unroll
        for (int e = 0; e < 4; ++e) { o0[e] = pk2(accv[2 * e], accv[2 * e + 1]); o1[e] = pk2(accv[8 + 2 * e], accv[8 + 2 * e + 1]); }
        *(u32x4*)(ucs + rr * USP + c0) = o0; *(u32x4*)(ucs + rr * USP + c0 + 8) = o1;
      }
      __syncthreads();
      f32x4 acc[4][4];
#pragma unroll
      for (int mi = 0; mi < 4; ++mi)
#pragma unroll
        for (int g4 = 0; g4 < 4; ++g4) acc[mi][g4] = (f32x4){0.f, 0.f, 0.f, 0.f};
#pragma unroll
      for (int kk = 0; kk < 4; ++kk)
#pragma unroll
        for (int mi = 0; mi < 4; ++mi) {
          const bf16x8 af = *(const bf16x8*)(ucs + (16 * mi + l15) * USP + 32 * kk + 8 * quad);
#pragma unroll
          for (int g4 = 0; g4 < 4; ++g4) acc[mi][g4] = mfma16(af, wf[g4][kk], acc[mi][g4]);
        }
      float ucv[4][4];
#pragma unroll
      for (int mi = 0; mi < 4; ++mi)
#pragma unroll
        for (int j = 0; j < 4; ++j) ucv[mi][j] = ucf[(16 * mi + 4 * quad + j) * UFP + cl];
      float hsum[4][4];
#pragma unroll
      for (int d = 0; d < 2; ++d) {
        float av[4][4], xv[4][4];
#pragma unroll
        for (int mi = 0; mi < 4; ++mi)
#pragma unroll
          for (int j = 0; j < 4; ++j) {
            const float rg = __builtin_amdgcn_rcpf(1.0f + __builtin_amdgcn_exp2f(acc[mi][2 * d][j] + bra[d]));
            const float ig = __builtin_amdgcn_rcpf(1.0f + __builtin_amdgcn_exp2f(acc[mi][2 * d + 1][j] + bri[d]));
            const float aa = __builtin_amdgcn_exp2f(rg * sp[d]);
            av[mi][j] = aa;
            xv[mi][j] = __builtin_amdgcn_sqrtf(fmaxf(1.0f - aa * aa, 0.f)) * ig * ucv[mi][j];
          }
        float at;
        if (PASS == 1) {
          const float hend = d ? scan16<true, false>(av, xv, 0.f, l15, quad, at) : scan16<false, false>(av, xv, 0.f, l15, quad, at);
          const size_t tci = ((size_t)((d * 4 + b) * 132 + idx)) * 1280 + ch;
          if (quad == 0) *(f32x2*)(WSP(float, O_TC) + tci * 2) = (f32x2){at, hend};
        } else {
          if (d) scan16<true, true>(av, xv, cin1, l15, quad, at); else scan16<false, true>(av, xv, cin0, l15, quad, at);
#pragma unroll
          for (int mi = 0; mi < 4; ++mi)
#pragma unroll
            for (int j = 0; j < 4; ++j) hsum[mi][j] = d ? hsum[mi][j] + xv[mi][j] : xv[mi][j];
        }
      }
      if (PASS == 1) __syncthreads();
      if (PASS == 2) {
        float* hsb = (float*)(lds + R_HS);
#pragma unroll
        for (int mi = 0; mi < 4; ++mi)
#pragma unroll
          for (int j = 0; j < 4; ++j) hsb[(16 * mi + 4 * quad + j) * UFP + cl] = hsum[mi][j];
        __syncthreads();
        const size_t row = (size_t)(row0 + tt);
        const int rr = rho_row(tt);
        float hv[16];
#pragma unroll
        for (int e = 0; e < 4; ++e) { const f32x4 t4 = *(const f32x4*)(hsb + rr * UFP + c0 + 4 * e); hv[4 * e] = t4[0]; hv[4 * e + 1] = t4[1]; hv[4 * e + 2] = t4[2]; hv[4 * e + 3] = t4[3]; }
        u32x4 o0, o1;
#pragma unroll
        for (int e = 0; e < 4; ++e) {
          o0[e] = pk2(hv[2 * e] * silu_f(bflo(z0[e])), hv[2 * e + 1] * silu_f(bfhi(z0[e])));
          o1[e] = pk2(hv[8 + 2 * e] * silu_f(bflo(z1[e])), hv[8 + 2 * e + 1] * silu_f(bfhi(z1[e])));
        }
        *(u32x4*)(WSP(bf16_t, O_OG) + row * 1280 + hd * 128 + c0) = o0; *(u32x4*)(WSP(bf16_t, O_OG) + row * 1280 + hd * 128 + c0 + 8) = o1;
      }
    }
  }
}

__device__ __forceinline__ void rglru_scan_phase(const Params& p, char* lds) {
  const int tid = threadIdx.x;
  f32x2* L = (f32x2*)lds;
  float* Cc = (float*)(lds + 132 * 40 * 8);
  for (int blk = blockIdx.x; blk < 256; blk += gridDim.x) {
    const int dir = blk >> 7, b = (blk & 127) >> 5, ch0 = (blk & 31) * 40;
    const size_t base = (size_t)((dir * 4 + b) * 132) * 1280 + ch0;
    __syncthreads();
    for (int e = tid; e < 132 * 40; e += NTHR) {
      const int idx = e / 40, cc = e % 40;
      L[e] = *(const f32x2*)(WSP(float, O_TC) + (base + (size_t)idx * 1280 + cc) * 2);
    }
    __syncthreads();
    if (tid < 40) {
      float carry = 0.f;
      for (int s = 0; s < 132; ++s) {
        int idx;
        if (dir == 0) idx = s; else idx = (s < 4) ? 3 - s : 135 - s;
        const f32x2 v = L[idx * 40 + tid];
        Cc[idx * 40 + tid] = carry;
        carry = v[0] * carry + v[1];
      }
    }
    __syncthreads();
    for (int e = tid; e < 132 * 40; e += NTHR) {
      const int idx = e / 40, cc = e % 40;
      WSP(float, O_CI)[base + (size_t)idx * 1280 + cc] = Cc[e];
    }
  }
}

#define XB_TMO      128
#define XB_XCNT(j)  (256  + 64 * (j))
#define XB_XSUB(j)  (1280 + 64 * (j))
#define XB_XGEN(j)  (2304 + 64 * (j))
#define XB_TOP      3328
#define XB_TOPGEN   3392
#define XCD_BAR_WORDS 3456
#define XB_SPIN_CAP (1u << 18)
#define LAS __attribute__((address_space(3)))

__device__ __forceinline__ unsigned xb_ld(unsigned* p)              { return __hip_atomic_load(p, __ATOMIC_RELAXED, __HIP_MEMORY_SCOPE_AGENT); }
__device__ __forceinline__ unsigned xb_add(unsigned* p, unsigned v) { return __hip_atomic_fetch_add(p, v, __ATOMIC_RELAXED, __HIP_MEMORY_SCOPE_AGENT); }
__device__ __forceinline__ unsigned xb_xcc_id() { return (unsigned)__builtin_amdgcn_s_getreg((3 << 11) | 20) & 0xFu; }
#define XB_SPIN(cond, bar) do { unsigned _sp = 0; while (cond) { __builtin_amdgcn_s_sleep(1); \
    if ((++_sp & 255u) == 0u) { if (xb_ld(&(bar)[XB_TMO])) break; if (_sp > XB_SPIN_CAP) { atomicAdd(&(bar)[XB_TMO], 1u); break; } } } } while (0)

struct XcdBarrier {
    unsigned* bar; unsigned x;
    volatile LAS unsigned* st;
};

__device__ __forceinline__ XcdBarrier xcd_barrier_post(unsigned* bar, volatile LAS unsigned* st) {
    XcdBarrier b; b.bar = bar; b.x = xb_xcc_id(); b.st = st;
    if (threadIdx.x == 0) (void)xb_add(&bar[XB_XCNT(b.x)], 1u);
    return b;
}
__device__ __forceinline__ void xcd_barrier_complete(unsigned* bar, unsigned x, unsigned& nloc, unsigned& nx) {
    const unsigned G = gridDim.x * gridDim.y * gridDim.z;
    unsigned sum, cnt, mine, sp = 0u;
    for (;;) {
        sum = 0u; cnt = 0u; mine = 0u;
#pragma unroll
        for (unsigned j = 0; j < 16; ++j) { const unsigned c = xb_ld(&bar[XB_XCNT(j)]); sum += c; cnt += (c > 0u) ? 1u : 0u; mine = (j == x) ? c : mine; }
        if (sum == G) break;
        __builtin_amdgcn_s_sleep(1);
        if ((++sp & 255u) == 0u) { if (xb_ld(&bar[XB_TMO])) break; if (sp > XB_SPIN_CAP) { atomicAdd(&bar[XB_TMO], 1u); break; } }
    }
    nloc = mine > 0u ? mine : 1u; nx = cnt > 0u ? cnt : 1u;
}

__device__ __forceinline__ void xcd_barrier(const XcdBarrier& b) {
    asm volatile("s_waitcnt vmcnt(0)" ::: "memory");
    __syncthreads();
    if (threadIdx.x == 0) {
        unsigned* bar = b.bar;
        __builtin_amdgcn_s_waitcnt(0);
        unsigned nloc = b.st[0], nx = b.st[1];
        if (nloc == 0u) { xcd_barrier_complete(bar, b.x, nloc, nx); b.st[0] = nloc; b.st[1] = nx; }
        const unsigned old = xb_add(&bar[XB_XSUB(b.x)], 1u);
        const unsigned gen = old / nloc;
        if (old + 1u == (gen + 1u) * nloc) {
            __builtin_amdgcn_fence(__ATOMIC_RELEASE, "agent");
            asm volatile("s_waitcnt vmcnt(0)" ::: "memory");
            const unsigned og = xb_add(&bar[XB_TOP], 1u);
            const unsigned tg = og / nx;
            if (og + 1u == (tg + 1u) * nx) xb_add(&bar[XB_TOPGEN], 1u);
            else XB_SPIN(xb_ld(&bar[XB_TOPGEN]) == tg, bar);
            __builtin_amdgcn_fence(__ATOMIC_ACQUIRE, "agent");
            xb_add(&bar[XB_XGEN(b.x)], 1u);
            asm volatile("s_waitcnt vmcnt(0)" ::: "memory");
        } else {
            XB_SPIN(xb_ld(&bar[XB_XGEN(b.x)]) == gen, bar);
            __builtin_amdgcn_fence(__ATOMIC_ACQUIRE, "agent");
            asm volatile("s_waitcnt vmcnt(0)" ::: "memory");
        }
    }
    __syncthreads();
}


__device__ __forceinline__ void post_phase(const Params& p, int layer) {
  post_rows(p, layer, blockIdx.x * 8 + (threadIdx.x >> 6), gridDim.x * 8, (layer == 3) ? ML : MT);
}
__device__ __forceinline__ void post_phase_ctx_overlap(const Params& p, int layer, const bf16_t* og_ctx, const bf16_t* wt, int K, char* lds, int vb) {
  const int tid = threadIdx.x, w = tid >> 6;
  constexpr int NCB = 8;
  if (vb < NCB) {
    pg8::Gemm g{og_ctx, wt, MC, 1024, K};
    GSched S{4, 16, NCB, vb};
    GEpi<0> E{WSP(bf16_t, O_Y) + (size_t)ML * 1024, 1024, WSP(float, O_G1), WSP(float, O_ROPE)};
    pg8::gemm_phase<GEpi<0>, GSched, true, true>((PG8_LAS unsigned char*)lds, g, S, E);
    unsigned* cnt = (unsigned*)(p.ws + O_BAR) + 3584 + 64 * layer;
    asm volatile("s_waitcnt vmcnt(0)" ::: "memory");
    __syncthreads();
    if (tid == 0) {
      __builtin_amdgcn_fence(__ATOMIC_RELEASE, "agent");
      asm volatile("s_waitcnt vmcnt(0)" ::: "memory");
      xb_add(cnt, 1u);
      unsigned spn = 0;
      while (xb_ld(cnt) < (unsigned)NCB) { __builtin_amdgcn_s_sleep(1); if (++spn > (1u << 20)) break; }
      __builtin_amdgcn_fence(__ATOMIC_ACQUIRE, "agent");
      asm volatile("s_waitcnt vmcnt(0)" ::: "memory");
    }
    __syncthreads();
    post_rows(p, layer, ML + vb * 8 + w, NCB * 8, MT);
  } else {
    post_rows(p, layer, (vb - NCB) * 8 + w, (256 - NCB) * 8, ML);
  }
}

template <class T> __device__ __forceinline__ T* uni_ptr(T* v) {
  const unsigned long long u = (unsigned long long)v;
  const unsigned lo = __builtin_amdgcn_readfirstlane((unsigned)u), hi = __builtin_amdgcn_readfirstlane((unsigned)(u >> 32));
  typedef __attribute__((address_space(1))) T GT;
  GT* g = (GT*)(((unsigned long long)hi << 32) | lo);
  return (T*)g;
}
__device__ __forceinline__ Params load_params(const Params& s) {
  Params q;
  q.x = uni_ptr(s.x); q.c = uni_ptr(s.c); q.ctx = uni_ptr(s.ctx); q.c_ctx = uni_ptr(s.c_ctx); q.w_mod = uni_ptr(s.w_mod); q.b_mod = uni_ptr(s.b_mod);
  q.g_pre = uni_ptr(s.g_pre); q.g_post = uni_ptr(s.g_post);
  q.a_w_in = uni_ptr(s.a_w_in); q.a_w_g1 = uni_ptr(s.a_w_g1); q.a_w_g2 = uni_ptr(s.a_w_g2); q.a_b_g = uni_ptr(s.a_b_g); q.a_g_head = uni_ptr(s.a_g_head); q.a_w_out = uni_ptr(s.a_w_out);
  q.b_w_in = uni_ptr(s.b_w_in); q.b_sink = uni_ptr(s.b_sink); q.b_w_out = uni_ptr(s.b_w_out);
  q.c_w_in = uni_ptr(s.c_w_in); q.c_conv_w = uni_ptr(s.c_conv_w); q.c_conv_b = uni_ptr(s.c_conv_b); q.c_w_ra = uni_ptr(s.c_w_ra); q.c_b_ra = uni_ptr(s.c_b_ra);
  q.c_w_ri = uni_ptr(s.c_w_ri); q.c_b_ri = uni_ptr(s.c_b_ri); q.c_lam = uni_ptr(s.c_lam); q.c_w_out = uni_ptr(s.c_w_out);
  q.out = uni_ptr(s.out); q.ws = uni_ptr(s.ws);
  return q;
}
#define PH(k, call) if (ph_lo <= (k) && (k) < ph_hi) { if ((k) > ph_lo) xcd_barrier(xb); { const Params p = load_params(sp); call; } }
#define PHR(k, rep, call) if (ph_lo <= (k) && (k) < ph_hi) { if ((k) > ph_lo) xcd_barrier(xb); { const Params p = load_params(sp); for (int rr_ = 0; rr_ < (rep); ++rr_) { call; } } }
__global__ void __launch_bounds__(512) mega(Params pk, int ph_lo, int ph_hi) {
  extern __shared__ __attribute__((aligned(16))) char lds[];
  __shared__ __attribute__((aligned(16))) Params sp;
  __shared__ uint4 xb_words;
  if (threadIdx.x == 0) { sp = pk; xb_words = make_uint4(0u, 0u, 0u, 0u); }
  __syncthreads();
  XcdBarrier xb; xb.bar = (unsigned*)(pk.ws + O_BAR); xb.x = xb_xcc_id(); xb.st = (volatile LAS unsigned*)&xb_words;
  if (threadIdx.x == 0) xb_words.z = xb_add(&xb.bar[XB_XCNT(xb.x)], 1u);
  __syncthreads();
  int vb = blockIdx.x;
  cg::grid_group grid = cg::this_grid();
  if (ph_hi < 0) grid.sync();
#ifdef DIAG_PHASE
  ph_lo = DIAG_PHASE; ph_hi = DIAG_PHASE + 1;
#endif
  PHR(0, REP_PRO, prologue_phase(p, lds))
  PHR(1, REP_PRO, post_phase(p, -1))
  if (ph_lo < 2) {
    bool uni = (gridDim.x == 256);
    for (int j = 0; j < 16; ++j) { const unsigned cnt = xb_ld(&xb.bar[XB_XCNT(j)]); uni = uni && (cnt == (j < 8 ? 32u : 0u)); }
    const unsigned rk = xb_words.z;
    if (uni && xb.x < 8 && rk < 32) vb = __builtin_amdgcn_readfirstlane((int)(xb.x * 32 + rk));
  }
  PHR(2, REP_G, gemm8<1>(p, WSP(bf16_t, O_H), WSP(bf16_t, O_WT_A_IN), 33792, NA_IN, 1024, WSP(bf16_t, O_PROJ), 3072, lds, vb))
  PHR(3, REP_GLA, gla_p1(p, 0, 1, lds))
  PH(4, gla_scan_phase(p, 0, 1, lds))
  PHR(5, REP_GLA, gla_p2(p, 0, 0, lds))
  PHR(6, REP_G, gemm8<0>(p, WSP(bf16_t, O_OG), WSP(bf16_t, O_WT_A_OUT), 32768, 1024, 1024, WSP(bf16_t, O_Y), 1024, lds, vb))
  PH(7, post_phase_ctx_overlap(p, 0, WSP(bf16_t, O_OG) + (size_t)ML * 1024, WSP(bf16_t, O_WT_A_OUT), 1024, lds, vb))
  PHR(8, REP_G, gemm8<2>(p, WSP(bf16_t, O_H), WSP(bf16_t, O_WT_B_IN), 33792, 2560, 1024, WSP(bf16_t, O_PROJ), 2560, lds, vb))
  PHR(9, REP_ATT, attn_phase(p, 1, lds))
  PHR(10, REP_G, gemm8<0>(p, WSP(bf16_t, O_OG), WSP(bf16_t, O_WT_B_OUT), 32768, 1024, 1024, WSP(bf16_t, O_Y), 1024, lds, vb))
  PH(11, post_phase_ctx_overlap(p, 1, WSP(bf16_t, O_OG) + (size_t)ML * 1024, WSP(bf16_t, O_WT_B_OUT), 1024, lds, vb))
  PHR(12, REP_G, gemm8<0>(p, WSP(bf16_t, O_H), WSP(bf16_t, O_WT_C_IN), 33792, 2560, 1024, WSP(bf16_t, O_PROJ), 2560, lds, vb))
  PHR(13, REP_R, rglru_phase<1>(p, lds))
  PHR(14, REP_R, rglru_scan_phase(p, lds))
  PHR(15, REP_R, rglru_phase<2>(p, lds))
  PHR(16, REP_G, gemm8<0>(p, WSP(bf16_t, O_OG), WSP(bf16_t, O_WT_C_OUT), 32768, 1024, 1280, WSP(bf16_t, O_Y), 1024, lds, vb))
  PH(17, post_phase_ctx_overlap(p, 2, WSP(bf16_t, O_OG) + (size_t)ML * 1280, WSP(bf16_t, O_WT_C_OUT), 1280, lds, vb))
  PHR(18, REP_G, gemm8<1>(p, WSP(bf16_t, O_H), WSP(bf16_t, O_WT_A_IN) + (size_t)NA_IN * 1024, 33792, NA_IN, 1024, WSP(bf16_t, O_PROJ), 3072, lds, vb))
  PHR(19, REP_GLA, gla_p1(p, 1, 0, lds))
  PH(20, gla_scan_phase(p, 1, 0, lds))
  PHR(21, REP_GLA, gla_p2(p, 1, 0, lds))
  PHR(22, REP_G, gemm8<0>(p, WSP(bf16_t, O_OG), WSP(bf16_t, O_WT_A_OUT) + (size_t)1024 * 1024, 32768, 1024, 1024, WSP(bf16_t, O_Y), 1024, lds, vb))
  PH(23, post_phase(p, 3))
}

extern "C" void kernel_launch(void* const* d_in, const int* in_sizes, int n_in, void* d_out, int out_size, void* d_ws, size_t ws_size, hipStream_t stream) {
  Params p{};
  const float* const* in = (const float* const*)d_in;
  p.x = in[0]; p.c = in[1]; p.ctx = in[2]; p.c_ctx = in[3]; p.w_mod = in[4]; p.b_mod = in[5]; p.g_pre = in[6]; p.g_post = in[7];
  p.a_w_in = in[8]; p.a_w_g1 = in[9]; p.a_w_g2 = in[10]; p.a_b_g = in[11]; p.a_g_head = in[12]; p.a_w_out = in[13];
  p.b_w_in = in[14]; p.b_sink = in[15]; p.b_w_out = in[16];
  p.c_w_in = in[17]; p.c_conv_w = in[18]; p.c_conv_b = in[19]; p.c_w_ra = in[20]; p.c_b_ra = in[21]; p.c_w_ri = in[22]; p.c_b_ri = in[23]; p.c_lam = in[24]; p.c_w_out = in[25];
  p.out = (float*)d_out;
  p.ws = (char*)d_ws;
  if (WS_NEED > ws_size) { fprintf(stderr, "workspace too small: need %zu have %zu\n", (size_t)WS_NEED, ws_size); return; }

  hipMemsetAsync((char*)d_ws + O_BAR, 0, 16384, stream);
  hipFuncSetAttribute((const void*)mega, hipFuncAttributeMaxDynamicSharedMemorySize, LDS_BYTES);
  int dev = 0, cus = 0, per_cu = 0;
  hipGetDevice(&dev);
  hipDeviceGetAttribute(&cus, hipDeviceAttributeMultiprocessorCount, dev);
  hipOccupancyMaxActiveBlocksPerMultiprocessor(&per_cu, mega, NTHR, LDS_BYTES);
  if (per_cu < 1) per_cu = 1;
  if (per_cu > 1) per_cu = 1;
  int grid = cus * per_cu;
#if ONE_LAUNCH
  int lo = 0, hi = NPH;
  void* args[] = {&p, &lo, &hi};
  hipError_t e = hipLaunchCooperativeKernel((const void*)mega, dim3(grid), dim3(NTHR), args, LDS_BYTES, stream);
  if (e != hipSuccess) fprintf(stderr, "cooperative launch failed: %s (grid %d)\n", hipGetErrorString(e), grid);
#else
  for (int ph = 0; ph < NPH; ++ph) {
    hipLaunchKernelGGL(mega, dim3(grid), dim3(NTHR), LDS_BYTES, stream, p, ph, ph + 1);
  }
#endif
}
```

```cpp
#include <hip/hip_runtime.h>
#include <hip/hip_cooperative_groups.h>
#include <cstdio>
namespace cg = cooperative_groups;

typedef unsigned short bf16_t;
typedef short bf16x8 __attribute__((ext_vector_type(8)));
typedef short s16x4 __attribute__((ext_vector_type(4)));
typedef float f32x4 __attribute__((ext_vector_type(4)));
typedef float f32x2 __attribute__((ext_vector_type(2)));
typedef unsigned u32x2 __attribute__((ext_vector_type(2)));
typedef unsigned u32x4 __attribute__((ext_vector_type(4)));

#ifndef REP_G
#define REP_G 1
#endif
#ifndef REP_GLA
#define REP_GLA 1
#endif
#ifndef REP_ATT
#define REP_ATT 1
#endif
#ifndef REP_R
#define REP_R 1
#endif
#ifndef REP_PRO
#define REP_PRO 1
#endif
#ifndef ONE_LAUNCH
#define ONE_LAUNCH 1
#endif

constexpr int NTHR = 512;
constexpr int DM = 1024;
constexpr int ML = 32768;
constexpr int MC = 1024;
constexpr int MT = ML + MC;
constexpr int NA_IN = 3328;
constexpr int LDS_BYTES = 159808;
constexpr int NPH = 24;
constexpr float EPS = 1e-6f;

struct Params {
  const float *x, *c, *ctx, *c_ctx, *w_mod, *b_mod, *g_pre, *g_post;
  const float *a_w_in, *a_w_g1, *a_w_g2, *a_b_g, *a_g_head, *a_w_out;
  const float *b_w_in, *b_sink, *b_w_out;
  const float *c_w_in, *c_conv_w, *c_conv_b, *c_w_ra, *c_b_ra, *c_w_ri, *c_b_ri, *c_lam, *c_w_out;
  float* out;
  char* ws;
};


constexpr size_t al256(size_t x) { return (x + 255) & ~(size_t)255; }
constexpr size_t O_WT_A_IN = 0;
constexpr size_t O_WT_A_OUT = O_WT_A_IN + al256((size_t)2 * NA_IN * 1024 * 2);
constexpr size_t O_WT_B_IN = O_WT_A_OUT + al256((size_t)2 * 1024 * 1024 * 2);
constexpr size_t O_WT_B_OUT = O_WT_B_IN + al256((size_t)2560 * 1024 * 2);
constexpr size_t O_WT_C_IN = O_WT_B_OUT + al256((size_t)1024 * 1024 * 2);
constexpr size_t O_WT_C_OUT = O_WT_C_IN + al256((size_t)2560 * 1024 * 2);
constexpr size_t O_WT_GATE = O_WT_C_OUT + al256((size_t)1024 * 1280 * 2);
constexpr size_t O_MOD = O_WT_GATE + al256((size_t)40 * 128 * 128 * 2);
constexpr size_t O_ROPE = O_MOD + al256((size_t)4 * 5 * 3072 * 4);
constexpr size_t O_G1 = O_ROPE + al256((size_t)128 * 16 * 2 * 4);
constexpr size_t O_XC = O_G1 + al256((size_t)MT * 32 * 4);
constexpr size_t O_H = O_XC + al256((size_t)MC * 1024 * 4);
constexpr size_t O_Y = O_H + al256((size_t)MT * 1024 * 2);
constexpr size_t O_PROJ = O_Y + al256((size_t)MT * 1024 * 2);
constexpr size_t O_OG = O_PROJ + al256((size_t)MT * 3072 * 2);
constexpr size_t O_BAR = O_OG + al256((size_t)MT * 1280 * 2);
constexpr size_t WS_NEED = O_BAR + 16384;
constexpr size_t O_OF = O_H;
constexpr size_t O_SEG_E = O_Y;
constexpr size_t O_SEG_D = O_Y + (size_t)512 * 16 * 512 * 16;
constexpr size_t O_TC = O_Y;
constexpr size_t O_CI = O_Y + (size_t)16 * 1024 * 1024;
static_assert(WS_NEED <= (size_t)512 * 1024 * 1024, "workspace map exceeds 512 MiB");
#define WSP(T, off) ((T*)(p.ws + (off)))

__device__ __forceinline__ unsigned short f2bf(float f) { unsigned u = __float_as_uint(f); u += 0x7fffu + ((u >> 16) & 1u); return (unsigned short)(u >> 16); }
__device__ __forceinline__ float bf2f(unsigned short h) { return __uint_as_float(((unsigned)h) << 16); }
typedef __bf16 bf16v2_t __attribute__((ext_vector_type(2)));
__device__ __forceinline__ unsigned pk2(float a, float b) {
  f32x2 v = {a, b}; bf16v2_t r = __builtin_convertvector(v, bf16v2_t); return __builtin_bit_cast(unsigned, r);
}
__device__ __forceinline__ float bflo(unsigned u) { return __uint_as_float(u << 16); }
__device__ __forceinline__ float bfhi(unsigned u) { return __uint_as_float(u & 0xffff0000u); }
__device__ __forceinline__ float silu_f(float x) { return x * __builtin_amdgcn_rcpf(1.f + __expf(-x)); }
__device__ __forceinline__ float sigm_f(float x) { return __builtin_amdgcn_rcpf(1.f + __expf(-x)); }
__device__ __forceinline__ f32x4 mfma16(bf16x8 a, bf16x8 b, f32x4 c) { return __builtin_amdgcn_mfma_f32_16x16x32_bf16(a, b, c, 0, 0, 0); }
__device__ __forceinline__ s16x4 tr_read(const bf16_t* p) {
  return __builtin_amdgcn_ds_read_tr16_b64_v4i16((__attribute__((address_space(3))) s16x4*)p);
}
__device__ __forceinline__ bf16x8 frag_tr(const bf16_t* tile, int pitch, int krow0, int col0, int lane) {
  const int g = lane >> 4, q = (lane & 15) >> 2, pp = lane & 3;
  const bf16_t* a = tile + (krow0 + 8 * g + q) * pitch + col0 + 4 * pp;
  s16x4 r0 = tr_read(a), r1 = tr_read(a + 4 * pitch);
  bf16x8 o; o[0] = r0[0]; o[1] = r0[1]; o[2] = r0[2]; o[3] = r0[3]; o[4] = r1[0]; o[5] = r1[1]; o[6] = r1[2]; o[7] = r1[3];
  return o;
}
__device__ __forceinline__ bf16x8 pack8(f32x4 a, f32x4 b) {
  union { bf16x8 v; unsigned u[4]; } r;
  r.u[0] = pk2(a[0], a[1]); r.u[1] = pk2(a[2], a[3]); r.u[2] = pk2(b[0], b[1]); r.u[3] = pk2(b[2], b[3]);
  return r.v;
}
template <class T> __device__ __forceinline__ T* sb_ptr(T* v) {
  const unsigned long long u = (unsigned long long)v;
  const unsigned lo = __builtin_amdgcn_readfirstlane((unsigned)u), hi = __builtin_amdgcn_readfirstlane((unsigned)(u >> 32));
  typedef __attribute__((address_space(1))) T GT;
  GT* g = (GT*)(((unsigned long long)hi << 32) | lo);
  return (T*)g;
}
__device__ __forceinline__ float wave_sum(float v) {
#pragma unroll
  for (int o = 32; o > 0; o >>= 1) v += __shfl_xor(v, o);
  return v;
}

__device__ __forceinline__ void conv_tile_wave(const float* __restrict__ src, int K, int N, bf16_t* __restrict__ dst, int ldk, int tk, int tn, float* T, int lane, float wscale) {
  const int k0 = tk * 64, n0 = tn * 64;
  const int c4 = (lane & 15) * 4, r0 = lane >> 4;
  f32x4 v[16];
#pragma unroll
  for (int i = 0; i < 16; ++i) {
    const int k = k0 + r0 + 4 * i, n = n0 + c4;
    v[i] = (f32x4){0.f, 0.f, 0.f, 0.f};
    if (n + 3 < N) v[i] = *(const f32x4*)(src + (size_t)k * N + n);
  }
#pragma unroll
  for (int i = 0; i < 16; ++i) { float* t = T + (r0 + 4 * i) * 65 + c4; t[0] = v[i][0] * wscale; t[1] = v[i][1] * wscale; t[2] = v[i][2] * wscale; t[3] = v[i][3] * wscale; }
  const int k8 = (lane & 7) * 8;
#pragma unroll
  for (int i = 0; i < 8; ++i) {
    const int n = (lane >> 3) + 8 * i;
    if (n0 + n < N) {
      u32x4 o;
      o[0] = pk2(T[(k8 + 0) * 65 + n], T[(k8 + 1) * 65 + n]);
      o[1] = pk2(T[(k8 + 2) * 65 + n], T[(k8 + 3) * 65 + n]);
      o[2] = pk2(T[(k8 + 4) * 65 + n], T[(k8 + 5) * 65 + n]);
      o[3] = pk2(T[(k8 + 6) * 65 + n], T[(k8 + 7) * 65 + n]);
      *(u32x4*)(dst + (size_t)(n0 + n) * ldk + k0 + k8) = o;
    }
  }
}

__device__ __forceinline__ void prologue_phase(const Params& p, char* lds) {
  const int tid = threadIdx.x;
  constexpr int NJ = 12 + 40;
  float* Tw = (float*)lds + (tid >> 6) * (64 * 65);
  for (int t = blockIdx.x * 8 + (tid >> 6); t < 4128; t += gridDim.x * 8) {
    int r = t;
    const float* src; bf16_t* dst; int K, N, ldk; float wscale = 1.0f;
    if (r < 1536) { int j = r / 768; r %= 768; K = 1024; N = 3072; src = p.a_w_in + (size_t)j * 1024 * 3072; dst = WSP(bf16_t, O_WT_A_IN) + (size_t)j * NA_IN * 1024; ldk = 1024; }
    else if ((r -= 1536) < 64) { int jd = r / 16; r %= 16; K = 1024; N = 16; src = p.a_w_g1 + (size_t)jd * 1024 * 16; dst = WSP(bf16_t, O_WT_A_IN) + (size_t)(jd >> 1) * NA_IN * 1024 + (size_t)(3072 + 16 * (jd & 1)) * 1024; ldk = 1024; }
    else if ((r -= 64) < 512) { int j = r / 256; r %= 256; K = 1024; N = 1024; src = p.a_w_out + (size_t)j * 1024 * 1024; dst = WSP(bf16_t, O_WT_A_OUT) + (size_t)j * 1024 * 1024; ldk = 1024; }
    else if ((r -= 512) < 640) { K = 1024; N = 2560; src = p.b_w_in; dst = WSP(bf16_t, O_WT_B_IN); ldk = 1024; }
    else if ((r -= 640) < 256) { K = 1024; N = 1024; src = p.b_w_out; dst = WSP(bf16_t, O_WT_B_OUT); ldk = 1024; }
    else if ((r -= 256) < 640) { K = 1024; N = 2560; src = p.c_w_in; dst = WSP(bf16_t, O_WT_C_IN); ldk = 1024; }
    else if ((r -= 640) < 320) { K = 1280; N = 1024; src = p.c_w_out; dst = WSP(bf16_t, O_WT_C_OUT); ldk = 1280; }
    else { r -= 320; int m = r / 4; r %= 4; K = 128; N = 128; ldk = 128; wscale = -1.4426950408889634f;
      src = (m < 20 ? p.c_w_ra + (size_t)m * 16384 : p.c_w_ri + (size_t)(m - 20) * 16384); dst = WSP(bf16_t, O_WT_GATE) + (size_t)m * 16384; }
    const int tnn = (N + 63) / 64;
    conv_tile_wave(src, K, N, dst, ldk, r / tnn, r % tnn, Tw, tid & 63, wscale);
  }
  (void)NJ;
  for (int i = blockIdx.x * NTHR + tid; i < 2 * 224 * 1024 / 8; i += gridDim.x * NTHR) {
    const int j = i / (224 * 128), r = i % (224 * 128);
    *(u32x4*)(WSP(bf16_t, O_WT_A_IN) + (size_t)j * NA_IN * 1024 + (size_t)3104 * 1024 + (size_t)r * 8) = (u32x4){0u, 0u, 0u, 0u};
  }
  for (int i = blockIdx.x * NTHR + tid; i < 2048; i += gridDim.x * NTHR) {
    const int pos = i >> 4, k = i & 15;
    const float f = powf(10000.0f, -(float)k / 16.0f);
    const float ang = (float)pos * f;
    float s, c; sincosf(ang, &s, &c);
    WSP(float, O_ROPE)[2 * i] = c; WSP(float, O_ROPE)[2 * i + 1] = s;
  }
  {
    float* sv = (float*)lds;
    float* red = (float*)(lds + 20480);
    __syncthreads();
    for (int i = tid; i < 5 * 1024; i += NTHR) {
      const int r = i >> 10, k = i & 1023;
      const float v = (r < 4) ? p.c[r * 1024 + k] : p.c_ctx[k];
      sv[i] = silu_f(v);
    }
    __syncthreads();
    const int lane = tid & 63, w = tid >> 6;
    for (int it = blockIdx.x; it < 4 * 48; it += gridDim.x) {
      const int layer = it / 48, n0 = (it % 48) * 64;
      const float* W = p.w_mod + (size_t)layer * 1024 * 3072 + n0 + lane;
      float a0 = 0.f, a1 = 0.f, a2 = 0.f, a3 = 0.f, a4 = 0.f;
#pragma unroll 8
      for (int k = w * 128; k < w * 128 + 128; ++k) {
        const float wv = W[(size_t)k * 3072];
        a0 += sv[k] * wv; a1 += sv[1024 + k] * wv; a2 += sv[2048 + k] * wv; a3 += sv[3072 + k] * wv; a4 += sv[4096 + k] * wv;
      }
      red[(w * 5 + 0) * 64 + lane] = a0; red[(w * 5 + 1) * 64 + lane] = a1; red[(w * 5 + 2) * 64 + lane] = a2;
      red[(w * 5 + 3) * 64 + lane] = a3; red[(w * 5 + 4) * 64 + lane] = a4;
      __syncthreads();
      if (tid < 320) {
        const int r = tid >> 6, l = tid & 63;
        float s = p.b_mod[layer * 3072 + n0 + l];
#pragma unroll
        for (int ww = 0; ww < 8; ++ww) s += red[(ww * 5 + r) * 64 + l];
        WSP(float, O_MOD)[((size_t)layer * 5 + r) * 3072 + n0 + l] = s;
      }
      __syncthreads();
    }
  }
}

__device__ __forceinline__ void post_rows(const Params& p, int layer, int m_first, int stride, int nrows) {
  const int tid = threadIdx.x, lane = tid & 63;
  const int nl = layer + 1;
  float gpv[16], gprev[16], gatev[16], scv[16], shv[16];
#pragma unroll
  for (int hh = 0; hh < 2; ++hh)
#pragma unroll
    for (int q4 = 0; q4 < 2; ++q4) {
      const int e0 = hh * 512 + lane * 8 + 4 * q4;
      if (layer >= 0) { const f32x4 t = *(const f32x4*)(p.g_post + layer * DM + e0); gpv[hh * 8 + 4 * q4] = t[0]; gpv[hh * 8 + 4 * q4 + 1] = t[1]; gpv[hh * 8 + 4 * q4 + 2] = t[2]; gpv[hh * 8 + 4 * q4 + 3] = t[3]; }
      if (layer < 3) { const f32x4 t = *(const f32x4*)(p.g_pre + nl * DM + e0); gprev[hh * 8 + 4 * q4] = t[0]; gprev[hh * 8 + 4 * q4 + 1] = t[1]; gprev[hh * 8 + 4 * q4 + 2] = t[2]; gprev[hh * 8 + 4 * q4 + 3] = t[3]; }
    }
  int cur_mb = -1;
  f32x4 xr[4]; u32x4 yr[2];
#define POST_LOAD(mm) { const float* xin_ = ((mm) < ML) ? ((layer <= 0) ? p.x + (size_t)(mm) * DM : p.out + (size_t)(mm) * DM) \
                                                     : ((layer <= 0) ? p.ctx + (size_t)((mm) - ML) * DM : WSP(float, O_XC) + (size_t)((mm) - ML) * DM); \
    xr[0] = *(const f32x4*)(xin_ + lane * 8); xr[1] = *(const f32x4*)(xin_ + lane * 8 + 4); xr[2] = *(const f32x4*)(xin_ + 512 + lane * 8); xr[3] = *(const f32x4*)(xin_ + 512 + lane * 8 + 4); \
    if (layer >= 0) { yr[0] = *(const u32x4*)(WSP(bf16_t, O_Y) + (size_t)(mm) * DM + lane * 8); yr[1] = *(const u32x4*)(WSP(bf16_t, O_Y) + (size_t)(mm) * DM + 512 + lane * 8); } }
  int m = m_first;
  if (m < nrows) POST_LOAD(m)
  while (m < nrows) {
    const int mn = m + stride;
    float xv[16], yv[16];
#pragma unroll
    for (int hh = 0; hh < 2; ++hh)
#pragma unroll
      for (int i = 0; i < 4; ++i) {
        xv[hh * 8 + i] = xr[2 * hh][i]; xv[hh * 8 + 4 + i] = xr[2 * hh + 1][i];
        if (layer >= 0) { yv[hh * 8 + 2 * i] = bflo(yr[hh][i]); yv[hh * 8 + 2 * i + 1] = bfhi(yr[hh][i]); }
      }
    if (mn < nrows) POST_LOAD(mn)
    const int mb = (m < ML) ? (m >> 13) : 4;
    if (mb != cur_mb) {
      cur_mb = mb;
#pragma unroll
      for (int hh = 0; hh < 2; ++hh)
#pragma unroll
        for (int q4 = 0; q4 < 2; ++q4) {
          const int e0 = hh * 512 + lane * 8 + 4 * q4, o = hh * 8 + 4 * q4;
          if (layer >= 0) { const f32x4 t = *(const f32x4*)(WSP(float, O_MOD) + ((size_t)layer * 5 + mb) * 3072 + 2048 + e0); gatev[o] = t[0]; gatev[o + 1] = t[1]; gatev[o + 2] = t[2]; gatev[o + 3] = t[3]; }
          if (layer < 3) {
            const float* sh = WSP(float, O_MOD) + ((size_t)nl * 5 + mb) * 3072 + e0;
            const f32x4 t = *(const f32x4*)sh, u = *(const f32x4*)(sh + 1024);
            shv[o] = t[0]; shv[o + 1] = t[1]; shv[o + 2] = t[2]; shv[o + 3] = t[3];
            scv[o] = 1.0f + u[0]; scv[o + 1] = 1.0f + u[1]; scv[o + 2] = 1.0f + u[2]; scv[o + 3] = 1.0f + u[3];
          }
        }
    }
    float* xout = (m < ML) ? p.out + (size_t)m * DM : WSP(float, O_XC) + (size_t)(m - ML) * DM;
    if (layer >= 0) {
      float ss = 0.f;
#pragma unroll
      for (int i = 0; i < 16; ++i) ss += yv[i] * yv[i];
      ss = wave_sum(ss);
      const float r = rsqrtf(ss * (1.0f / 1024.0f) + EPS);
#pragma unroll
      for (int hh = 0; hh < 2; ++hh) {
        const int e0 = hh * 512 + lane * 8;
        f32x4 o0, o1;
#pragma unroll
        for (int i = 0; i < 8; ++i) {
          const float v = xv[hh * 8 + i] + gatev[hh * 8 + i] * (yv[hh * 8 + i] * r * gpv[hh * 8 + i]);
          xv[hh * 8 + i] = v;
          if (i < 4) o0[i] = v; else o1[i - 4] = v;
        }
        *(f32x4*)(xout + e0) = o0; *(f32x4*)(xout + e0 + 4) = o1;
      }
    }
    if (layer < 3) {
      float ss = 0.f;
#pragma unroll
      for (int i = 0; i < 16; ++i) ss += xv[i] * xv[i];
      ss = wave_sum(ss);
      const float r = rsqrtf(ss * (1.0f / 1024.0f) + EPS);
#pragma unroll
      for (int hh = 0; hh < 2; ++hh) {
        const int e0 = hh * 512 + lane * 8;
        float hv[8];
#pragma unroll
        for (int i = 0; i < 8; ++i) hv[i] = xv[hh * 8 + i] * r * gprev[hh * 8 + i] * scv[hh * 8 + i] + shv[hh * 8 + i];
        u32x4 o; o[0] = pk2(hv[0], hv[1]); o[1] = pk2(hv[2], hv[3]); o[2] = pk2(hv[4], hv[5]); o[3] = pk2(hv[6], hv[7]);
        *(u32x4*)(WSP(bf16_t, O_H) + (size_t)m * DM + e0) = o;
      }
    }
    m = mn;
  }
#undef POST_LOAD
}

template <int EPI>
__device__ __forceinline__ void gemm_phase(const Params& p, const bf16_t* __restrict__ A, int lda, const bf16_t* __restrict__ Bt, int N, int K,
                           bf16_t* __restrict__ C, int ldc, int mtiles, char* lds, int vb) {
  const int tid = threadIdx.x, lane = tid & 63, w = tid >> 6, l15 = lane & 15, quad = lane >> 4;
  const int wm = w >> 1, wn = w & 1;
  const int ntn = N / 128, ntiles = mtiles * ntn, nk = K / 64;
  bf16_t* As0 = (bf16_t*)lds; bf16_t* Bs0 = As0 + 256 * 64;
  bf16_t* As1 = (bf16_t*)(lds + 49152); bf16_t* Bs1 = As1 + 256 * 64;
  const int lrow = tid >> 3, lch = (tid & 7) * 8;
  const int wsw = (((tid & 7) ^ (lrow & 7)) * 8);
  const int rsw = l15 & 7;
  u32x4 s0a0, s0a1, s0a2, s0a3, s0b0, s0b1, s1a0, s1a1, s1a2, s1a3, s1b0, s1b1, s2a0, s2a1, s2a2, s2a3, s2b0, s2b1;
  const bf16_t* Ag = A; const bf16_t* Bg = Bt;
  int m0 = 0, n0 = 0;
#define G_TILE_PTRS(t_) { const int band_ = (t_) / (4 * ntn), qq_ = (t_) % (4 * ntn); \
      m0 = (4 * band_ + (qq_ & 3)) * 256; n0 = (qq_ >> 2) * 128; \
      Ag = A + (size_t)(m0 + lrow) * lda + lch; Bg = Bt + (size_t)(n0 + lrow) * K + lch; }
#define G_LOAD(S, kt_) { const int ko_ = (kt_) * 64; \
      S##a0 = *(const u32x4*)(Ag + ko_); S##a1 = *(const u32x4*)(Ag + (size_t)64 * lda + ko_); S##a2 = *(const u32x4*)(Ag + (size_t)128 * lda + ko_); S##a3 = *(const u32x4*)(Ag + (size_t)192 * lda + ko_); \
      S##b0 = *(const u32x4*)(Bg + ko_); S##b1 = *(const u32x4*)(Bg + (size_t)64 * K + ko_); }
#define G_WRITE(S, buf_) { bf16_t* a_ = ((buf_) ? As1 : As0) + lrow * 64 + wsw; bf16_t* b_ = ((buf_) ? Bs1 : Bs0) + lrow * 64 + wsw; \
      *(u32x4*)a_ = S##a0; *(u32x4*)(a_ + 64 * 64) = S##a1; *(u32x4*)(a_ + 128 * 64) = S##a2; *(u32x4*)(a_ + 192 * 64) = S##a3; \
      *(u32x4*)b_ = S##b0; *(u32x4*)(b_ + 64 * 64) = S##b1; }
#define G_COMP(ks) { \
        bf16x8 xf[4], wf[4]; \
        _Pragma("unroll") for (int i = 0; i < 4; ++i) { \
          xf[i] = *(const bf16x8*)(as + (wm * 64 + i * 16 + l15) * 64 + ((((ks) * 4 + quad) ^ rsw) * 8)); \
          wf[i] = *(const bf16x8*)(bs + (wn * 64 + i * 16 + l15) * 64 + ((((ks) * 4 + quad) ^ rsw) * 8)); } \
        _Pragma("unroll") for (int mi = 0; mi < 4; ++mi) \
          _Pragma("unroll") for (int ni = 0; ni < 4; ++ni) acc[mi][ni] = mfma16(wf[ni], xf[mi], acc[mi][ni]); }
#define G_BODY(kt_, S) { \
      if ((kt_) + 1 < nk) { G_WRITE(S, ((kt_) + 1) & 1) if ((kt_) + 4 < nk) G_LOAD(S, (kt_) + 4) } \
      const bf16_t* as = ((kt_) & 1) ? As1 : As0; const bf16_t* bs = ((kt_) & 1) ? Bs1 : Bs0; \
      G_COMP(0) \
      G_COMP(1) \
      __syncthreads(); }
  int t = vb;
  if (t < ntiles) { G_TILE_PTRS(t) G_LOAD(s0, 0) G_LOAD(s1, 1) G_LOAD(s2, 2) }
  while (t < ntiles) {
    f32x4 acc[4][4];
#pragma unroll
    for (int i = 0; i < 4; ++i)
#pragma unroll
      for (int j = 0; j < 4; ++j) acc[i][j] = (f32x4){0.f, 0.f, 0.f, 0.f};
    G_WRITE(s0, 0)
    G_LOAD(s0, 3)
    __syncthreads();
    for (int kt = 0; kt < nk; kt += 3) {
      G_BODY(kt, s1)
      if (kt + 1 < nk) G_BODY(kt + 1, s2)
      if (kt + 2 < nk) G_BODY(kt + 2, s0)
    }
    const int m0c = m0, n0c = n0;
    t += gridDim.x;
    if (t < ntiles) { G_TILE_PTRS(t) G_LOAD(s0, 0) G_LOAD(s1, 1) G_LOAD(s2, 2) }
    const int nw = n0c + wn * 64;
    if (EPI == 2) {
      if (nw < 1280 && m0c < ML) {
#pragma unroll
        for (int mi = 0; mi < 4; ++mi) {
          const int m = m0c + wm * 64 + mi * 16 + l15;
          const int tt = m & 8191;
#pragma unroll
          for (int pr = 0; pr < 2; ++pr) {
            const int pos = pr ? (tt & 63) : (tt >> 6);
            const float* rp = WSP(float, O_ROPE) + (size_t)(pos * 16 + quad * 4) * 2;
            const f32x4 r0 = *(const f32x4*)rp, r1 = *(const f32x4*)(rp + 4);
            const float cs[4] = {r0[0], r0[2], r1[0], r1[2]}, sn[4] = {r0[1], r0[3], r1[1], r1[3]};
#pragma unroll
            for (int j = 0; j < 4; ++j) {
              const float x1 = acc[mi][2 * pr][j], x2 = acc[mi][2 * pr + 1][j];
              acc[mi][2 * pr][j] = x1 * cs[j] - x2 * sn[j];
              acc[mi][2 * pr + 1][j] = x2 * cs[j] + x1 * sn[j];
            }
          }
        }
      }
    }
#pragma unroll
    for (int mi = 0; mi < 4; ++mi) {
      const int m = m0c + wm * 64 + mi * 16 + l15;
#pragma unroll
      for (int ni = 0; ni < 4; ++ni) {
        const int n = nw + ni * 16 + quad * 4;
        const f32x4 v = acc[mi][ni];
        if (EPI == 1) {
          if (n < 3072) { u32x2 o; o[0] = pk2(v[0], v[1]); o[1] = pk2(v[2], v[3]); *(u32x2*)(C + (size_t)m * ldc + n) = o; }
          else if (n < 3104) { *(f32x4*)(WSP(float, O_G1) + (size_t)m * 32 + (n - 3072)) = v; }
        } else {
          u32x2 o; o[0] = pk2(v[0], v[1]); o[1] = pk2(v[2], v[3]); *(u32x2*)(C + (size_t)m * ldc + n) = o;
        }
      }
    }
  }
}

#undef G_LOAD
#undef G_WRITE
#undef G_BODY
#undef G_COMP
#undef G_TILE_PTRS
namespace pg8 {
#define PG8_LAS __attribute__((address_space(3)))
typedef unsigned short bf16_t;
typedef short bf16x8 __attribute__((ext_vector_type(8)));
typedef float f32x4 __attribute__((ext_vector_type(4)));
typedef unsigned u32x4 __attribute__((ext_vector_type(4)));
constexpr int BM = 256, BK = 64, HALF = 128, HTB = HALF * BK * 2  , STAGE_BYTES = 8 * HTB, NXCD = 8, WGM = 8;

__host__ __device__ __forceinline__ int lds_byte(int r, int c) { const int st = (r >> 4) * 2 + (c >> 5), rr = r & 15, cc = c & 31, ob = rr * 64 + cc * 2; return st * 1024 + (ob ^ (((ob >> 9) & 1) << 5)); }
__host__ __device__ __forceinline__ void stage_rc(int b, int& R, int& C) { const int st = b / 1024, sb = b % 1024, swz = sb ^ (((sb >> 9) & 1) << 5); R = (st >> 1) * 16 + swz / 64; C = (st & 1) * 32 + (swz % 64) / 2; }
__host__ __device__ __forceinline__ int perm32(int rho) { const int n = rho >> 4, i = rho & 15; return 8 * (i >> 2) + 4 * n + (i & 3); }

struct Unit { int pm, pn; };
struct Gemm { const bf16_t* A; const bf16_t* Bt; int M, N, K; };

struct StaticOrder {
    int nM, nN, nwg, G, c;
    __host__ __device__ void init(int M, int N, int G_, int c_) { nM = M / BM; nN = N / BM; nwg = nM * nN; G = G_; c = c_; }
    __host__ __device__ bool next(int i, Unit& u) const {
        const long L = (long)i * G + c; if (L >= nwg) return false;
        int wgid = (int)L; { const int q = nwg / NXCD, r = nwg % NXCD, xcd = wgid % NXCD, off = wgid / NXCD; wgid = (xcd < r ? xcd * (q + 1) : r * (q + 1) + (xcd - r) * q) + off; }
        const int nig = WGM * nN, gid = wgid / nig, fm = gid * WGM, gsz = (nM - fm) < WGM ? (nM - fm) : WGM;
        u.pm = fm + ((wgid % nig) % gsz); u.pn = (wgid % nig) / gsz; return true;
    }
    __device__ __forceinline__ void a_ready(const Unit&) const {}
    __device__ __forceinline__ void done(const Unit&) const {}
};
template <class Epi, class Sched, bool ALIGN_EPI = false, bool SP2 = false>
__device__ __forceinline__ void gemm_phase(PG8_LAS unsigned char* lds, const Gemm g, const Sched& S, const Epi& E) {
    const int tid = threadIdx.x, wid = __builtin_amdgcn_readfirstlane(tid >> 6), lane = tid & 63, wr = wid >> 2, wc = wid & 3, fr = lane & 15, fq = lane >> 4;
    const int K = g.K, nt = K / BK;
    unsigned voffA[2], voffB[2];
#pragma unroll
    for (int i = 0; i < 2; ++i) { int R, C; stage_rc(tid * 16 + i * 8192, R, C); const int Rb = Epi::PERM ? ((R & ~31) + perm32(R & 31)) : R;
        voffA[i] = (unsigned)(R * K + C) * 2u; voffB[i] = (unsigned)(Rb * K + C) * 2u; }
    const size_t kstep = (size_t)(BK * 2);
    const size_t hstep = (size_t)HALF * K * 2;
    const size_t tstep = 2 * hstep;
    const unsigned ldsw = (unsigned)wid * 1024u;
    const int aoff = lds_byte(wr * 64 + fr, fq * 8), boff = lds_byte(wc * 32 + fr, fq * 8);
#define PG8_SA(b, h) (((b) * 2 + (h)) * HTB)
#define PG8_SB(b, h) ((4 + (b) * 2 + (h)) * HTB)
#define PG8_STAGE(bufoff, gbase, voff) do { _Pragma("unroll") for (int _i = 0; _i < 2; ++_i) \
        __builtin_amdgcn_global_load_lds((const unsigned*)((const char*)(gbase) + (voff)[_i]), (PG8_LAS unsigned*)(lds + (bufoff) + ldsw + _i * 8192), 16, 0, 0); } while (0)
#define PG8_LDA(dst, b, h) do { _Pragma("unroll") for (int m = 0; m < 4; ++m) _Pragma("unroll") for (int k = 0; k < 2; ++k) dst[m][k] = *(const PG8_LAS bf16x8*)(lds + PG8_SA(b, h) + aoff + m * 2048 + k * 1024); } while (0)
#define PG8_LDB(dst, b, h) do { _Pragma("unroll") for (int n = 0; n < 2; ++n) _Pragma("unroll") for (int k = 0; k < 2; ++k) dst[n][k] = *(const PG8_LAS bf16x8*)(lds + PG8_SB(b, h) + boff + n * 2048 + k * 1024); } while (0)
#define PG8_MMA(ai, bj, At, Bt) do { __builtin_amdgcn_s_setprio(1); _Pragma("unroll") for (int m = 0; m < 4; ++m) _Pragma("unroll") for (int n = 0; n < 2; ++n) _Pragma("unroll") for (int k = 0; k < 2; ++k) \
        acc[ai][bj][m][n] = __builtin_amdgcn_mfma_f32_16x16x32_bf16(Bt[n][k], At[m][k], acc[ai][bj][m][n], 0, 0, 0); __builtin_amdgcn_s_setprio(0); } while (0)
#define PG8_WAIT_V(n) asm volatile("s_waitcnt vmcnt(" #n ")" ::: "memory")
#define PG8_WAIT_L(n) asm volatile("s_waitcnt lgkmcnt(" #n ")" ::: "memory")
#define PG8_BAR __builtin_amdgcn_s_barrier()
#define PG8_SCHED __builtin_amdgcn_sched_barrier(0)
    Unit cur, nxt; int ui = 0;
    if (!S.next(0, cur)) return;
    f32x4 acc[2][2][4][2];
#pragma unroll
    for (int a = 0; a < 2; ++a)
#pragma unroll
        for (int b = 0; b < 2; ++b)
#pragma unroll
            for (int m = 0; m < 4; ++m)
#pragma unroll
                for (int n = 0; n < 2; ++n) acc[a][b][m][n] = (f32x4){0.f, 0.f, 0.f, 0.f};
    bf16x8 At[4][2], B0[2][2], B1[2][2];
    const char* cA = (const char*)g.A + (size_t)cur.pm * tstep; const char* cB = (const char*)g.Bt + (size_t)cur.pn * tstep;
    S.a_ready(cur);
    if constexpr (SP2) {
        PG8_STAGE(PG8_SB(0, 0), cB, voffB); PG8_STAGE(PG8_SB(0, 1), cB + hstep, voffB); PG8_STAGE(PG8_SA(0, 0), cA, voffA); PG8_STAGE(PG8_SA(0, 1), cA + hstep, voffA);
        if (wr == 1) PG8_BAR;
        PG8_WAIT_V(2); PG8_BAR;
        PG8_STAGE(PG8_SB(1, 0), cB + kstep, voffB); PG8_STAGE(PG8_SA(1, 0), cA + kstep, voffA); PG8_STAGE(PG8_SB(1, 1), cB + hstep + kstep, voffB);
        PG8_WAIT_V(6); PG8_BAR;
    } else {
        PG8_STAGE(PG8_SB(0, 0), cB, voffB); PG8_STAGE(PG8_SA(0, 0), cA, voffA); PG8_STAGE(PG8_SB(0, 1), cB + hstep, voffB); PG8_STAGE(PG8_SA(0, 1), cA + hstep, voffA);
        if (wr == 1) PG8_BAR;
        PG8_WAIT_V(4); PG8_BAR;
        PG8_STAGE(PG8_SB(1, 0), cB + kstep, voffB); PG8_STAGE(PG8_SA(1, 0), cA + kstep, voffA); PG8_STAGE(PG8_SB(1, 1), cB + hstep + kstep, voffB);
        PG8_WAIT_V(6); PG8_BAR;
    }
    for (;;) {
        const bool has_next = S.next(ui + 1, nxt);
        const char* nA = has_next ? (const char*)g.A + (size_t)nxt.pm * tstep : cA; const char* nB = has_next ? (const char*)g.Bt + (size_t)nxt.pn * tstep : cB;
        for (int t = 0; t < nt; t += 2) {
            const bool last = (t == nt - 2);
            const char* a1 = cA + (size_t)(t + 1) * kstep;
            const char* a2 = last ? nA : cA + (size_t)(t + 2) * kstep; const char* b2 = last ? nB : cB + (size_t)(t + 2) * kstep;
            const char* a3 = a2 + kstep; const char* b3 = b2 + kstep;
            if (last && has_next) S.a_ready(nxt);
            if constexpr (SP2) {
            PG8_LDB(B0, 0, 0); PG8_LDB(B1, 0, 1); PG8_SCHED; PG8_LDA(At, 0, 0); PG8_STAGE(PG8_SA(1, 1), a1 + hstep, voffA);
            PG8_WAIT_V(8); PG8_WAIT_L(0); PG8_BAR; PG8_MMA(0, 0, At, B0); PG8_MMA(0, 1, At, B1); PG8_BAR; PG8_SCHED;
            PG8_LDA(At, 0, 1); PG8_STAGE(PG8_SB(0, 0), b2, voffB); PG8_STAGE(PG8_SB(0, 1), b2 + hstep, voffB); PG8_STAGE(PG8_SA(0, 0), a2, voffA);
            PG8_WAIT_V(8); PG8_WAIT_L(0); PG8_BAR; PG8_MMA(1, 0, At, B0); PG8_MMA(1, 1, At, B1); PG8_BAR; PG8_SCHED;
            PG8_LDB(B0, 1, 0); PG8_LDB(B1, 1, 1); PG8_SCHED; PG8_LDA(At, 1, 0); PG8_STAGE(PG8_SA(0, 1), a2 + hstep, voffA);
            PG8_WAIT_V(8); PG8_WAIT_L(0); PG8_BAR; PG8_MMA(0, 0, At, B0); PG8_MMA(0, 1, At, B1); PG8_BAR; PG8_SCHED;
            PG8_LDA(At, 1, 1); PG8_STAGE(PG8_SB(1, 0), b3, voffB); PG8_STAGE(PG8_SB(1, 1), b3 + hstep, voffB); PG8_STAGE(PG8_SA(1, 0), a3, voffA);
            PG8_WAIT_V(8); PG8_WAIT_L(0); PG8_BAR; PG8_MMA(1, 0, At, B0); PG8_MMA(1, 1, At, B1); PG8_BAR; PG8_SCHED;
            } else {
            PG8_LDB(B0, 0, 0); PG8_SCHED; PG8_LDA(At, 0, 0); PG8_STAGE(PG8_SA(1, 1), a1 + hstep, voffA);
            PG8_WAIT_L(8); PG8_BAR; PG8_WAIT_L(0); PG8_MMA(0, 0, At, B0); PG8_BAR; PG8_SCHED;
            PG8_LDB(B1, 0, 1); PG8_STAGE(PG8_SB(0, 0), b2, voffB);
            PG8_BAR; PG8_WAIT_L(0); PG8_MMA(0, 1, At, B1); PG8_BAR;
            PG8_LDA(At, 0, 1); PG8_STAGE(PG8_SA(0, 0), a2, voffA);
            PG8_BAR; PG8_WAIT_L(0); PG8_MMA(1, 0, At, B0); PG8_BAR; PG8_SCHED;
            PG8_STAGE(PG8_SB(0, 1), b2 + hstep, voffB);
            PG8_WAIT_V(6); PG8_BAR; PG8_MMA(1, 1, At, B1); PG8_BAR;
            PG8_LDB(B0, 1, 0); PG8_SCHED; PG8_LDA(At, 1, 0); PG8_STAGE(PG8_SA(0, 1), a2 + hstep, voffA);
            PG8_WAIT_L(8); PG8_BAR; PG8_WAIT_L(0); PG8_MMA(0, 0, At, B0); PG8_BAR; PG8_SCHED;
            PG8_LDB(B1, 1, 1); PG8_STAGE(PG8_SB(1, 0), b3, voffB);
            PG8_BAR; PG8_WAIT_L(0); PG8_MMA(0, 1, At, B1); PG8_BAR;
            PG8_LDA(At, 1, 1); PG8_STAGE(PG8_SA(1, 0), a3, voffA);
            PG8_BAR; PG8_WAIT_L(0); PG8_MMA(1, 0, At, B0); PG8_BAR; PG8_SCHED;
            PG8_STAGE(PG8_SB(1, 1), b3 + hstep, voffB);
            PG8_WAIT_V(6); PG8_BAR; PG8_MMA(1, 1, At, B1); PG8_BAR;
            }
        }
        if constexpr (ALIGN_EPI) { if (wr == 0) PG8_BAR; }
        if constexpr (!Epi::AFTER_DRAIN) { E(acc, cur, wr, wc, fr, fq); S.done(cur); }
        if (!has_next) break;
#pragma unroll
        for (int a = 0; a < 2; ++a)
#pragma unroll
            for (int b = 0; b < 2; ++b)
#pragma unroll
                for (int m = 0; m < 4; ++m)
#pragma unroll
                    for (int n = 0; n < 2; ++n) acc[a][b][m][n] = (f32x4){0.f, 0.f, 0.f, 0.f};
        cur = nxt; cA = nA; cB = nB; ++ui;
        if constexpr (ALIGN_EPI) { if (wr == 1) PG8_BAR; }
    }
    PG8_WAIT_V(0);
    if constexpr (!ALIGN_EPI) { if (wr == 0) PG8_BAR; }
    PG8_BAR;
    if constexpr (Epi::AFTER_DRAIN) { E.fused(acc, cur, wr, wc, fr, fq, lds, wid, lane); S.done(cur); }
#undef PG8_SA
#undef PG8_SB
#undef PG8_STAGE
#undef PG8_LDA
#undef PG8_LDB
#undef PG8_MMA
#undef PG8_WAIT_V
#undef PG8_WAIT_L
#undef PG8_BAR
#undef PG8_SCHED
}
}

struct GSched {
  int ntn, nunits, G, c;
  __device__ __forceinline__ bool next(int i, pg8::Unit& u) const {
    const long L = (long)i * G + c; if (L >= nunits) return false;
    const int band = (int)(L / (4 * ntn)), q = (int)(L % (4 * ntn)); u.pm = 4 * band + (q & 3); u.pn = q >> 2; return true;
  }
  __device__ __forceinline__ void a_ready(const pg8::Unit&) const {}
  __device__ __forceinline__ void done(const pg8::Unit&) const {}
};
template <int EPI> struct GEpi {
  static constexpr bool PERM = (EPI != 2), AFTER_DRAIN = false;
  bf16_t* C; int ldc; float* g1; const float* rope;
  __device__ __forceinline__ void operator()(f32x4 (&acc)[2][2][4][2], const pg8::Unit& u, int wr, int wc, int fr, int fq) const {
#pragma unroll
    for (int ai = 0; ai < 2; ++ai)
#pragma unroll
      for (int m = 0; m < 4; ++m) {
        const int row = u.pm * 256 + ai * 128 + wr * 64 + m * 16 + fr;
#pragma unroll
        for (int bj = 0; bj < 2; ++bj) {
          const int cb = u.pn * 256 + bj * 128 + wc * 32;
          if (EPI == 2) {
            f32x4 v0 = acc[ai][bj][m][0], v1 = acc[ai][bj][m][1];
            if (cb < 1280 && row < ML) {
              const int tt = row & 8191;
              const int pos = (wc & 1) ? (tt & 63) : (tt >> 6);
              const float* rp = rope + (size_t)(pos * 16 + fq * 4) * 2;
              const f32x4 r0 = *(const f32x4*)rp, r1 = *(const f32x4*)(rp + 4);
              const float cs[4] = {r0[0], r0[2], r1[0], r1[2]}, sn[4] = {r0[1], r0[3], r1[1], r1[3]};
#pragma unroll
              for (int j = 0; j < 4; ++j) { const float x1 = v0[j], x2 = v1[j]; v0[j] = x1 * cs[j] - x2 * sn[j]; v1[j] = x2 * cs[j] + x1 * sn[j]; }
            }
            u32x2 o0, o1; o0[0] = pk2(v0[0], v0[1]); o0[1] = pk2(v0[2], v0[3]); o1[0] = pk2(v1[0], v1[1]); o1[1] = pk2(v1[2], v1[3]);
            bf16_t* cp = C + (size_t)row * ldc + cb + 4 * fq;
            *(u32x2*)cp = o0; *(u32x2*)(cp + 16) = o1;
          } else {
            const int col = cb + 8 * fq;
            const f32x4 v0 = acc[ai][bj][m][0], v1 = acc[ai][bj][m][1];
            if (EPI == 1 && col >= 3072) {
              if (col < 3104) { float* gp = g1 + (size_t)row * 32 + (col - 3072); *(f32x4*)gp = v0; *(f32x4*)(gp + 4) = v1; }
            } else {
              u32x4 o; o[0] = pk2(v0[0], v0[1]); o[1] = pk2(v0[2], v0[3]); o[2] = pk2(v1[0], v1[1]); o[3] = pk2(v1[2], v1[3]);
              *(u32x4*)(C + (size_t)row * ldc + col) = o;
            }
          }
        }
      }
  }
};
template <int EPI>
__device__ __forceinline__ void gemm8(const Params& p, const bf16_t* A, const bf16_t* Bt, int M, int N, int K, bf16_t* C, int ldc, char* lds, int vb) {
  pg8::Gemm g{A, Bt, M, N, K};
  GSched S{N / 256, (M / 256) * (N / 256), (int)gridDim.x, vb};
  GEpi<EPI> E{C, ldc, WSP(float, O_G1), WSP(float, O_ROPE)};
  pg8::gemm_phase<GEpi<EPI>, GSched, false, true>((PG8_LAS unsigned char*)lds, g, S, E);
}

constexpr int G_G1S = 0, G_TOT = 4096, G_BS = 6144, G_QS = 38912, G_KS = 56320, G_KHS = 73728, G_VS = 91136, G_PS = 124928, G_RED = 134144, G_WG2 = 136192;
constexpr int QP = 136, VP = 264, PP = 72;

template <int MODE>
__device__ __forceinline__ void gla_run(const Params& p, int jl, int hd, int dir, int row_first, int row_step, int nch, f32x4 (&S)[8][2], float& logD, char* lds) {
  const int tid = threadIdx.x, lane = tid & 63, w = tid >> 6, l15 = lane & 15, quad = lane >> 4;
  float* g1s = (float*)(lds + G_G1S); float* tot = (float*)(lds + G_TOT); float* bs = (float*)(lds + G_BS);
  bf16_t* qs = (bf16_t*)(lds + G_QS); bf16_t* ks_ = (bf16_t*)(lds + G_KS); bf16_t* khs = (bf16_t*)(lds + G_KHS);
  bf16_t* vs = (bf16_t*)(lds + G_VS); bf16_t* ps = (bf16_t*)(lds + G_PS); float* red = (float*)(lds + G_RED);
  float wb[4];
#pragma unroll
  for (int ks4 = 0; ks4 < 4; ++ks4) wb[ks4] = p.a_w_g2[((size_t)(jl * 2 + dir) * 16 + 4 * ks4 + quad) * 512 + hd * 128 + 16 * w + l15];
  const float bg = p.a_b_g[(jl * 2 + dir) * 512 + hd * 128 + 16 * w + l15];
  const int tl = dir ? 0 : 63;
  constexpr bool PF = (MODE == 0);
  u32x4 rq[2], rk[2], rv[4];
  f32x4 rg1 = {0.f, 0.f, 0.f, 0.f};
  const unsigned g1off = (unsigned)((tid >> 2) * 128 + (tid & 3) * 16);
  const unsigned qkoff = (unsigned)((tid >> 4) * 6144 + (tid & 15) * 16);
  const unsigned vvoff = (unsigned)((tid >> 5) * 6144 + (tid & 31) * 16);
  const unsigned eoff = (unsigned)(l15 * 2048 + (32 * w + 4 * quad) * 2);
  const unsigned zoff = (unsigned)(l15 * 6144 + (32 * w + 4 * quad) * 2);
#define GLA_ISSUE_G1(row0_) { \
    const char* g1b_ = sb_ptr((const char*)WSP(float, O_G1) + (size_t)(row0_) * 128 + dir * 64); \
    if (tid < 256) rg1 = *(const f32x4*)(g1b_ + g1off); }
#define GLA_ISSUE(row0_) { \
    const char* qb_ = sb_ptr((const char*)WSP(bf16_t, O_PROJ) + (size_t)(row0_) * 6144 + hd * 256); \
    _Pragma("unroll") for (int i = 0; i < 2; ++i) { \
      if (MODE != 0) rq[i] = *(const u32x4*)(qb_ + (qkoff + (unsigned)(i * 32 * 6144))); \
      rk[i] = *(const u32x4*)(qb_ + 1024 + (qkoff + (unsigned)(i * 32 * 6144))); } \
    const char* vb_ = sb_ptr((const char*)WSP(bf16_t, O_PROJ) + (size_t)(row0_) * 6144 + 2048 + hd * 512); \
    _Pragma("unroll") for (int i = 0; i < 4; ++i) rv[i] = *(const u32x4*)(vb_ + (vvoff + (unsigned)(i * 16 * 6144))); }
  f32x4 ghv[2];
  u32x2 pof[4][2], pz[4][2];
  float* const g1sA = g1s; float* const g1sB = (float*)(lds + G_KHS); float* const blv = tot;
  GLA_ISSUE_G1(row_first)
  if (tid < 256) *(f32x4*)(g1sA + (tid >> 2) * 16 + (tid & 3) * 4) = rg1;
  if (nch > 1) GLA_ISSUE_G1(row_first + row_step)
  __syncthreads();
  if (PF) GLA_ISSUE(row_first)
  for (int ci = 0; ci < nch; ++ci) {
    const int row0 = row_first + ci * row_step;
    if (!PF) GLA_ISSUE(row0)
    const float* const g1c = (ci & 1) ? g1sB : g1sA;
    {
      float lav[4][4];
      const int arow = 16 * (l15 >> 2) + (l15 & 3);
#pragma unroll
      for (int mt = 0; mt < 4; ++mt) {
        f32x4 acc4 = {0.f, 0.f, 0.f, 0.f};
#pragma unroll
        for (int ks4 = 0; ks4 < 4; ++ks4) acc4 = __builtin_amdgcn_mfma_f32_16x16x4f32(g1c[(arow + 4 * mt) * 16 + 4 * ks4 + quad], wb[ks4], acc4, 0, 0, 0);
#pragma unroll
        for (int j = 0; j < 4; ++j) {
          const float xg = acc4[j] + bg;
          lav[mt][j] = (fminf(xg, 0.f) - 0.6931471805599453f * __builtin_amdgcn_logf(1.0f + __builtin_amdgcn_exp2f(-1.4426950408889634f * fabsf(xg)))) * (1.0f / 16.0f);
        }
      }
      float run = 0.f;
      if (dir == 0) {
#pragma unroll
        for (int mt = 0; mt < 4; ++mt)
#pragma unroll
          for (int j = 0; j < 4; ++j) { run += lav[mt][j]; lav[mt][j] = run; }
      } else {
#pragma unroll
        for (int mt = 3; mt >= 0; --mt)
#pragma unroll
          for (int j = 3; j >= 0; --j) { run += lav[mt][j]; lav[mt][j] = run; }
      }
      const float t0 = __shfl(run, l15), t1 = __shfl(run, l15 + 16), t2 = __shfl(run, l15 + 32), t3 = __shfl(run, l15 + 48);
      float off;
      if (dir == 0) off = (quad > 0 ? t0 : 0.f) + (quad > 1 ? t1 : 0.f) + (quad > 2 ? t2 : 0.f);
      else off = (quad < 3 ? t3 : 0.f) + (quad < 2 ? t2 : 0.f) + (quad < 1 ? t1 : 0.f);
#pragma unroll
      for (int mt = 0; mt < 4; ++mt)
#pragma unroll
        for (int j = 0; j < 4; ++j) bs[(16 * quad + 4 * mt + j) * 128 + 16 * w + l15] = lav[mt][j] + off;
    }
    __syncthreads();
    if (tid < 128) { const float blt = bs[tl * 128 + tid]; logD += blt; blv[(ci & 1) * 128 + tid] = blt; }
    if (ci + 1 < nch) {
      if (tid < 256) *(f32x4*)(((ci & 1) ? g1sA : g1sB) + (tid >> 2) * 16 + (tid & 3) * 4) = rg1;
      if (ci + 2 < nch) GLA_ISSUE_G1(row0 + 2 * row_step)
    }
#pragma unroll
    for (int i = 0; i < 2; ++i) {
      const int cc = tid + 512 * i, t = cc >> 4, ch = cc & 15;
      const f32x4 b0 = *(const f32x4*)(bs + t * 128 + ch * 8), b1 = *(const f32x4*)(bs + t * 128 + ch * 8 + 4);
      float bv[8] = {b0[0], b0[1], b0[2], b0[3], b1[0], b1[1], b1[2], b1[3]};
      float kf[8], qf[8];
#pragma unroll
      for (int e = 0; e < 4; ++e) { kf[2 * e] = bflo(rk[i][e]); kf[2 * e + 1] = bfhi(rk[i][e]); }
      u32x4 ok;
#pragma unroll
      for (int e = 0; e < 4; ++e) ok[e] = pk2(kf[2 * e] * __expf(-bv[2 * e]), kf[2 * e + 1] * __expf(-bv[2 * e + 1]));
      *(u32x4*)(ks_ + t * QP + ch * 8) = ok;
      if (MODE != 0) {
#pragma unroll
        for (int e = 0; e < 4; ++e) { qf[2 * e] = bflo(rq[i][e]); qf[2 * e + 1] = bfhi(rq[i][e]); }
        u32x4 oq;
        const float qsc = 0.08838834764831845f;
#pragma unroll
        for (int e = 0; e < 4; ++e) oq[e] = pk2(qf[2 * e] * (qsc * __expf(bv[2 * e])), qf[2 * e + 1] * (qsc * __expf(bv[2 * e + 1])));
        *(u32x4*)(qs + t * QP + ch * 8) = oq;
      }
    }
#pragma unroll
    for (int i = 0; i < 4; ++i) {
      const int cc = tid + 512 * i, t = cc >> 5, ch = cc & 31;
      *(u32x4*)(vs + t * VP + ch * 8) = rv[i];
    }
    if (PF && ci + 1 < nch) GLA_ISSUE(row0 + row_step)
    const char* ofb = sb_ptr((const char*)WSP(bf16_t, O_OF) + (size_t)row0 * 2048 + hd * 512);
    if (MODE == 2) {
      __builtin_amdgcn_sched_barrier(0);
#pragma unroll
      for (int it = 0; it < 4; ++it)
#pragma unroll
        for (int et = 0; et < 2; ++et)
          pof[it][et] = *(const u32x2*)(ofb + (eoff + (unsigned)(it * 32768 + et * 32)));
      __builtin_amdgcn_sched_barrier(0);
    }
    __syncthreads();
    if (MODE != 0) {
      const int it = w >> 1;
#pragma unroll
      for (int si = 0; si < 2; ++si) {
        const int st = 2 * (w & 1) + si;
        f32x4 sc = {0.f, 0.f, 0.f, 0.f};
#pragma unroll
        for (int kk = 0; kk < 4; ++kk) {
          const bf16x8 a = *(const bf16x8*)(ks_ + (16 * st + l15) * QP + 32 * kk + 8 * quad);
          const bf16x8 b = *(const bf16x8*)(qs + (16 * it + l15) * QP + 32 * kk + 8 * quad);
          sc = mfma16(a, b, sc);
        }
        const int ii = 16 * it + l15;
#pragma unroll
        for (int j = 0; j < 4; ++j) {
          const int s = 16 * st + 4 * quad + j;
          const bool keep = dir ? (s >= ii) : (s <= ii);
          if (!keep) sc[j] = 0.f;
        }
        u32x2 o; o[0] = pk2(sc[0], sc[1]); o[1] = pk2(sc[2], sc[3]);
        *(u32x2*)(ps + ii * PP + 16 * st + 4 * quad) = o;
      }
      __syncthreads();
    }
    f32x4 o[4][2];
    if (MODE != 0) {
      bf16x8 vf[2][2];
#pragma unroll
      for (int et = 0; et < 2; ++et)
#pragma unroll
        for (int kk = 0; kk < 2; ++kk) vf[et][kk] = frag_tr(vs, VP, 32 * kk, 32 * w + 16 * et, lane);
#pragma unroll
      for (int it = 0; it < 4; ++it)
#pragma unroll
        for (int et = 0; et < 2; ++et) o[it][et] = (f32x4){0.f, 0.f, 0.f, 0.f};
#pragma unroll
      for (int it = 0; it < 4; ++it)
#pragma unroll
        for (int kk = 0; kk < 2; ++kk) {
          const bf16x8 pb = *(const bf16x8*)(ps + (16 * it + l15) * PP + 32 * kk + 8 * quad);
#pragma unroll
          for (int et = 0; et < 2; ++et) o[it][et] = mfma16(vf[et][kk], pb, o[it][et]);
        }
#pragma unroll
      for (int m = 0; m < 4; ++m) {
        bf16x8 sf[2];
#pragma unroll
        for (int et = 0; et < 2; ++et) sf[et] = pack8(S[2 * m][et], S[2 * m + 1][et]);
#pragma unroll
        for (int it = 0; it < 4; ++it) {
          const bf16_t* qp = qs + (16 * it + l15) * QP + 32 * m + 4 * quad;
          const s16x4 q0 = *(const s16x4*)qp, q1 = *(const s16x4*)(qp + 16);
          bf16x8 qb; qb[0] = q0[0]; qb[1] = q0[1]; qb[2] = q0[2]; qb[3] = q0[3]; qb[4] = q1[0]; qb[5] = q1[1]; qb[6] = q1[2]; qb[7] = q1[3];
#pragma unroll
          for (int et = 0; et < 2; ++et) o[it][et] = mfma16(sf[et], qb, o[it][et]);
        }
      }
    }
    if (MODE == 1) {
#pragma unroll
      for (int it = 0; it < 4; ++it)
#pragma unroll
        for (int et = 0; et < 2; ++et) {
          u32x2 ov; ov[0] = pk2(o[it][et][0], o[it][et][1]); ov[1] = pk2(o[it][et][2], o[it][et][3]);
          *(u32x2*)((char*)ofb + (eoff + (unsigned)(it * 32768 + et * 32))) = ov;
        }
    }
    if (MODE == 2) {
#pragma unroll
      for (int it = 0; it < 4; ++it)
#pragma unroll
        for (int et = 0; et < 2; ++et)
          pz[it][et] = *(const u32x2*)(sb_ptr((const char*)WSP(bf16_t, O_PROJ) + (size_t)row0 * 6144 + 4096 + hd * 512) + (zoff + (unsigned)(it * 16 * 6144 + et * 32)));
#pragma unroll
      for (int et = 0; et < 2; ++et) ghv[et] = *(const f32x4*)(p.a_g_head + (size_t)(jl * 4 + hd) * 256 + 32 * w + 16 * et + 4 * quad);
#pragma unroll
      for (int it = 0; it < 4; ++it) {
        float s = 0.f;
#pragma unroll
        for (int et = 0; et < 2; ++et) {
          const u32x2 pv = pof[it][et];
          o[it][et][0] += bflo(pv[0]); o[it][et][1] += bfhi(pv[0]); o[it][et][2] += bflo(pv[1]); o[it][et][3] += bfhi(pv[1]);
#pragma unroll
          for (int j = 0; j < 4; ++j) s += o[it][et][j] * o[it][et][j];
        }
        s += __shfl_xor(s, 16); s += __shfl_xor(s, 32);
        if (quad == 0) red[(16 * it + l15) * 8 + w] = s;
      }
      __syncthreads();
#pragma unroll
      for (int it = 0; it < 4; ++it) {
        const f32x4 r0 = *(const f32x4*)(red + (16 * it + l15) * 8), r1 = *(const f32x4*)(red + (16 * it + l15) * 8 + 4);
        const float tot2 = (r0[0] + r0[1]) + (r0[2] + r0[3]) + (r1[0] + r1[1]) + (r1[2] + r1[3]);
        const float rn = rsqrtf(tot2 * (1.0f / 256.0f) + EPS);
        const size_t row = (size_t)(row0 + 16 * it + l15);
#pragma unroll
        for (int et = 0; et < 2; ++et) {
          const int e = 32 * w + 16 * et + 4 * quad;
          const f32x4 gh = ghv[et];
          const u32x2 zv = pz[it][et];
          const float z0 = bflo(zv[0]), z1 = bfhi(zv[0]), z2 = bflo(zv[1]), z3 = bfhi(zv[1]);
          const float v0 = o[it][et][0] * rn * gh[0] * silu_f(z0), v1 = o[it][et][1] * rn * gh[1] * silu_f(z1);
          const float v2 = o[it][et][2] * rn * gh[2] * silu_f(z2), v3 = o[it][et][3] * rn * gh[3] * silu_f(z3);
          u32x2 ov; ov[0] = pk2(v0, v1); ov[1] = pk2(v2, v3);
          *(u32x2*)(sb_ptr((char*)WSP(bf16_t, O_OG) + (size_t)row0 * 2048 + hd * 512) + (eoff + (unsigned)(it * 32768 + et * 32))) = ov;
        }
      }
    }
    bf16x8 vf2[2][2];
#pragma unroll
    for (int et = 0; et < 2; ++et)
#pragma unroll
      for (int kk = 0; kk < 2; ++kk) vf2[et][kk] = frag_tr(vs, VP, 32 * kk, 32 * w + 16 * et, lane);
#pragma unroll
    for (int dt = 0; dt < 8; ++dt) {
#pragma unroll
      for (int kk = 0; kk < 2; ++kk) {
        const bf16x8 ka = frag_tr(ks_, QP, 32 * kk, 16 * dt, lane);
#pragma unroll
        for (int et = 0; et < 2; ++et) S[dt][et] = mfma16(ka, vf2[et][kk], S[dt][et]);
      }
    }
#pragma unroll
    for (int dt = 0; dt < 8; ++dt) {
      const f32x4 bl = *(const f32x4*)(blv + (ci & 1) * 128 + 16 * dt + 4 * quad);
      f32x4 sc; sc[0] = __expf(bl[0]); sc[1] = __expf(bl[1]); sc[2] = __expf(bl[2]); sc[3] = __expf(bl[3]);
#pragma unroll
      for (int et = 0; et < 2; ++et) S[dt][et] = S[dt][et] * sc;
    }
  }
}

#undef GLA_ISSUE
#undef GLA_ISSUE_G1
__device__ __forceinline__ void gla_p1(const Params& p, int jl, int ctx_out, char* lds) {
  const int tid = threadIdx.x;
  for (int item = blockIdx.x; item < 512; item += gridDim.x) {
    const int u = item & 15, rec = item >> 4;
    const int dir = rec & 1, hd = (rec >> 1) & 3, b = rec >> 3;
    f32x4 S[8][2];
#pragma unroll
    for (int i = 0; i < 8; ++i) { S[i][0] = (f32x4){0.f, 0.f, 0.f, 0.f}; S[i][1] = (f32x4){0.f, 0.f, 0.f, 0.f}; }
    float logD = 0.f;
    int row_first, step, nch;
    if (u == 0) { nch = 4; row_first = ML + b * 256 + (dir ? 192 : 0); step = dir ? -64 : 64; }
    else { const int pp = u - 1; const int ts = dir ? 15 - pp : pp; nch = 8; row_first = b * 8192 + ts * 512 + (dir ? 448 : 0); step = dir ? -64 : 64; }
    gla_run<0>(p, jl, hd, dir, row_first, step, nch, S, logD, lds);
    f32x4* E = (f32x4*)WSP(float, O_SEG_E) + (size_t)item * 16 * 512;
#pragma unroll
    for (int dt = 0; dt < 8; ++dt)
#pragma unroll
      for (int et = 0; et < 2; ++et) E[(dt * 2 + et) * 512 + tid] = S[dt][et];
    if (tid < 128) WSP(float, O_SEG_D)[(size_t)item * 128 + tid] = __expf(logD);
    if (ctx_out && u == 0) {
      const int pi = rec >> 1, want = (pi < 8) ? (pi & 1) : 1 - (pi & 1);
      if (dir == want) {
#pragma unroll
        for (int i = 0; i < 8; ++i) { S[i][0] = (f32x4){0.f, 0.f, 0.f, 0.f}; S[i][1] = (f32x4){0.f, 0.f, 0.f, 0.f}; }
        float dummy = 0.f;
        gla_run<1>(p, jl, hd, 0, ML + b * 256, 64, 4, S, dummy, lds);
      }
    }
  }
}

__device__ __forceinline__ void gla_scan_phase(const Params& p, int jl, int ctx_out, char* lds) {
  const int tid = threadIdx.x;
  const int nskip = ctx_out ? 16 : 0;
  if ((int)blockIdx.x < nskip) {
    const int hd = blockIdx.x & 3, b = blockIdx.x >> 2;
    f32x4 S[8][2];
#pragma unroll
    for (int i = 0; i < 8; ++i) { S[i][0] = (f32x4){0.f, 0.f, 0.f, 0.f}; S[i][1] = (f32x4){0.f, 0.f, 0.f, 0.f}; }
    float dummy = 0.f;
    gla_run<2>(p, jl, hd, 1, ML + b * 256 + 192, -64, 4, S, dummy, lds);
    return;
  }
  f32x4* Eall = (f32x4*)WSP(float, O_SEG_E);
  const float* Dall = WSP(float, O_SEG_D);
  for (int slot = ((int)blockIdx.x - nskip) * NTHR + tid; slot < 32 * 8192; slot += ((int)gridDim.x - nskip) * NTHR) {
    const int rec = slot >> 13, q = slot & 8191;
    const int dt = (q >> 9) >> 1, quad = ((q & 511) & 63) >> 4;
    f32x4* E = Eall + (size_t)(rec * 16) * 8192 + q;
    const float* D = Dall + (size_t)(rec * 16) * 128 + 16 * dt + 4 * quad;
    f32x4 ev[16];
#pragma unroll
    for (int u = 0; u < 16; ++u) ev[u] = E[(size_t)u * 8192];
    f32x4 S = ev[0];
#pragma unroll
    for (int u = 1; u < 16; ++u) {
      const f32x4 dv = *(const f32x4*)(D + (size_t)u * 128);
      S = S * dv + ev[u];
      E[(size_t)u * 8192] = S;
    }
  }
}

__device__ __forceinline__ void gla_fold(const Params& p, int rec, int upto, f32x4 (&S)[8][2]) {
  const int tid = threadIdx.x;
  if (upto < 0) {
#pragma unroll
    for (int dt = 0; dt < 8; ++dt) { S[dt][0] = (f32x4){0.f, 0.f, 0.f, 0.f}; S[dt][1] = (f32x4){0.f, 0.f, 0.f, 0.f}; }
    return;
  }
  const f32x4* E = (const f32x4*)WSP(float, O_SEG_E) + (size_t)(rec * 16 + upto) * 16 * 512;
#pragma unroll
  for (int dt = 0; dt < 8; ++dt)
#pragma unroll
    for (int et = 0; et < 2; ++et) S[dt][et] = E[(dt * 2 + et) * 512 + tid];
}

__device__ __forceinline__ void gla_p2(const Params& p, int jl, int ctx_out, char* lds) {
  const int nitems = 256 + (ctx_out ? 16 : 0);
  for (int item0 = blockIdx.x; item0 < nitems; item0 += gridDim.x) {
    int item = item0;
    bool is_ctx = false;
    if (ctx_out) { if (item0 < 16) is_ctx = true; else item = item0 - 16; }
    int hd, b, ts, nch, nch1, rf0, rf1;
    if (is_ctx) { hd = item & 3; b = item >> 2; ts = 0; nch = 4; nch1 = 0; rf0 = ML + b * 256; rf1 = rf0 + 192; }
    else { ts = item & 15; hd = (item >> 4) & 3; b = item >> 6; nch = 8; nch1 = 8; rf0 = b * 8192 + ts * 512; rf1 = rf0 + 448; }
    const int rec0 = (b * 4 + hd) * 2;
    f32x4 S[8][2];
    float logD = 0.f;
    gla_fold(p, rec0, is_ctx ? -1 : ts, S);
    gla_run<1>(p, jl, hd, 0, rf0, 64, nch1, S, logD, lds);
    gla_fold(p, rec0 + 1, is_ctx ? -1 : 15 - ts, S);
    gla_run<2>(p, jl, hd, 1, rf1, -64, nch, S, logD, lds);
  }
}

constexpr int KP = 72;
constexpr float QSC = 0.125f * 1.4426950408889634f;
__device__ __forceinline__ void attn_phase(const Params& p, int ctx_out, char* lds) {
  const int tid = threadIdx.x, lane = tid & 63, w = tid >> 6, l15 = lane & 15, quad = lane >> 4;
  bf16_t* KVb = (bf16_t*)lds;
  const int nitems = 4096 + (ctx_out ? 128 : 0);
  for (int item = blockIdx.x; item < nitems; item += gridDim.x) {
    int b, h, qrow0, nblk, tix0;
    if (item < 4096) {
      nblk = item & 63; h = (item >> 6) & 15; b = item >> 10;
      qrow0 = b * 8192 + nblk * 128; tix0 = 0;
    } else {
      const int it = item - 4096; const int cb = it & 1; h = (it >> 1) & 15; b = it >> 5;
      qrow0 = ML + b * 256 + cb * 128; nblk = 1; tix0 = 3;
    }
    const int hk = h >> 2;
    const int ii = 16 * w + l15;
    const size_t qrow = (size_t)(qrow0 + ii);
    bf16x8 qf[2];
#pragma unroll
    for (int kk = 0; kk < 2; ++kk) {
      const u32x4 u = *(const u32x4*)(WSP(bf16_t, O_PROJ) + qrow * 2560 + h * 64 + 32 * kk + 8 * quad);
      union { bf16x8 v; unsigned uu[4]; } r;
#pragma unroll
      for (int e = 0; e < 4; ++e) r.uu[e] = pk2(bflo(u[e]) * QSC, bfhi(u[e]) * QSC);
      qf[kk] = r.v;
    }
    float m_run = p.b_sink[h] * 1.4426950408889634f;
    float l_part = (quad == 0) ? 1.f : 0.f;
    f32x4 O[4];
#pragma unroll
    for (int d = 0; d < 4; ++d) O[d] = (f32x4){0.f, 0.f, 0.f, 0.f};
    u32x4 pk0, pk1, pv0, pv1;
#define ATT_ISSUE(tix_) { const int kr_ = ((tix_) < 3) ? b * 8192 + (nblk - 1 + (tix_)) * 128 : ML + b * 256 + ((tix_) - 3) * 128; \
      const bf16_t* src_ = WSP(bf16_t, O_PROJ) + (size_t)(kr_ + (tid >> 3)) * 2560 + 1024 + hk * 64 + (tid & 7) * 8; \
      pk0 = *(const u32x4*)src_; pv0 = *(const u32x4*)(src_ + 256); pk1 = *(const u32x4*)(src_ + (size_t)64 * 2560); pv1 = *(const u32x4*)(src_ + (size_t)64 * 2560 + 256); }
#define ATT_TILE(KS_, VS_, MODE_, KLO_, KHI_) { \
      f32x4 sc[8]; float mx = -INFINITY; \
      const int mlo = ((MODE_) == 1) ? ii : -100000, mhi = ((MODE_) == 2) ? ii : 100000; \
      _Pragma("unroll") for (int kt = 0; kt < 8; ++kt) { \
        if (kt >= (KLO_) && kt <= (KHI_)) { \
          f32x4 s_ = {0.f, 0.f, 0.f, 0.f}; \
          _Pragma("unroll") for (int kk = 0; kk < 2; ++kk) { \
            const bf16x8 a_ = *(const bf16x8*)((KS_) + (16 * kt + l15) * KP + 32 * kk + 8 * quad); \
            s_ = mfma16(a_, qf[kk], s_); } \
          if ((MODE_) != 0 && kt == w) { \
            _Pragma("unroll") for (int j = 0; j < 4; ++j) { \
              const int kkey = 16 * kt + 4 * quad + j; \
              const int dneg = min(kkey - mlo, 0) + min(mhi - kkey, 0); \
              s_[j] += (float)dneg * 1e30f; } } \
          mx = fmaxf(mx, fmaxf(fmaxf(s_[0], s_[1]), fmaxf(s_[2], s_[3]))); \
          sc[kt] = s_; \
        } else sc[kt] = (f32x4){0.f, 0.f, 0.f, 0.f}; } \
      mx = fmaxf(mx, __shfl_xor(mx, 16)); mx = fmaxf(mx, __shfl_xor(mx, 32)); \
      const float m_new = fmaxf(m_run, mx); \
      const float alpha = __builtin_amdgcn_exp2f(m_run - m_new); \
      m_run = m_new; l_part *= alpha; \
      _Pragma("unroll") for (int d = 0; d < 4; ++d) O[d] = O[d] * alpha; \
      _Pragma("unroll") for (int kt = 0; kt < 8; ++kt) { \
        if (kt >= (KLO_) && kt <= (KHI_)) { \
          _Pragma("unroll") for (int j = 0; j < 4; ++j) { const float e_ = __builtin_amdgcn_exp2f(sc[kt][j] - m_new); sc[kt][j] = e_; l_part += e_; } } } \
      _Pragma("unroll") for (int kp = 0; kp < 4; ++kp) { \
        if (2 * kp + 1 >= (KLO_) && 2 * kp <= (KHI_)) { \
          const bf16x8 pb = pack8(sc[2 * kp], sc[2 * kp + 1]); \
          _Pragma("unroll") for (int d = 0; d < 4; ++d) { \
            const int q_ = (lane & 15) >> 2, pp_ = lane & 3; \
            const bf16_t* a0 = (VS_) + (32 * kp + 4 * quad + q_) * KP + 16 * d + 4 * pp_; \
            const s16x4 r0 = tr_read(a0), r1 = tr_read(a0 + 16 * KP); \
            bf16x8 va; va[0] = r0[0]; va[1] = r0[1]; va[2] = r0[2]; va[3] = r0[3]; va[4] = r1[0]; va[5] = r1[1]; va[6] = r1[2]; va[7] = r1[3]; \
            O[d] = mfma16(va, pb, O[d]); } } } }
#define ATT_WRITE(KS_, VS_) { const int r_ = tid >> 3, ch_ = tid & 7; \
      *(u32x4*)((KS_) + r_ * KP + ch_ * 8) = pk0; *(u32x4*)((VS_) + r_ * KP + ch_ * 8) = pv0; \
      *(u32x4*)((KS_) + (r_ + 64) * KP + ch_ * 8) = pk1; *(u32x4*)((VS_) + (r_ + 64) * KP + ch_ * 8) = pv1; }
    bf16_t* const K0 = KVb; bf16_t* const V0 = KVb + 128 * KP; bf16_t* const K1 = KVb + 256 * KP; bf16_t* const V1 = K1 + 128 * KP;
    const bool paired = (tix0 == 0 && nblk > 0 && nblk < 63);
    int tix = (tix0 == 0 && nblk == 0) ? 1 : tix0;
    int par = 0;
    __syncthreads();
    if (paired) {
      ATT_ISSUE(0)
      ATT_WRITE(K0, V0)
      ATT_ISSUE(2)
      ATT_WRITE(K1, V1)
      __syncthreads();
      ATT_ISSUE(1)
      ATT_TILE(K0, V0, 1, w, 7)
      ATT_TILE(K1, V1, 2, 0, w)
      __syncthreads();
      tix = 1;
    } else {
      ATT_ISSUE(tix)
    }
#pragma unroll 1
    while (tix < 5) {
      int nx = tix + 1;
      if (nx == 2 && (nblk == 63 || paired)) nx = 3;
      const int mode = tix == 0 ? 1 : (tix == 2 ? 2 : 0);
      bf16_t* Ks = par ? K1 : K0; bf16_t* Vs = par ? V1 : V0; par ^= 1;
      ATT_WRITE(Ks, Vs)
      __syncthreads();
      if (nx < 5) ATT_ISSUE(nx)
      const int klo = (mode == 1) ? w : 0, khi = (mode == 2) ? w : 7;
      ATT_TILE(Ks, Vs, mode, klo, khi)
      tix = nx;
    }
#undef ATT_TILE
#undef ATT_WRITE
#undef ATT_ISSUE
    float l_tot = l_part; l_tot += __shfl_xor(l_tot, 16); l_tot += __shfl_xor(l_tot, 32);
    const float inv = 1.0f / l_tot;
#pragma unroll
    for (int d = 0; d < 4; ++d) {
      const int dd = 16 * d + 4 * quad;
      const u32x2 zv = *(const u32x2*)(WSP(bf16_t, O_PROJ) + qrow * 2560 + 1536 + h * 64 + dd);
      const float v0 = O[d][0] * inv * silu_f(bflo(zv[0])), v1 = O[d][1] * inv * silu_f(bfhi(zv[0]));
      const float v2 = O[d][2] * inv * silu_f(bflo(zv[1])), v3 = O[d][3] * inv * silu_f(bfhi(zv[1]));
      u32x2 ov; ov[0] = pk2(v0, v1); ov[1] = pk2(v2, v3);
      *(u32x2*)(WSP(bf16_t, O_OG) + qrow * 1024 + h * 64 + dd) = ov;
    }
  }
}

constexpr int R_CW = 0, R_UCF = 4096, R_UCS = 37888, R_US = 55296, R_HS = 126016;
constexpr int UFP = 132, USP = 136;
__device__ __forceinline__ int rho_row(int t) { return 16 * ((t >> 2) & 3) + 4 * (t >> 4) + (t & 3); }

template <bool REV, bool WANT_H>
__device__ __forceinline__ float scan16(float (&a)[4][4], float (&x)[4][4], float cin, int l15, int quad, float& A_tile) {
  float A = 1.f, H = 0.f;
#pragma unroll
  for (int mm = 0; mm < 4; ++mm)
#pragma unroll
    for (int jj = 0; jj < 4; ++jj) {
      const int mi = REV ? 3 - mm : mm, j = REV ? 3 - jj : jj;
      H = a[mi][j] * H + x[mi][j]; A *= a[mi][j];
    }
  const float A0 = __shfl(A, l15), A1 = __shfl(A, l15 + 16), A2 = __shfl(A, l15 + 32), A3 = __shfl(A, l15 + 48);
  const float H0 = __shfl(H, l15), H1 = __shfl(H, l15 + 16), H2 = __shfl(H, l15 + 32), H3 = __shfl(H, l15 + 48);
  A_tile = (A0 * A1) * (A2 * A3);
  float cc = cin, cl = cin;
  if (!REV) {
    if (quad == 0) cl = cc; cc = A0 * cc + H0;
    if (quad == 1) cl = cc; cc = A1 * cc + H1;
    if (quad == 2) cl = cc; cc = A2 * cc + H2;
    if (quad == 3) cl = cc; cc = A3 * cc + H3;
  } else {
    if (quad == 3) cl = cc; cc = A3 * cc + H3;
    if (quad == 2) cl = cc; cc = A2 * cc + H2;
    if (quad == 1) cl = cc; cc = A1 * cc + H1;
    if (quad == 0) cl = cc; cc = A0 * cc + H0;
  }
  if (WANT_H) {
    float h = cl;
#pragma unroll
    for (int mm = 0; mm < 4; ++mm)
#pragma unroll
      for (int jj = 0; jj < 4; ++jj) {
        const int mi = REV ? 3 - mm : mm, j = REV ? 3 - jj : jj;
        h = a[mi][j] * h + x[mi][j]; x[mi][j] = h;
      }
  }
  return cc;
}

template <int PASS>
__device__ __forceinline__ void rglru_phase(const Params& p, char* lds) {
  const int tid = threadIdx.x, lane = tid & 63, w = tid >> 6, l15 = lane & 15, quad = lane >> 4;
  float* cw = (float*)(lds + R_CW); float* ucf = (float*)(lds + R_UCF); bf16_t* ucs = (bf16_t*)(lds + R_UCS); bf16_t* us = (bf16_t*)(lds + R_US);
  const int tg_lo = (int)(((long long)blockIdx.x * 5280) / gridDim.x), tg_hi = (int)(((long long)(blockIdx.x + 1) * 5280) / gridDim.x);
  const int it_lo = tg_lo >> 2, it_hi = (tg_hi + 3) >> 2;
  const int cl = 16 * w + l15;
  bf16x8 wf[4][4];
  float bra[2], bri[2], sp[2];
  int cur_hd = -1;
  for (int item = it_lo; item < it_hi; ++item) {
    const int hd = item / 132, rem = item % 132, b = rem / 33, grp = rem % 33;
    const int ch = hd * 128 + cl;
    int idx0, row_base, seq_lo, seq_hi;
    if (grp == 0) { idx0 = 0; row_base = ML + b * 256; seq_lo = row_base; seq_hi = seq_lo + 256; }
    else { idx0 = 4 + 4 * (grp - 1); row_base = b * 8192 + 256 * (grp - 1); seq_lo = b * 8192; seq_hi = seq_lo + 8192; }
    __syncthreads();
    for (int c = tid; c < 259 * 16; c += NTHR) {
      const int r = c >> 4, c8 = (c & 15) * 8;
      const int grow = row_base - 2 + r;
      u32x4 v = {0u, 0u, 0u, 0u};
      if (grow >= seq_lo && grow < seq_hi) v = *(const u32x4*)(WSP(bf16_t, O_PROJ) + (size_t)grow * 2560 + hd * 128 + c8);
      *(u32x4*)(us + r * USP + c8) = v;
    }
    if (hd != cur_hd) {
      cur_hd = hd;
#pragma unroll
      for (int g4 = 0; g4 < 4; ++g4) {
        const int gt = g4 & 1, d = g4 >> 1;
        const bf16_t* wp = WSP(bf16_t, O_WT_GATE) + ((size_t)((gt * 2 + d) * 10 + hd) * 128 + cl) * 128 + 8 * quad;
#pragma unroll
        for (int kk = 0; kk < 4; ++kk) wf[g4][kk] = *(const bf16x8*)(wp + 32 * kk);
      }
#pragma unroll
      for (int d = 0; d < 2; ++d) {
        bra[d] = -1.4426950408889634f * p.c_b_ra[d * 1280 + ch]; bri[d] = -1.4426950408889634f * p.c_b_ri[d * 1280 + ch];
        const float nl = -p.c_lam[d * 1280 + ch];
        sp[d] = (-8.0f * 1.4426950408889634f) * (fmaxf(nl, 0.f) + log1pf(expf(-fabsf(nl))));
      }
      for (int i = tid; i < 640; i += NTHR) {
        const int r = i >> 7, cc = i & 127;
        cw[i] = (r < 4) ? p.c_conv_w[r * 1280 + hd * 128 + cc] : p.c_conv_b[hd * 128 + cc];
      }
    }
    __syncthreads();
    const int tl0 = max(tg_lo - 4 * item, 0), tl1 = min(tg_hi - 4 * item, 4);
    for (int tile = tl0; tile < tl1; ++tile) {
      const int idx = idx0 + tile, row0 = row_base + 64 * tile;
      const int tt = tid >> 3, c0 = (tid & 7) * 16;
      float cin0 = 0.f, cin1 = 0.f; u32x4 z0 = {0u, 0u, 0u, 0u}, z1 = {0u, 0u, 0u, 0u};
      if (PASS == 2) {
        cin0 = WSP(float, O_CI)[((size_t)((0 * 4 + b) * 132 + idx)) * 1280 + ch];
        cin1 = WSP(float, O_CI)[((size_t)((1 * 4 + b) * 132 + idx)) * 1280 + ch];
        const bf16_t* zp = WSP(bf16_t, O_PROJ) + (size_t)(row0 + tt) * 2560 + 1280 + hd * 128 + c0;
        z0 = *(const u32x4*)zp; z1 = *(const u32x4*)(zp + 8);
      }
      {
        float accv[16];
#pragma unroll
        for (int e = 0; e < 4; ++e) { const f32x4 bv = *(const f32x4*)(cw + 512 + c0 + 4 * e); accv[4 * e] = bv[0]; accv[4 * e + 1] = bv[1]; accv[4 * e + 2] = bv[2]; accv[4 * e + 3] = bv[3]; }
#pragma unroll
        for (int j4 = 0; j4 < 4; ++j4) {
          const bf16_t* up = us + (64 * tile + tt + j4) * USP + c0;
          const u32x4 u0 = *(const u32x4*)up, u1 = *(const u32x4*)(up + 8);
          float wv[16];
#pragma unroll
          for (int e = 0; e < 4; ++e) { const f32x4 t4 = *(const f32x4*)(cw + j4 * 128 + c0 + 4 * e); wv[4 * e] = t4[0]; wv[4 * e + 1] = t4[1]; wv[4 * e + 2] = t4[2]; wv[4 * e + 3] = t4[3]; }
#pragma unroll
          for (int e = 0; e < 4; ++e) {
            accv[2 * e] += bflo(u0[e]) * wv[2 * e]; accv[2 * e + 1] += bfhi(u0[e]) * wv[2 * e + 1];
            accv[8 + 2 * e] += bflo(u1[e]) * wv[8 + 2 * e]; accv[8 + 2 * e + 1] += bfhi(u1[e]) * wv[8 + 2 * e + 1];
          }
        }
        const int rr = rho_row(tt);
#pragma unroll
        for (int e = 0; e < 4; ++e) *(f32x4*)(ucf + rr * UFP + c0 + 4 * e) = (f32x4){accv[4 * e], accv[4 * e + 1], accv[4 * e + 2], accv[4 * e + 3]};
        u32x4 o0, o1;
#pragma unroll
        for (int e = 0; e < 4; ++e) { o0[e] = pk2(accv[2 * e], accv[2 * e + 1]); o1[e] = pk2(accv[8 + 2 * e], accv[8 + 2 * e + 1]); }
        *(u32x4*)(ucs + rr * USP + c0) = o0; *(u32x4*)(ucs + rr * USP + c0 + 8) = o1;
      }
      __syncthreads();
      f32x4 acc[4][4];
#pragma unroll
      for (int mi = 0; mi < 4; ++mi)
#pragma unroll
        for (int g4 = 0; g4 < 4; ++g4) acc[mi][g4] = (f32x4){0.f, 0.f, 0.f, 0.f};
#pragma unroll
      for (int kk = 0; kk < 4; ++kk)
#pragma unroll
        for (int mi = 0; mi < 4; ++mi) {
          const bf16x8 af = *(const bf16x8*)(ucs + (16 * mi + l15) * USP + 32 * kk + 8 * quad);
#pragma unroll
          for (int g4 = 0; g4 < 4; ++g4) acc[mi][g4] = mfma16(af, wf[g4][kk], acc[mi][g4]);
        }
      float ucv[4][4];
#pragma unroll
      for (int mi = 0; mi < 4; ++mi)
#pragma unroll
        for (int j = 0; j < 4; ++j) ucv[mi][j] = ucf[(16 * mi + 4 * quad + j) * UFP + cl];
      float hsum[4][4];
#pragma unroll
      for (int d = 0; d < 2; ++d) {
        float av[4][4], xv[4][4];
#pragma unroll
        for (int mi = 0; mi < 4; ++mi)
#pragma unroll
          for (int j = 0; j < 4; ++j) {
            const float rg = __builtin_amdgcn_rcpf(1.0f + __builtin_amdgcn_exp2f(acc[mi][2 * d][j] + bra[d]));
            const float ig = __builtin_amdgcn_rcpf(1.0f + __builtin_amdgcn_exp2f(acc[mi][2 * d + 1][j] + bri[d]));
            const float aa = __builtin_amdgcn_exp2f(rg * sp[d]);
            av[mi][j] = aa;
            xv[mi][j] = __builtin_amdgcn_sqrtf(fmaxf(1.0f - aa * aa, 0.f)) * ig * ucv[mi][j];
          }
        float at;
        if (PASS == 1) {
          const float hend = d ? scan16<true, false>(av, xv, 0.f, l15, quad, at) : scan16<false, false>(av, xv, 0.f, l15, quad, at);
          const size_t tci = ((size_t)((d * 4 + b) * 132 + idx)) * 1280 + ch;
          if (quad == 0) *(f32x2*)(WSP(float, O_TC) + tci * 2) = (f32x2){at, hend};
        } else {
          if (d) scan16<true, true>(av, xv, cin1, l15, quad, at); else scan16<false, true>(av, xv, cin0, l15, quad, at);
#pragma unroll
          for (int mi = 0; mi < 4; ++mi)
#pragma unroll
            for (int j = 0; j < 4; ++j) hsum[mi][j] = d ? hsum[mi][j] + xv[mi][j] : xv[mi][j];
        }
      }
      if (PASS == 1) __syncthreads();
      if (PASS == 2) {
        float* hsb = (float*)(lds + R_HS);
#pragma unroll
        for (int mi = 0; mi < 4; ++mi)
#pragma unroll
          for (int j = 0; j < 4; ++j) hsb[(16 * mi + 4 * quad + j) * UFP + cl] = hsum[mi][j];
        __syncthreads();
        const size_t row = (size_t)(row0 + tt);
        const int rr = rho_row(tt);
        float hv[16];
#pragma unroll
        for (int e = 0; e < 4; ++e) { const f32x4 t4 = *(const f32x4*)(hsb + rr * UFP + c0 + 4 * e); hv[4 * e] = t4[0]; hv[4 * e + 1] = t4[1]; hv[4 * e + 2] = t4[2]; hv[4 * e + 3] = t4[3]; }
        u32x4 o0, o1;
#pragma unroll
        for (int e = 0; e < 4; ++e) {
          o0[e] = pk2(hv[2 * e] * silu_f(bflo(z0[e])), hv[2 * e + 1] * silu_f(bfhi(z0[e])));
          o1[e] = pk2(hv[8 + 2 * e] * silu_f(bflo(z1[e])), hv[8 + 2 * e + 1] * silu_f(bfhi(z1[e])));
        }
        *(u32x4*)(WSP(bf16_t, O_OG) + row * 1280 + hd * 128 + c0) = o0; *(u32x4*)(WSP(bf16_t, O_OG) + row * 1280 + hd * 128 + c0 + 8) = o1;
      }
    }
  }
}

__device__ __forceinline__ void rglru_scan_phase(const Params& p, char* lds) {
  const int tid = threadIdx.x;
  f32x2* L = (f32x2*)lds;
  float* Cc = (float*)(lds + 132 * 40 * 8);
  for (int blk = blockIdx.x; blk < 256; blk += gridDim.x) {
    const int dir = blk >> 7, b = (blk & 127) >> 5, ch0 = (blk & 31) * 40;
    const size_t base = (size_t)((dir * 4 + b) * 132) * 1280 + ch0;
    __syncthreads();
    for (int e = tid; e < 132 * 40; e += NTHR) {
      const int idx = e / 40, cc = e % 40;
      L[e] = *(const f32x2*)(WSP(float, O_TC) + (base + (size_t)idx * 1280 + cc) * 2);
    }
    __syncthreads();
    if (tid < 40) {
      float carry = 0.f;
      for (int s = 0; s < 132; ++s) {
        int idx;
        if (dir == 0) idx = s; else idx = (s < 4) ? 3 - s : 135 - s;
        const f32x2 v = L[idx * 40 + tid];
        Cc[idx * 40 + tid] = carry;
        carry = v[0] * carry + v[1];
      }
    }
    __syncthreads();
    for (int e = tid; e < 132 * 40; e += NTHR) {
      const int idx = e / 40, cc = e % 40;
      WSP(float, O_CI)[base + (size_t)idx * 1280 + cc] = Cc[e];
    }
  }
}

#define XB_TMO      128
#define XB_XCNT(j)  (256  + 64 * (j))
#define XB_XSUB(j)  (1280 + 64 * (j))
#define XB_XGEN(j)  (2304 + 64 * (j))
#define XB_TOP      3328
#define XB_TOPGEN   3392
#define XCD_BAR_WORDS 3456
#define XB_SPIN_CAP (1u << 18)
#define LAS __attribute__((address_space(3)))

__device__ __forceinline__ unsigned xb_ld(unsigned* p)              { return __hip_atomic_load(p, __ATOMIC_RELAXED, __HIP_MEMORY_SCOPE_AGENT); }
__device__ __forceinline__ unsigned xb_add(unsigned* p, unsigned v) { return __hip_atomic_fetch_add(p, v, __ATOMIC_RELAXED, __HIP_MEMORY_SCOPE_AGENT); }
__device__ __forceinline__ unsigned xb_xcc_id() { return (unsigned)__builtin_amdgcn_s_getreg((3 << 11) | 20) & 0xFu; }
#define XB_SPIN(cond, bar) do { unsigned _sp = 0; while (cond) { __builtin_amdgcn_s_sleep(1); \
    if ((++_sp & 255u) == 0u) { if (xb_ld(&(bar)[XB_TMO])) break; if (_sp > XB_SPIN_CAP) { atomicAdd(&(bar)[XB_TMO], 1u); break; } } } } while (0)

struct XcdBarrier {
    unsigned* bar; unsigned x;
    volatile LAS unsigned* st;
};

__device__ __forceinline__ XcdBarrier xcd_barrier_post(unsigned* bar, volatile LAS unsigned* st) {
    XcdBarrier b; b.bar = bar; b.x = xb_xcc_id(); b.st = st;
    if (threadIdx.x == 0) (void)xb_add(&bar[XB_XCNT(b.x)], 1u);
    return b;
}
__device__ __forceinline__ void xcd_barrier_complete(unsigned* bar, unsigned x, unsigned& nloc, unsigned& nx) {
    const unsigned G = gridDim.x * gridDim.y * gridDim.z;
    unsigned sum, cnt, mine, sp = 0u;
    for (;;) {
        sum = 0u; cnt = 0u; mine = 0u;
#pragma unroll
        for (unsigned j = 0; j < 16; ++j) { const unsigned c = xb_ld(&bar[XB_XCNT(j)]); sum += c; cnt += (c > 0u) ? 1u : 0u; mine = (j == x) ? c : mine; }
        if (sum == G) break;
        __builtin_amdgcn_s_sleep(1);
        if ((++sp & 255u) == 0u) { if (xb_ld(&bar[XB_TMO])) break; if (sp > XB_SPIN_CAP) { atomicAdd(&bar[XB_TMO], 1u); break; } }
    }
    nloc = mine > 0u ? mine : 1u; nx = cnt > 0u ? cnt : 1u;
}

__device__ __forceinline__ void xcd_barrier(const XcdBarrier& b) {
    asm volatile("s_waitcnt vmcnt(0)" ::: "memory");
    __syncthreads();
    if (threadIdx.x == 0) {
        unsigned* bar = b.bar;
        __builtin_amdgcn_s_waitcnt(0);
        unsigned nloc = b.st[0], nx = b.st[1];
        if (nloc == 0u) { xcd_barrier_complete(bar, b.x, nloc, nx); b.st[0] = nloc; b.st[1] = nx; }
        const unsigned old = xb_add(&bar[XB_XSUB(b.x)], 1u);
        const unsigned gen = old / nloc;
        if (old + 1u == (gen + 1u) * nloc) {
            __builtin_amdgcn_fence(__ATOMIC_RELEASE, "agent");
            asm volatile("s_waitcnt vmcnt(0)" ::: "memory");
            const unsigned og = xb_add(&bar[XB_TOP], 1u);
            const unsigned tg = og / nx;
            if (og + 1u == (tg + 1u) * nx) xb_add(&bar[XB_TOPGEN], 1u);
            else XB_SPIN(xb_ld(&bar[XB_TOPGEN]) == tg, bar);
            __builtin_amdgcn_fence(__ATOMIC_ACQUIRE, "agent");
            xb_add(&bar[XB_XGEN(b.x)], 1u);
            asm volatile("s_waitcnt vmcnt(0)" ::: "memory");
        } else {
            XB_SPIN(xb_ld(&bar[XB_XGEN(b.x)]) == gen, bar);
            __builtin_amdgcn_fence(__ATOMIC_ACQUIRE, "agent");
            asm volatile("s_waitcnt vmcnt(0)" ::: "memory");
        }
    }
    __syncthreads();
}


__device__ __forceinline__ void post_phase(const Params& p, int layer) {
  post_rows(p, layer, blockIdx.x * 8 + (threadIdx.x >> 6), gridDim.x * 8, (layer == 3) ? ML : MT);
}
__device__ __forceinline__ void post_phase_ctx_overlap(const Params& p, int layer, const bf16_t* og_ctx, const bf16_t* wt, int K, char* lds, int vb) {
  const int tid = threadIdx.x, w = tid >> 6;
  if (vb < 16) {
    pg8::Gemm g{og_ctx, wt, MC, 1024, K};
    GSched S{4, 16, 16, vb};
    GEpi<0> E{WSP(bf16_t, O_Y) + (size_t)ML * 1024, 1024, WSP(float, O_G1), WSP(float, O_ROPE)};
    pg8::gemm_phase<GEpi<0>, GSched, true, true>((PG8_LAS unsigned char*)lds, g, S, E);
    unsigned* cnt = (unsigned*)(p.ws + O_BAR) + 3584 + 64 * layer;
    asm volatile("s_waitcnt vmcnt(0)" ::: "memory");
    __syncthreads();
    if (tid == 0) {
      __builtin_amdgcn_fence(__ATOMIC_RELEASE, "agent");
      asm volatile("s_waitcnt vmcnt(0)" ::: "memory");
      xb_add(cnt, 1u);
      unsigned spn = 0;
      while (xb_ld(cnt) < 16u) { __builtin_amdgcn_s_sleep(1); if (++spn > (1u << 20)) break; }
      __builtin_amdgcn_fence(__ATOMIC_ACQUIRE, "agent");
      asm volatile("s_waitcnt vmcnt(0)" ::: "memory");
    }
    __syncthreads();
    post_rows(p, layer, ML + vb * 8 + w, 16 * 8, MT);
  } else {
    post_rows(p, layer, (vb - 16) * 8 + w, 240 * 8, ML);
  }
}

template <class T> __device__ __forceinline__ T* uni_ptr(T* v) {
  const unsigned long long u = (unsigned long long)v;
  const unsigned lo = __builtin_amdgcn_readfirstlane((unsigned)u), hi = __builtin_amdgcn_readfirstlane((unsigned)(u >> 32));
  typedef __attribute__((address_space(1))) T GT;
  GT* g = (GT*)(((unsigned long long)hi << 32) | lo);
  return (T*)g;
}
__device__ __forceinline__ Params load_params(const Params& s) {
  Params q;
  q.x = uni_ptr(s.x); q.c = uni_ptr(s.c); q.ctx = uni_ptr(s.ctx); q.c_ctx = uni_ptr(s.c_ctx); q.w_mod = uni_ptr(s.w_mod); q.b_mod = uni_ptr(s.b_mod);
  q.g_pre = uni_ptr(s.g_pre); q.g_post = uni_ptr(s.g_post);
  q.a_w_in = uni_ptr(s.a_w_in); q.a_w_g1 = uni_ptr(s.a_w_g1); q.a_w_g2 = uni_ptr(s.a_w_g2); q.a_b_g = uni_ptr(s.a_b_g); q.a_g_head = uni_ptr(s.a_g_head); q.a_w_out = uni_ptr(s.a_w_out);
  q.b_w_in = uni_ptr(s.b_w_in); q.b_sink = uni_ptr(s.b_sink); q.b_w_out = uni_ptr(s.b_w_out);
  q.c_w_in = uni_ptr(s.c_w_in); q.c_conv_w = uni_ptr(s.c_conv_w); q.c_conv_b = uni_ptr(s.c_conv_b); q.c_w_ra = uni_ptr(s.c_w_ra); q.c_b_ra = uni_ptr(s.c_b_ra);
  q.c_w_ri = uni_ptr(s.c_w_ri); q.c_b_ri = uni_ptr(s.c_b_ri); q.c_lam = uni_ptr(s.c_lam); q.c_w_out = uni_ptr(s.c_w_out);
  q.out = uni_ptr(s.out); q.ws = uni_ptr(s.ws);
  return q;
}
#define PH(k, call) if (ph_lo <= (k) && (k) < ph_hi) { if ((k) > ph_lo) xcd_barrier(xb); { const Params p = load_params(sp); call; } }
#define PHR(k, rep, call) if (ph_lo <= (k) && (k) < ph_hi) { if ((k) > ph_lo) xcd_barrier(xb); { const Params p = load_params(sp); for (int rr_ = 0; rr_ < (rep); ++rr_) { call; } } }
__global__ void __launch_bounds__(512) mega(Params pk, int ph_lo, int ph_hi) {
  extern __shared__ __attribute__((aligned(16))) char lds[];
  __shared__ __attribute__((aligned(16))) Params sp;
  __shared__ uint4 xb_words;
  if (threadIdx.x == 0) { sp = pk; xb_words = make_uint4(0u, 0u, 0u, 0u); }
  __syncthreads();
  XcdBarrier xb; xb.bar = (unsigned*)(pk.ws + O_BAR); xb.x = xb_xcc_id(); xb.st = (volatile LAS unsigned*)&xb_words;
  if (threadIdx.x == 0) xb_words.z = xb_add(&xb.bar[XB_XCNT(xb.x)], 1u);
  __syncthreads();
  int vb = blockIdx.x;
  cg::grid_group grid = cg::this_grid();
  if (ph_hi < 0) grid.sync();
#ifdef DIAG_PHASE
  ph_lo = DIAG_PHASE; ph_hi = DIAG_PHASE + 1;
#endif
  PHR(0, REP_PRO, prologue_phase(p, lds))
  PHR(1, REP_PRO, post_phase(p, -1))
  if (ph_lo < 2) {
    bool uni = (gridDim.x == 256);
    for (int j = 0; j < 16; ++j) { const unsigned cnt = xb_ld(&xb.bar[XB_XCNT(j)]); uni = uni && (cnt == (j < 8 ? 32u : 0u)); }
    const unsigned rk = xb_words.z;
    if (uni && xb.x < 8 && rk < 32) vb = __builtin_amdgcn_readfirstlane((int)(xb.x * 32 + rk));
  }
  PHR(2, REP_G, gemm8<1>(p, WSP(bf16_t, O_H), WSP(bf16_t, O_WT_A_IN), 33792, NA_IN, 1024, WSP(bf16_t, O_PROJ), 3072, lds, vb))
  PHR(3, REP_GLA, gla_p1(p, 0, 1, lds))
  PH(4, gla_scan_phase(p, 0, 1, lds))
  PHR(5, REP_GLA, gla_p2(p, 0, 0, lds))
  PHR(6, REP_G, gemm8<0>(p, WSP(bf16_t, O_OG), WSP(bf16_t, O_WT_A_OUT), 32768, 1024, 1024, WSP(bf16_t, O_Y), 1024, lds, vb))
  PH(7, post_phase_ctx_overlap(p, 0, WSP(bf16_t, O_OG) + (size_t)ML * 1024, WSP(bf16_t, O_WT_A_OUT), 1024, lds, vb))
  PHR(8, REP_G, gemm8<2>(p, WSP(bf16_t, O_H), WSP(bf16_t, O_WT_B_IN), 33792, 2560, 1024, WSP(bf16_t, O_PROJ), 2560, lds, vb))
  PHR(9, REP_ATT, attn_phase(p, 1, lds))
  PHR(10, REP_G, gemm8<0>(p, WSP(bf16_t, O_OG), WSP(bf16_t, O_WT_B_OUT), 32768, 1024, 1024, WSP(bf16_t, O_Y), 1024, lds, vb))
  PH(11, post_phase_ctx_overlap(p, 1, WSP(bf16_t, O_OG) + (size_t)ML * 1024, WSP(bf16_t, O_WT_B_OUT), 1024, lds, vb))
  PHR(12, REP_G, gemm8<0>(p, WSP(bf16_t, O_H), WSP(bf16_t, O_WT_C_IN), 33792, 2560, 1024, WSP(bf16_t, O_PROJ), 2560, lds, vb))
  PHR(13, REP_R, rglru_phase<1>(p, lds))
  PHR(14, REP_R, rglru_scan_phase(p, lds))
  PHR(15, REP_R, rglru_phase<2>(p, lds))
  PHR(16, REP_G, gemm8<0>(p, WSP(bf16_t, O_OG), WSP(bf16_t, O_WT_C_OUT), 32768, 1024, 1280, WSP(bf16_t, O_Y), 1024, lds, vb))
  PH(17, post_phase_ctx_overlap(p, 2, WSP(bf16_t, O_OG) + (size_t)ML * 1280, WSP(bf16_t, O_WT_C_OUT), 1280, lds, vb))
  PHR(18, REP_G, gemm8<1>(p, WSP(bf16_t, O_H), WSP(bf16_t, O_WT_A_IN) + (size_t)NA_IN * 1024, 33792, NA_IN, 1024, WSP(bf16_t, O_PROJ), 3072, lds, vb))
  PHR(19, REP_GLA, gla_p1(p, 1, 0, lds))
  PH(20, gla_scan_phase(p, 1, 0, lds))
  PHR(21, REP_GLA, gla_p2(p, 1, 0, lds))
  PHR(22, REP_G, gemm8<0>(p, WSP(bf16_t, O_OG), WSP(bf16_t, O_WT_A_OUT) + (size_t)1024 * 1024, 32768, 1024, 1024, WSP(bf16_t, O_Y), 1024, lds, vb))
  PH(23, post_phase(p, 3))
}

extern "C" void kernel_launch(void* const* d_in, const int* in_sizes, int n_in, void* d_out, int out_size, void* d_ws, size_t ws_size, hipStream_t stream) {
  Params p{};
  const float* const* in = (const float* const*)d_in;
  p.x = in[0]; p.c = in[1]; p.ctx = in[2]; p.c_ctx = in[3]; p.w_mod = in[4]; p.b_mod = in[5]; p.g_pre = in[6]; p.g_post = in[7];
  p.a_w_in = in[8]; p.a_w_g1 = in[9]; p.a_w_g2 = in[10]; p.a_b_g = in[11]; p.a_g_head = in[12]; p.a_w_out = in[13];
  p.b_w_in = in[14]; p.b_sink = in[15]; p.b_w_out = in[16];
  p.c_w_in = in[17]; p.c_conv_w = in[18]; p.c_conv_b = in[19]; p.c_w_ra = in[20]; p.c_b_ra = in[21]; p.c_w_ri = in[22]; p.c_b_ri = in[23]; p.c_lam = in[24]; p.c_w_out = in[25];
  p.out = (float*)d_out;
  p.ws = (char*)d_ws;
  if (WS_NEED > ws_size) { fprintf(stderr, "workspace too small: need %zu have %zu\n", (size_t)WS_NEED, ws_size); return; }

  hipMemsetAsync((char*)d_ws + O_BAR, 0, 16384, stream);
  hipFuncSetAttribute((const void*)mega, hipFuncAttributeMaxDynamicSharedMemorySize, LDS_BYTES);
  int dev = 0, cus = 0, per_cu = 0;
  hipGetDevice(&dev);
  hipDeviceGetAttribute(&cus, hipDeviceAttributeMultiprocessorCount, dev);
  hipOccupancyMaxActiveBlocksPerMultiprocessor(&per_cu, mega, NTHR, LDS_BYTES);
  if (per_cu < 1) per_cu = 1;
  if (per_cu > 1) per_cu = 1;
  int grid = cus * per_cu;
#if ONE_LAUNCH
  int lo = 0, hi = NPH;
  void* args[] = {&p, &lo, &hi};
  hipError_t e = hipLaunchCooperativeKernel((const void*)mega, dim3(grid), dim3(NTHR), args, LDS_BYTES, stream);
  if (e != hipSuccess) fprintf(stderr, "cooperative launch failed: %s (grid %d)\n", hipGetErrorString(e), grid);
#else
  for (int ph = 0; ph < NPH; ++ph) {
    hipLaunchKernelGGL(mega, dim3(grid), dim3(NTHR), LDS_BYTES, stream, p, ph, ph + 1);
  }
#endif
}
```

```cpp
#include <hip/hip_runtime.h>
#include <hip/hip_cooperative_groups.h>
#include <cstdio>
namespace cg = cooperative_groups;

typedef unsigned short bf16_t;
typedef short bf16x8 __attribute__((ext_vector_type(8)));
typedef short s16x4 __attribute__((ext_vector_type(4)));
typedef float f32x4 __attribute__((ext_vector_type(4)));
typedef float f32x2 __attribute__((ext_vector_type(2)));
typedef unsigned u32x2 __attribute__((ext_vector_type(2)));
typedef unsigned u32x4 __attribute__((ext_vector_type(4)));

#ifndef REP_G
#define REP_G 1
#endif
#ifndef REP_GLA
#define REP_GLA 1
#endif
#ifndef REP_ATT
#define REP_ATT 1
#endif
#ifndef REP_R
#define REP_R 1
#endif
#ifndef REP_PRO
#define REP_PRO 1
#endif
#ifndef ONE_LAUNCH
#define ONE_LAUNCH 1
#endif

constexpr int NTHR = 512;
constexpr int DM = 1024;
constexpr int ML = 32768;
constexpr int MC = 1024;
constexpr int MT = ML + MC;
constexpr int NA_IN = 3328;
constexpr int LDS_BYTES = 159808;
constexpr int NPH = 24;
constexpr float EPS = 1e-6f;

struct Params {
  const float *x, *c, *ctx, *c_ctx, *w_mod, *b_mod, *g_pre, *g_post;
  const float *a_w_in, *a_w_g1, *a_w_g2, *a_b_g, *a_g_head, *a_w_out;
  const float *b_w_in, *b_sink, *b_w_out;
  const float *c_w_in, *c_conv_w, *c_conv_b, *c_w_ra, *c_b_ra, *c_w_ri, *c_b_ri, *c_lam, *c_w_out;
  float* out;
  char* ws;
};


constexpr size_t al256(size_t x) { return (x + 255) & ~(size_t)255; }
constexpr size_t O_WT_A_IN = 0;
constexpr size_t O_WT_A_OUT = O_WT_A_IN + al256((size_t)2 * NA_IN * 1024 * 2);
constexpr size_t O_WT_B_IN = O_WT_A_OUT + al256((size_t)2 * 1024 * 1024 * 2);
constexpr size_t O_WT_B_OUT = O_WT_B_IN + al256((size_t)2560 * 1024 * 2);
constexpr size_t O_WT_C_IN = O_WT_B_OUT + al256((size_t)1024 * 1024 * 2);
constexpr size_t O_WT_C_OUT = O_WT_C_IN + al256((size_t)2560 * 1024 * 2);
constexpr size_t O_WT_GATE = O_WT_C_OUT + al256((size_t)1024 * 1280 * 2);
constexpr size_t O_MOD = O_WT_GATE + al256((size_t)40 * 128 * 128 * 2);
constexpr size_t O_ROPE = O_MOD + al256((size_t)4 * 5 * 3072 * 4);
constexpr size_t O_G1 = O_ROPE + al256((size_t)128 * 16 * 2 * 4);
constexpr size_t O_XC = O_G1 + al256((size_t)MT * 32 * 4);
constexpr size_t O_H = O_XC + al256((size_t)MC * 1024 * 4);
constexpr size_t O_Y = O_H + al256((size_t)MT * 1024 * 2);
constexpr size_t O_PROJ = O_Y + al256((size_t)MT * 1024 * 2);
constexpr size_t O_OG = O_PROJ + al256((size_t)MT * 3072 * 2);
constexpr size_t O_BAR = O_OG + al256((size_t)MT * 1280 * 2);
constexpr size_t WS_NEED = O_BAR + 16384;
constexpr size_t O_OF = O_H;
constexpr size_t O_SEG_E = O_Y;
constexpr size_t O_SEG_D = O_Y + (size_t)512 * 16 * 512 * 16;
constexpr size_t O_TC = O_Y;
constexpr size_t O_CI = O_Y + (size_t)16 * 1024 * 1024;
static_assert(WS_NEED <= (size_t)512 * 1024 * 1024, "workspace map exceeds 512 MiB");
#define WSP(T, off) ((T*)(p.ws + (off)))

__device__ __forceinline__ unsigned short f2bf(float f) { unsigned u = __float_as_uint(f); u += 0x7fffu + ((u >> 16) & 1u); return (unsigned short)(u >> 16); }
__device__ __forceinline__ float bf2f(unsigned short h) { return __uint_as_float(((unsigned)h) << 16); }
typedef __bf16 bf16v2_t __attribute__((ext_vector_type(2)));
__device__ __forceinline__ unsigned pk2(float a, float b) {
  f32x2 v = {a, b}; bf16v2_t r = __builtin_convertvector(v, bf16v2_t); return __builtin_bit_cast(unsigned, r);
}
__device__ __forceinline__ float bflo(unsigned u) { return __uint_as_float(u << 16); }
__device__ __forceinline__ float bfhi(unsigned u) { return __uint_as_float(u & 0xffff0000u); }
__device__ __forceinline__ float silu_f(float x) { return x * __builtin_amdgcn_rcpf(1.f + __expf(-x)); }
__device__ __forceinline__ float sigm_f(float x) { return __builtin_amdgcn_rcpf(1.f + __expf(-x)); }
__device__ __forceinline__ f32x4 mfma16(bf16x8 a, bf16x8 b, f32x4 c) { return __builtin_amdgcn_mfma_f32_16x16x32_bf16(a, b, c, 0, 0, 0); }
__device__ __forceinline__ s16x4 tr_read(const bf16_t* p) {
  return __builtin_amdgcn_ds_read_tr16_b64_v4i16((__attribute__((address_space(3))) s16x4*)p);
}
__device__ __forceinline__ bf16x8 frag_tr(const bf16_t* tile, int pitch, int krow0, int col0, int lane) {
  const int g = lane >> 4, q = (lane & 15) >> 2, pp = lane & 3;
  const bf16_t* a = tile + (krow0 + 8 * g + q) * pitch + col0 + 4 * pp;
  s16x4 r0 = tr_read(a), r1 = tr_read(a + 4 * pitch);
  bf16x8 o; o[0] = r0[0]; o[1] = r0[1]; o[2] = r0[2]; o[3] = r0[3]; o[4] = r1[0]; o[5] = r1[1]; o[6] = r1[2]; o[7] = r1[3];
  return o;
}
__device__ __forceinline__ bf16x8 pack8(f32x4 a, f32x4 b) {
  union { bf16x8 v; unsigned u[4]; } r;
  r.u[0] = pk2(a[0], a[1]); r.u[1] = pk2(a[2], a[3]); r.u[2] = pk2(b[0], b[1]); r.u[3] = pk2(b[2], b[3]);
  return r.v;
}
template <class T> __device__ __forceinline__ T* sb_ptr(T* v) {
  const unsigned long long u = (unsigned long long)v;
  const unsigned lo = __builtin_amdgcn_readfirstlane((unsigned)u), hi = __builtin_amdgcn_readfirstlane((unsigned)(u >> 32));
  typedef __attribute__((address_space(1))) T GT;
  GT* g = (GT*)(((unsigned long long)hi << 32) | lo);
  return (T*)g;
}
__device__ __forceinline__ float wave_sum(float v) {
#pragma unroll
  for (int o = 32; o > 0; o >>= 1) v += __shfl_xor(v, o);
  return v;
}

__device__ __forceinline__ void conv_tile_wave(const float* __restrict__ src, int K, int N, bf16_t* __restrict__ dst, int ldk, int tk, int tn, float* T, int lane, float wscale) {
  const int k0 = tk * 64, n0 = tn * 64;
  const int c4 = (lane & 15) * 4, r0 = lane >> 4;
  f32x4 v[16];
#pragma unroll
  for (int i = 0; i < 16; ++i) {
    const int k = k0 + r0 + 4 * i, n = n0 + c4;
    v[i] = (f32x4){0.f, 0.f, 0.f, 0.f};
    if (n + 3 < N) v[i] = *(const f32x4*)(src + (size_t)k * N + n);
  }
#pragma unroll
  for (int i = 0; i < 16; ++i) { float* t = T + (r0 + 4 * i) * 65 + c4; t[0] = v[i][0] * wscale; t[1] = v[i][1] * wscale; t[2] = v[i][2] * wscale; t[3] = v[i][3] * wscale; }
  const int k8 = (lane & 7) * 8;
#pragma unroll
  for (int i = 0; i < 8; ++i) {
    const int n = (lane >> 3) + 8 * i;
    if (n0 + n < N) {
      u32x4 o;
      o[0] = pk2(T[(k8 + 0) * 65 + n], T[(k8 + 1) * 65 + n]);
      o[1] = pk2(T[(k8 + 2) * 65 + n], T[(k8 + 3) * 65 + n]);
      o[2] = pk2(T[(k8 + 4) * 65 + n], T[(k8 + 5) * 65 + n]);
      o[3] = pk2(T[(k8 + 6) * 65 + n], T[(k8 + 7) * 65 + n]);
      *(u32x4*)(dst + (size_t)(n0 + n) * ldk + k0 + k8) = o;
    }
  }
}

__device__ __forceinline__ void prologue_phase(const Params& p, char* lds) {
  const int tid = threadIdx.x;
  constexpr int NJ = 12 + 40;
  float* Tw = (float*)lds + (tid >> 6) * (64 * 65);
  for (int t = blockIdx.x * 8 + (tid >> 6); t < 4128; t += gridDim.x * 8) {
    int r = t;
    const float* src; bf16_t* dst; int K, N, ldk; float wscale = 1.0f;
    if (r < 1536) { int j = r / 768; r %= 768; K = 1024; N = 3072; src = p.a_w_in + (size_t)j * 1024 * 3072; dst = WSP(bf16_t, O_WT_A_IN) + (size_t)j * NA_IN * 1024; ldk = 1024; }
    else if ((r -= 1536) < 64) { int jd = r / 16; r %= 16; K = 1024; N = 16; src = p.a_w_g1 + (size_t)jd * 1024 * 16; dst = WSP(bf16_t, O_WT_A_IN) + (size_t)(jd >> 1) * NA_IN * 1024 + (size_t)(3072 + 16 * (jd & 1)) * 1024; ldk = 1024; }
    else if ((r -= 64) < 512) { int j = r / 256; r %= 256; K = 1024; N = 1024; src = p.a_w_out + (size_t)j * 1024 * 1024; dst = WSP(bf16_t, O_WT_A_OUT) + (size_t)j * 1024 * 1024; ldk = 1024; }
    else if ((r -= 512) < 640) { K = 1024; N = 2560; src = p.b_w_in; dst = WSP(bf16_t, O_WT_B_IN); ldk = 1024; }
    else if ((r -= 640) < 256) { K = 1024; N = 1024; src = p.b_w_out; dst = WSP(bf16_t, O_WT_B_OUT); ldk = 1024; }
    else if ((r -= 256) < 640) { K = 1024; N = 2560; src = p.c_w_in; dst = WSP(bf16_t, O_WT_C_IN); ldk = 1024; }
    else if ((r -= 640) < 320) { K = 1280; N = 1024; src = p.c_w_out; dst = WSP(bf16_t, O_WT_C_OUT); ldk = 1280; }
    else { r -= 320; int m = r / 4; r %= 4; K = 128; N = 128; ldk = 128; wscale = -1.4426950408889634f;
      src = (m < 20 ? p.c_w_ra + (size_t)m * 16384 : p.c_w_ri + (size_t)(m - 20) * 16384); dst = WSP(bf16_t, O_WT_GATE) + (size_t)m * 16384; }
    const int tnn = (N + 63) / 64;
    conv_tile_wave(src, K, N, dst, ldk, r / tnn, r % tnn, Tw, tid & 63, wscale);
  }
  (void)NJ;
  for (int i = blockIdx.x * NTHR + tid; i < 2 * 224 * 1024 / 8; i += gridDim.x * NTHR) {
    const int j = i / (224 * 128), r = i % (224 * 128);
    *(u32x4*)(WSP(bf16_t, O_WT_A_IN) + (size_t)j * NA_IN * 1024 + (size_t)3104 * 1024 + (size_t)r * 8) = (u32x4){0u, 0u, 0u, 0u};
  }
  for (int i = blockIdx.x * NTHR + tid; i < 2048; i += gridDim.x * NTHR) {
    const int pos = i >> 4, k = i & 15;
    const float f = powf(10000.0f, -(float)k / 16.0f);
    const float ang = (float)pos * f;
    float s, c; sincosf(ang, &s, &c);
    WSP(float, O_ROPE)[2 * i] = c; WSP(float, O_ROPE)[2 * i + 1] = s;
  }
  {
    float* sv = (float*)lds;
    float* red = (float*)(lds + 20480);
    __syncthreads();
    for (int i = tid; i < 5 * 1024; i += NTHR) {
      const int r = i >> 10, k = i & 1023;
      const float v = (r < 4) ? p.c[r * 1024 + k] : p.c_ctx[k];
      sv[i] = silu_f(v);
    }
    __syncthreads();
    const int lane = tid & 63, w = tid >> 6;
    for (int it = blockIdx.x; it < 4 * 48; it += gridDim.x) {
      const int layer = it / 48, n0 = (it % 48) * 64;
      const float* W = p.w_mod + (size_t)layer * 1024 * 3072 + n0 + lane;
      float a0 = 0.f, a1 = 0.f, a2 = 0.f, a3 = 0.f, a4 = 0.f;
#pragma unroll 8
      for (int k = w * 128; k < w * 128 + 128; ++k) {
        const float wv = W[(size_t)k * 3072];
        a0 += sv[k] * wv; a1 += sv[1024 + k] * wv; a2 += sv[2048 + k] * wv; a3 += sv[3072 + k] * wv; a4 += sv[4096 + k] * wv;
      }
      red[(w * 5 + 0) * 64 + lane] = a0; red[(w * 5 + 1) * 64 + lane] = a1; red[(w * 5 + 2) * 64 + lane] = a2;
      red[(w * 5 + 3) * 64 + lane] = a3; red[(w * 5 + 4) * 64 + lane] = a4;
      __syncthreads();
      if (tid < 320) {
        const int r = tid >> 6, l = tid & 63;
        float s = p.b_mod[layer * 3072 + n0 + l];
#pragma unroll
        for (int ww = 0; ww < 8; ++ww) s += red[(ww * 5 + r) * 64 + l];
        WSP(float, O_MOD)[((size_t)layer * 5 + r) * 3072 + n0 + l] = s;
      }
      __syncthreads();
    }
  }
}

__device__ __forceinline__ void post_rows(const Params& p, int layer, int m_first, int stride, int nrows) {
  const int tid = threadIdx.x, lane = tid & 63;
  const int nl = layer + 1;
  float gpv[16], gprev[16], gatev[16], scv[16], shv[16];
#pragma unroll
  for (int hh = 0; hh < 2; ++hh)
#pragma unroll
    for (int q4 = 0; q4 < 2; ++q4) {
      const int e0 = hh * 512 + lane * 8 + 4 * q4;
      if (layer >= 0) { const f32x4 t = *(const f32x4*)(p.g_post + layer * DM + e0); gpv[hh * 8 + 4 * q4] = t[0]; gpv[hh * 8 + 4 * q4 + 1] = t[1]; gpv[hh * 8 + 4 * q4 + 2] = t[2]; gpv[hh * 8 + 4 * q4 + 3] = t[3]; }
      if (layer < 3) { const f32x4 t = *(const f32x4*)(p.g_pre + nl * DM + e0); gprev[hh * 8 + 4 * q4] = t[0]; gprev[hh * 8 + 4 * q4 + 1] = t[1]; gprev[hh * 8 + 4 * q4 + 2] = t[2]; gprev[hh * 8 + 4 * q4 + 3] = t[3]; }
    }
  int cur_mb = -1;
  f32x4 xr[4]; u32x4 yr[2];
#define POST_LOAD(mm) { const float* xin_ = ((mm) < ML) ? ((layer <= 0) ? p.x + (size_t)(mm) * DM : p.out + (size_t)(mm) * DM) \
                                                     : ((layer <= 0) ? p.ctx + (size_t)((mm) - ML) * DM : WSP(float, O_XC) + (size_t)((mm) - ML) * DM); \
    xr[0] = *(const f32x4*)(xin_ + lane * 8); xr[1] = *(const f32x4*)(xin_ + lane * 8 + 4); xr[2] = *(const f32x4*)(xin_ + 512 + lane * 8); xr[3] = *(const f32x4*)(xin_ + 512 + lane * 8 + 4); \
    if (layer >= 0) { yr[0] = *(const u32x4*)(WSP(bf16_t, O_Y) + (size_t)(mm) * DM + lane * 8); yr[1] = *(const u32x4*)(WSP(bf16_t, O_Y) + (size_t)(mm) * DM + 512 + lane * 8); } }
  int m = m_first;
  if (m < nrows) POST_LOAD(m)
  while (m < nrows) {
    const int mn = m + stride;
    float xv[16], yv[16];
#pragma unroll
    for (int hh = 0; hh < 2; ++hh)
#pragma unroll
      for (int i = 0; i < 4; ++i) {
        xv[hh * 8 + i] = xr[2 * hh][i]; xv[hh * 8 + 4 + i] = xr[2 * hh + 1][i];
        if (layer >= 0) { yv[hh * 8 + 2 * i] = bflo(yr[hh][i]); yv[hh * 8 + 2 * i + 1] = bfhi(yr[hh][i]); }
      }
    if (mn < nrows) POST_LOAD(mn)
    const int mb = (m < ML) ? (m >> 13) : 4;
    if (mb != cur_mb) {
      cur_mb = mb;
#pragma unroll
      for (int hh = 0; hh < 2; ++hh)
#pragma unroll
        for (int q4 = 0; q4 < 2; ++q4) {
          const int e0 = hh * 512 + lane * 8 + 4 * q4, o = hh * 8 + 4 * q4;
          if (layer >= 0) { const f32x4 t = *(const f32x4*)(WSP(float, O_MOD) + ((size_t)layer * 5 + mb) * 3072 + 2048 + e0); gatev[o] = t[0]; gatev[o + 1] = t[1]; gatev[o + 2] = t[2]; gatev[o + 3] = t[3]; }
          if (layer < 3) {
            const float* sh = WSP(float, O_MOD) + ((size_t)nl * 5 + mb) * 3072 + e0;
            const f32x4 t = *(const f32x4*)sh, u = *(const f32x4*)(sh + 1024);
            shv[o] = t[0]; shv[o + 1] = t[1]; shv[o + 2] = t[2]; shv[o + 3] = t[3];
            scv[o] = 1.0f + u[0]; scv[o + 1] = 1.0f + u[1]; scv[o + 2] = 1.0f + u[2]; scv[o + 3] = 1.0f + u[3];
          }
        }
    }
    float* xout = (m < ML) ? p.out + (size_t)m * DM : WSP(float, O_XC) + (size_t)(m - ML) * DM;
    if (layer >= 0) {
      float ss = 0.f;
#pragma unroll
      for (int i = 0; i < 16; ++i) ss += yv[i] * yv[i];
      ss = wave_sum(ss);
      const float r = rsqrtf(ss * (1.0f / 1024.0f) + EPS);
#pragma unroll
      for (int hh = 0; hh < 2; ++hh) {
        const int e0 = hh * 512 + lane * 8;
        f32x4 o0, o1;
#pragma unroll
        for (int i = 0; i < 8; ++i) {
          const float v = xv[hh * 8 + i] + gatev[hh * 8 + i] * (yv[hh * 8 + i] * r * gpv[hh * 8 + i]);
          xv[hh * 8 + i] = v;
          if (i < 4) o0[i] = v; else o1[i - 4] = v;
        }
        *(f32x4*)(xout + e0) = o0; *(f32x4*)(xout + e0 + 4) = o1;
      }
    }
    if (layer < 3) {
      float ss = 0.f;
#pragma unroll
      for (int i = 0; i < 16; ++i) ss += xv[i] * xv[i];
      ss = wave_sum(ss);
      const float r = rsqrtf(ss * (1.0f / 1024.0f) + EPS);
#pragma unroll
      for (int hh = 0; hh < 2; ++hh) {
        const int e0 = hh * 512 + lane * 8;
        float hv[8];
#pragma unroll
        for (int i = 0; i < 8; ++i) hv[i] = xv[hh * 8 + i] * r * gprev[hh * 8 + i] * scv[hh * 8 + i] + shv[hh * 8 + i];
        u32x4 o; o[0] = pk2(hv[0], hv[1]); o[1] = pk2(hv[2], hv[3]); o[2] = pk2(hv[4], hv[5]); o[3] = pk2(hv[6], hv[7]);
        *(u32x4*)(WSP(bf16_t, O_H) + (size_t)m * DM + e0) = o;
      }
    }
    m = mn;
  }
#undef POST_LOAD
}

template <int EPI>
__device__ __forceinline__ void gemm_phase(const Params& p, const bf16_t* __restrict__ A, int lda, const bf16_t* __restrict__ Bt, int N, int K,
                           bf16_t* __restrict__ C, int ldc, int mtiles, char* lds, int vb) {
  const int tid = threadIdx.x, lane = tid & 63, w = tid >> 6, l15 = lane & 15, quad = lane >> 4;
  const int wm = w >> 1, wn = w & 1;
  const int ntn = N / 128, ntiles = mtiles * ntn, nk = K / 64;
  bf16_t* As0 = (bf16_t*)lds; bf16_t* Bs0 = As0 + 256 * 64;
  bf16_t* As1 = (bf16_t*)(lds + 49152); bf16_t* Bs1 = As1 + 256 * 64;
  const int lrow = tid >> 3, lch = (tid & 7) * 8;
  const int wsw = (((tid & 7) ^ (lrow & 7)) * 8);
  const int rsw = l15 & 7;
  u32x4 s0a0, s0a1, s0a2, s0a3, s0b0, s0b1, s1a0, s1a1, s1a2, s1a3, s1b0, s1b1, s2a0, s2a1, s2a2, s2a3, s2b0, s2b1;
  const bf16_t* Ag = A; const bf16_t* Bg = Bt;
  int m0 = 0, n0 = 0;
#define G_TILE_PTRS(t_) { const int band_ = (t_) / (4 * ntn), qq_ = (t_) % (4 * ntn); \
      m0 = (4 * band_ + (qq_ & 3)) * 256; n0 = (qq_ >> 2) * 128; \
      Ag = A + (size_t)(m0 + lrow) * lda + lch; Bg = Bt + (size_t)(n0 + lrow) * K + lch; }
#define G_LOAD(S, kt_) { const int ko_ = (kt_) * 64; \
      S##a0 = *(const u32x4*)(Ag + ko_); S##a1 = *(const u32x4*)(Ag + (size_t)64 * lda + ko_); S##a2 = *(const u32x4*)(Ag + (size_t)128 * lda + ko_); S##a3 = *(const u32x4*)(Ag + (size_t)192 * lda + ko_); \
      S##b0 = *(const u32x4*)(Bg + ko_); S##b1 = *(const u32x4*)(Bg + (size_t)64 * K + ko_); }
#define G_WRITE(S, buf_) { bf16_t* a_ = ((buf_) ? As1 : As0) + lrow * 64 + wsw; bf16_t* b_ = ((buf_) ? Bs1 : Bs0) + lrow * 64 + wsw; \
      *(u32x4*)a_ = S##a0; *(u32x4*)(a_ + 64 * 64) = S##a1; *(u32x4*)(a_ + 128 * 64) = S##a2; *(u32x4*)(a_ + 192 * 64) = S##a3; \
      *(u32x4*)b_ = S##b0; *(u32x4*)(b_ + 64 * 64) = S##b1; }
#define G_COMP(ks) { \
        bf16x8 xf[4], wf[4]; \
        _Pragma("unroll") for (int i = 0; i < 4; ++i) { \
          xf[i] = *(const bf16x8*)(as + (wm * 64 + i * 16 + l15) * 64 + ((((ks) * 4 + quad) ^ rsw) * 8)); \
          wf[i] = *(const bf16x8*)(bs + (wn * 64 + i * 16 + l15) * 64 + ((((ks) * 4 + quad) ^ rsw) * 8)); } \
        _Pragma("unroll") for (int mi = 0; mi < 4; ++mi) \
          _Pragma("unroll") for (int ni = 0; ni < 4; ++ni) acc[mi][ni] = mfma16(wf[ni], xf[mi], acc[mi][ni]); }
#define G_BODY(kt_, S) { \
      if ((kt_) + 1 < nk) { G_WRITE(S, ((kt_) + 1) & 1) if ((kt_) + 4 < nk) G_LOAD(S, (kt_) + 4) } \
      const bf16_t* as = ((kt_) & 1) ? As1 : As0; const bf16_t* bs = ((kt_) & 1) ? Bs1 : Bs0; \
      G_COMP(0) \
      G_COMP(1) \
      __syncthreads(); }
  int t = vb;
  if (t < ntiles) { G_TILE_PTRS(t) G_LOAD(s0, 0) G_LOAD(s1, 1) G_LOAD(s2, 2) }
  while (t < ntiles) {
    f32x4 acc[4][4];
#pragma unroll
    for (int i = 0; i < 4; ++i)
#pragma unroll
      for (int j = 0; j < 4; ++j) acc[i][j] = (f32x4){0.f, 0.f, 0.f, 0.f};
    G_WRITE(s0, 0)
    G_LOAD(s0, 3)
    __syncthreads();
    for (int kt = 0; kt < nk; kt += 3) {
      G_BODY(kt, s1)
      if (kt + 1 < nk) G_BODY(kt + 1, s2)
      if (kt + 2 < nk) G_BODY(kt + 2, s0)
    }
    const int m0c = m0, n0c = n0;
    t += gridDim.x;
    if (t < ntiles) { G_TILE_PTRS(t) G_LOAD(s0, 0) G_LOAD(s1, 1) G_LOAD(s2, 2) }
    const int nw = n0c + wn * 64;
    if (EPI == 2) {
      if (nw < 1280 && m0c < ML) {
#pragma unroll
        for (int mi = 0; mi < 4; ++mi) {
          const int m = m0c + wm * 64 + mi * 16 + l15;
          const int tt = m & 8191;
#pragma unroll
          for (int pr = 0; pr < 2; ++pr) {
            const int pos = pr ? (tt & 63) : (tt >> 6);
            const float* rp = WSP(float, O_ROPE) + (size_t)(pos * 16 + quad * 4) * 2;
            const f32x4 r0 = *(const f32x4*)rp, r1 = *(const f32x4*)(rp + 4);
            const float cs[4] = {r0[0], r0[2], r1[0], r1[2]}, sn[4] = {r0[1], r0[3], r1[1], r1[3]};
#pragma unroll
            for (int j = 0; j < 4; ++j) {
              const float x1 = acc[mi][2 * pr][j], x2 = acc[mi][2 * pr + 1][j];
              acc[mi][2 * pr][j] = x1 * cs[j] - x2 * sn[j];
              acc[mi][2 * pr + 1][j] = x2 * cs[j] + x1 * sn[j];
            }
          }
        }
      }
    }
#pragma unroll
    for (int mi = 0; mi < 4; ++mi) {
      const int m = m0c + wm * 64 + mi * 16 + l15;
#pragma unroll
      for (int ni = 0; ni < 4; ++ni) {
        const int n = nw + ni * 16 + quad * 4;
        const f32x4 v = acc[mi][ni];
        if (EPI == 1) {
          if (n < 3072) { u32x2 o; o[0] = pk2(v[0], v[1]); o[1] = pk2(v[2], v[3]); *(u32x2*)(C + (size_t)m * ldc + n) = o; }
          else if (n < 3104) { *(f32x4*)(WSP(float, O_G1) + (size_t)m * 32 + (n - 3072)) = v; }
        } else {
          u32x2 o; o[0] = pk2(v[0], v[1]); o[1] = pk2(v[2], v[3]); *(u32x2*)(C + (size_t)m * ldc + n) = o;
        }
      }
    }
  }
}

#undef G_LOAD
#undef G_WRITE
#undef G_BODY
#undef G_COMP
#undef G_TILE_PTRS
namespace pg8 {
#define PG8_LAS __attribute__((address_space(3)))
typedef unsigned short bf16_t;
typedef short bf16x8 __attribute__((ext_vector_type(8)));
typedef float f32x4 __attribute__((ext_vector_type(4)));
typedef unsigned u32x4 __attribute__((ext_vector_type(4)));
constexpr int BM = 256, BK = 64, HALF = 128, HTB = HALF * BK * 2  , STAGE_BYTES = 8 * HTB, NXCD = 8, WGM = 8;

__host__ __device__ __forceinline__ int lds_byte(int r, int c) { const int st = (r >> 4) * 2 + (c >> 5), rr = r & 15, cc = c & 31, ob = rr * 64 + cc * 2; return st * 1024 + (ob ^ (((ob >> 9) & 1) << 5)); }
__host__ __device__ __forceinline__ void stage_rc(int b, int& R, int& C) { const int st = b / 1024, sb = b % 1024, swz = sb ^ (((sb >> 9) & 1) << 5); R = (st >> 1) * 16 + swz / 64; C = (st & 1) * 32 + (swz % 64) / 2; }
__host__ __device__ __forceinline__ int perm32(int rho) { const int n = rho >> 4, i = rho & 15; return 8 * (i >> 2) + 4 * n + (i & 3); }

struct Unit { int pm, pn; };
struct Gemm { const bf16_t* A; const bf16_t* Bt; int M, N, K; };

struct StaticOrder {
    int nM, nN, nwg, G, c;
    __host__ __device__ void init(int M, int N, int G_, int c_) { nM = M / BM; nN = N / BM; nwg = nM * nN; G = G_; c = c_; }
    __host__ __device__ bool next(int i, Unit& u) const {
        const long L = (long)i * G + c; if (L >= nwg) return false;
        int wgid = (int)L; { const int q = nwg / NXCD, r = nwg % NXCD, xcd = wgid % NXCD, off = wgid / NXCD; wgid = (xcd < r ? xcd * (q + 1) : r * (q + 1) + (xcd - r) * q) + off; }
        const int nig = WGM * nN, gid = wgid / nig, fm = gid * WGM, gsz = (nM - fm) < WGM ? (nM - fm) : WGM;
        u.pm = fm + ((wgid % nig) % gsz); u.pn = (wgid % nig) / gsz; return true;
    }
    __device__ __forceinline__ void a_ready(const Unit&) const {}
    __device__ __forceinline__ void done(const Unit&) const {}
};
template <class Epi, class Sched, bool ALIGN_EPI = false, bool SP2 = false>
__device__ __forceinline__ void gemm_phase(PG8_LAS unsigned char* lds, const Gemm g, const Sched& S, const Epi& E) {
    const int tid = threadIdx.x, wid = __builtin_amdgcn_readfirstlane(tid >> 6), lane = tid & 63, wr = wid >> 2, wc = wid & 3, fr = lane & 15, fq = lane >> 4;
    const int K = g.K, nt = K / BK;
    unsigned voffA[2], voffB[2];
#pragma unroll
    for (int i = 0; i < 2; ++i) { int R, C; stage_rc(tid * 16 + i * 8192, R, C); const int Rb = Epi::PERM ? ((R & ~31) + perm32(R & 31)) : R;
        voffA[i] = (unsigned)(R * K + C) * 2u; voffB[i] = (unsigned)(Rb * K + C) * 2u; }
    const size_t kstep = (size_t)(BK * 2);
    const size_t hstep = (size_t)HALF * K * 2;
    const size_t tstep = 2 * hstep;
    const unsigned ldsw = (unsigned)wid * 1024u;
    const int aoff = lds_byte(wr * 64 + fr, fq * 8), boff = lds_byte(wc * 32 + fr, fq * 8);
#define PG8_SA(b, h) (((b) * 2 + (h)) * HTB)
#define PG8_SB(b, h) ((4 + (b) * 2 + (h)) * HTB)
#define PG8_STAGE(bufoff, gbase, voff) do { _Pragma("unroll") for (int _i = 0; _i < 2; ++_i) \
        __builtin_amdgcn_global_load_lds((const unsigned*)((const char*)(gbase) + (voff)[_i]), (PG8_LAS unsigned*)(lds + (bufoff) + ldsw + _i * 8192), 16, 0, 0); } while (0)
#define PG8_LDA(dst, b, h) do { _Pragma("unroll") for (int m = 0; m < 4; ++m) _Pragma("unroll") for (int k = 0; k < 2; ++k) dst[m][k] = *(const PG8_LAS bf16x8*)(lds + PG8_SA(b, h) + aoff + m * 2048 + k * 1024); } while (0)
#define PG8_LDB(dst, b, h) do { _Pragma("unroll") for (int n = 0; n < 2; ++n) _Pragma("unroll") for (int k = 0; k < 2; ++k) dst[n][k] = *(const PG8_LAS bf16x8*)(lds + PG8_SB(b, h) + boff + n * 2048 + k * 1024); } while (0)
#define PG8_MMA(ai, bj, At, Bt) do { __builtin_amdgcn_s_setprio(1); _Pragma("unroll") for (int m = 0; m < 4; ++m) _Pragma("unroll") for (int n = 0; n < 2; ++n) _Pragma("unroll") for (int k = 0; k < 2; ++k) \
        acc[ai][bj][m][n] = __builtin_amdgcn_mfma_f32_16x16x32_bf16(Bt[n][k], At[m][k], acc[ai][bj][m][n], 0, 0, 0); __builtin_amdgcn_s_setprio(0); } while (0)
#define PG8_WAIT_V(n) asm volatile("s_waitcnt vmcnt(" #n ")" ::: "memory")
#define PG8_WAIT_L(n) asm volatile("s_waitcnt lgkmcnt(" #n ")" ::: "memory")
#define PG8_BAR __builtin_amdgcn_s_barrier()
#define PG8_SCHED __builtin_amdgcn_sched_barrier(0)
    Unit cur, nxt; int ui = 0;
    if (!S.next(0, cur)) return;
    f32x4 acc[2][2][4][2];
#pragma unroll
    for (int a = 0; a < 2; ++a)
#pragma unroll
        for (int b = 0; b < 2; ++b)
#pragma unroll
            for (int m = 0; m < 4; ++m)
#pragma unroll
                for (int n = 0; n < 2; ++n) acc[a][b][m][n] = (f32x4){0.f, 0.f, 0.f, 0.f};
    bf16x8 At[4][2], B0[2][2], B1[2][2];
    const char* cA = (const char*)g.A + (size_t)cur.pm * tstep; const char* cB = (const char*)g.Bt + (size_t)cur.pn * tstep;
    S.a_ready(cur);
    if constexpr (SP2) {
        PG8_STAGE(PG8_SB(0, 0), cB, voffB); PG8_STAGE(PG8_SB(0, 1), cB + hstep, voffB); PG8_STAGE(PG8_SA(0, 0), cA, voffA); PG8_STAGE(PG8_SA(0, 1), cA + hstep, voffA);
        if (wr == 1) PG8_BAR;
        PG8_WAIT_V(2); PG8_BAR;
        PG8_STAGE(PG8_SB(1, 0), cB + kstep, voffB); PG8_STAGE(PG8_SA(1, 0), cA + kstep, voffA); PG8_STAGE(PG8_SB(1, 1), cB + hstep + kstep, voffB);
        PG8_WAIT_V(6); PG8_BAR;
    } else {
        PG8_STAGE(PG8_SB(0, 0), cB, voffB); PG8_STAGE(PG8_SA(0, 0), cA, voffA); PG8_STAGE(PG8_SB(0, 1), cB + hstep, voffB); PG8_STAGE(PG8_SA(0, 1), cA + hstep, voffA);
        if (wr == 1) PG8_BAR;
        PG8_WAIT_V(4); PG8_BAR;
        PG8_STAGE(PG8_SB(1, 0), cB + kstep, voffB); PG8_STAGE(PG8_SA(1, 0), cA + kstep, voffA); PG8_STAGE(PG8_SB(1, 1), cB + hstep + kstep, voffB);
        PG8_WAIT_V(6); PG8_BAR;
    }
    for (;;) {
        const bool has_next = S.next(ui + 1, nxt);
        const char* nA = has_next ? (const char*)g.A + (size_t)nxt.pm * tstep : cA; const char* nB = has_next ? (const char*)g.Bt + (size_t)nxt.pn * tstep : cB;
        for (int t = 0; t < nt; t += 2) {
            const bool last = (t == nt - 2);
            const char* a1 = cA + (size_t)(t + 1) * kstep;
            const char* a2 = last ? nA : cA + (size_t)(t + 2) * kstep; const char* b2 = last ? nB : cB + (size_t)(t + 2) * kstep;
            const char* a3 = a2 + kstep; const char* b3 = b2 + kstep;
            if (last && has_next) S.a_ready(nxt);
            if constexpr (SP2) {
            PG8_LDB(B0, 0, 0); PG8_LDB(B1, 0, 1); PG8_SCHED; PG8_LDA(At, 0, 0); PG8_STAGE(PG8_SA(1, 1), a1 + hstep, voffA);
            PG8_WAIT_V(8); PG8_WAIT_L(0); PG8_BAR; PG8_MMA(0, 0, At, B0); PG8_MMA(0, 1, At, B1); PG8_BAR; PG8_SCHED;
            PG8_LDA(At, 0, 1); PG8_STAGE(PG8_SB(0, 0), b2, voffB); PG8_STAGE(PG8_SB(0, 1), b2 + hstep, voffB); PG8_STAGE(PG8_SA(0, 0), a2, voffA);
            PG8_WAIT_V(8); PG8_WAIT_L(0); PG8_BAR; PG8_MMA(1, 0, At, B0); PG8_MMA(1, 1, At, B1); PG8_BAR; PG8_SCHED;
            PG8_LDB(B0, 1, 0); PG8_LDB(B1, 1, 1); PG8_SCHED; PG8_LDA(At, 1, 0); PG8_STAGE(PG8_SA(0, 1), a2 + hstep, voffA);
            PG8_WAIT_V(8); PG8_WAIT_L(0); PG8_BAR; PG8_MMA(0, 0, At, B0); PG8_MMA(0, 1, At, B1); PG8_BAR; PG8_SCHED;
            PG8_LDA(At, 1, 1); PG8_STAGE(PG8_SB(1, 0), b3, voffB); PG8_STAGE(PG8_SB(1, 1), b3 + hstep, voffB); PG8_STAGE(PG8_SA(1, 0), a3, voffA);
            PG8_WAIT_V(8); PG8_WAIT_L(0); PG8_BAR; PG8_MMA(1, 0, At, B0); PG8_MMA(1, 1, At, B1); PG8_BAR; PG8_SCHED;
            } else {
            PG8_LDB(B0, 0, 0); PG8_SCHED; PG8_LDA(At, 0, 0); PG8_STAGE(PG8_SA(1, 1), a1 + hstep, voffA);
            PG8_WAIT_L(8); PG8_BAR; PG8_WAIT_L(0); PG8_MMA(0, 0, At, B0); PG8_BAR; PG8_SCHED;
            PG8_LDB(B1, 0, 1); PG8_STAGE(PG8_SB(0, 0), b2, voffB);
            PG8_BAR; PG8_WAIT_L(0); PG8_MMA(0, 1, At, B1); PG8_BAR;
            PG8_LDA(At, 0, 1); PG8_STAGE(PG8_SA(0, 0), a2, voffA);
            PG8_BAR; PG8_WAIT_L(0); PG8_MMA(1, 0, At, B0); PG8_BAR; PG8_SCHED;
            PG8_STAGE(PG8_SB(0, 1), b2 + hstep, voffB);
            PG8_WAIT_V(6); PG8_BAR; PG8_MMA(1, 1, At, B1); PG8_BAR;
            PG8_LDB(B0, 1, 0); PG8_SCHED; PG8_LDA(At, 1, 0); PG8_STAGE(PG8_SA(0, 1), a2 + hstep, voffA);
            PG8_WAIT_L(8); PG8_BAR; PG8_WAIT_L(0); PG8_MMA(0, 0, At, B0); PG8_BAR; PG8_SCHED;
            PG8_LDB(B1, 1, 1); PG8_STAGE(PG8_SB(1, 0), b3, voffB);
            PG8_BAR; PG8_WAIT_L(0); PG8_MMA(0, 1, At, B1); PG8_BAR;
            PG8_LDA(At, 1, 1); PG8_STAGE(PG8_SA(1, 0), a3, voffA);
            PG8_BAR; PG8_WAIT_L(0); PG8_MMA(1, 0, At, B0); PG8_BAR; PG8_SCHED;
            PG8_STAGE(PG8_SB(1, 1), b3 + hstep, voffB);
            PG8_WAIT_V(6); PG8_BAR; PG8_MMA(1, 1, At, B1); PG8_BAR;
            }
        }
        if constexpr (ALIGN_EPI) { if (wr == 0) PG8_BAR; }
        if constexpr (!Epi::AFTER_DRAIN) { E(acc, cur, wr, wc, fr, fq); S.done(cur); }
        if (!has_next) break;
#pragma unroll
        for (int a = 0; a < 2; ++a)
#pragma unroll
            for (int b = 0; b < 2; ++b)
#pragma unroll
                for (int m = 0; m < 4; ++m)
#pragma unroll
                    for (int n = 0; n < 2; ++n) acc[a][b][m][n] = (f32x4){0.f, 0.f, 0.f, 0.f};
        cur = nxt; cA = nA; cB = nB; ++ui;
        if constexpr (ALIGN_EPI) { if (wr == 1) PG8_BAR; }
    }
    PG8_WAIT_V(0);
    if constexpr (!ALIGN_EPI) { if (wr == 0) PG8_BAR; }
    PG8_BAR;
    if constexpr (Epi::AFTER_DRAIN) { E.fused(acc, cur, wr, wc, fr, fq, lds, wid, lane); S.done(cur); }
#undef PG8_SA
#undef PG8_SB
#undef PG8_STAGE
#undef PG8_LDA
#undef PG8_LDB
#undef PG8_MMA
#undef PG8_WAIT_V
#undef PG8_WAIT_L
#undef PG8_BAR
#undef PG8_SCHED
}
}

struct GSched {
  int ntn, nunits, G, c;
  __device__ __forceinline__ bool next(int i, pg8::Unit& u) const {
    const long L = (long)i * G + c; if (L >= nunits) return false;
    const int band = (int)(L / (4 * ntn)), q = (int)(L % (4 * ntn)); u.pm = 4 * band + (q & 3); u.pn = q >> 2; return true;
  }
  __device__ __forceinline__ void a_ready(const pg8::Unit&) const {}
  __device__ __forceinline__ void done(const pg8::Unit&) const {}
};
template <int EPI> struct GEpi {
  static constexpr bool PERM = (EPI != 2), AFTER_DRAIN = false;
  bf16_t* C; int ldc; float* g1; const float* rope;
  __device__ __forceinline__ void operator()(f32x4 (&acc)[2][2][4][2], const pg8::Unit& u, int wr, int wc, int fr, int fq) const {
#pragma unroll
    for (int ai = 0; ai < 2; ++ai)
#pragma unroll
      for (int m = 0; m < 4; ++m) {
        const int row = u.pm * 256 + ai * 128 + wr * 64 + m * 16 + fr;
#pragma unroll
        for (int bj = 0; bj < 2; ++bj) {
          const int cb = u.pn * 256 + bj * 128 + wc * 32;
          if (EPI == 2) {
            f32x4 v0 = acc[ai][bj][m][0], v1 = acc[ai][bj][m][1];
            if (cb < 1280 && row < ML) {
              const int tt = row & 8191;
              const int pos = (wc & 1) ? (tt & 63) : (tt >> 6);
              const float* rp = rope + (size_t)(pos * 16 + fq * 4) * 2;
              const f32x4 r0 = *(const f32x4*)rp, r1 = *(const f32x4*)(rp + 4);
              const float cs[4] = {r0[0], r0[2], r1[0], r1[2]}, sn[4] = {r0[1], r0[3], r1[1], r1[3]};
#pragma unroll
              for (int j = 0; j < 4; ++j) { const float x1 = v0[j], x2 = v1[j]; v0[j] = x1 * cs[j] - x2 * sn[j]; v1[j] = x2 * cs[j] + x1 * sn[j]; }
            }
            u32x2 o0, o1; o0[0] = pk2(v0[0], v0[1]); o0[1] = pk2(v0[2], v0[3]); o1[0] = pk2(v1[0], v1[1]); o1[1] = pk2(v1[2], v1[3]);
            bf16_t* cp = C + (size_t)row * ldc + cb + 4 * fq;
            *(u32x2*)cp = o0; *(u32x2*)(cp + 16) = o1;
          } else {
            const int col = cb + 8 * fq;
            const f32x4 v0 = acc[ai][bj][m][0], v1 = acc[ai][bj][m][1];
            if (EPI == 1 && col >= 3072) {
              if (col < 3104) { float* gp = g1 + (size_t)row * 32 + (col - 3072); *(f32x4*)gp = v0; *(f32x4*)(gp + 4) = v1; }
            } else {
              u32x4 o; o[0] = pk2(v0[0], v0[1]); o[1] = pk2(v0[2], v0[3]); o[2] = pk2(v1[0], v1[1]); o[3] = pk2(v1[2], v1[3]);
              *(u32x4*)(C + (size_t)row * ldc + col) = o;
            }
          }
        }
      }
  }
};
template <int EPI>
__device__ __forceinline__ void gemm8(const Params& p, const bf16_t* A, const bf16_t* Bt, int M, int N, int K, bf16_t* C, int ldc, char* lds, int vb) {
  pg8::Gemm g{A, Bt, M, N, K};
  GSched S{N / 256, (M / 256) * (N / 256), (int)gridDim.x, vb};
  GEpi<EPI> E{C, ldc, WSP(float, O_G1), WSP(float, O_ROPE)};
  pg8::gemm_phase<GEpi<EPI>, GSched, true, false>((PG8_LAS unsigned char*)lds, g, S, E);
}

constexpr int G_G1S = 0, G_TOT = 4096, G_BS = 6144, G_QS = 38912, G_KS = 56320, G_KHS = 73728, G_VS = 91136, G_PS = 124928, G_RED = 134144, G_WG2 = 136192;
constexpr int QP = 136, VP = 264, PP = 72;

template <int MODE>
__device__ __forceinline__ void gla_run(const Params& p, int jl, int hd, int dir, int row_first, int row_step, int nch, f32x4 (&S)[8][2], float& logD, char* lds) {
  const int tid = threadIdx.x, lane = tid & 63, w = tid >> 6, l15 = lane & 15, quad = lane >> 4;
  float* g1s = (float*)(lds + G_G1S); float* tot = (float*)(lds + G_TOT); float* bs = (float*)(lds + G_BS);
  bf16_t* qs = (bf16_t*)(lds + G_QS); bf16_t* ks_ = (bf16_t*)(lds + G_KS); bf16_t* khs = (bf16_t*)(lds + G_KHS);
  bf16_t* vs = (bf16_t*)(lds + G_VS); bf16_t* ps = (bf16_t*)(lds + G_PS); float* red = (float*)(lds + G_RED);
  float wb[4];
#pragma unroll
  for (int ks4 = 0; ks4 < 4; ++ks4) wb[ks4] = p.a_w_g2[((size_t)(jl * 2 + dir) * 16 + 4 * ks4 + quad) * 512 + hd * 128 + 16 * w + l15];
  const float bg = p.a_b_g[(jl * 2 + dir) * 512 + hd * 128 + 16 * w + l15];
  const int tl = dir ? 0 : 63;
  constexpr bool PF = (MODE == 0);
  u32x4 rq[2], rk[2], rv[4];
  f32x4 rg1 = {0.f, 0.f, 0.f, 0.f};
  const unsigned g1off = (unsigned)((tid >> 2) * 128 + (tid & 3) * 16);
  const unsigned qkoff = (unsigned)((tid >> 4) * 6144 + (tid & 15) * 16);
  const unsigned vvoff = (unsigned)((tid >> 5) * 6144 + (tid & 31) * 16);
  const unsigned eoff = (unsigned)(l15 * 2048 + (32 * w + 4 * quad) * 2);
  const unsigned zoff = (unsigned)(l15 * 6144 + (32 * w + 4 * quad) * 2);
#define GLA_ISSUE_G1(row0_) { \
    const char* g1b_ = sb_ptr((const char*)WSP(float, O_G1) + (size_t)(row0_) * 128 + dir * 64); \
    if (tid < 256) rg1 = *(const f32x4*)(g1b_ + g1off); }
#define GLA_ISSUE(row0_) { \
    const char* qb_ = sb_ptr((const char*)WSP(bf16_t, O_PROJ) + (size_t)(row0_) * 6144 + hd * 256); \
    _Pragma("unroll") for (int i = 0; i < 2; ++i) { \
      if (MODE != 0) rq[i] = *(const u32x4*)(qb_ + (qkoff + (unsigned)(i * 32 * 6144))); \
      rk[i] = *(const u32x4*)(qb_ + 1024 + (qkoff + (unsigned)(i * 32 * 6144))); } \
    const char* vb_ = sb_ptr((const char*)WSP(bf16_t, O_PROJ) + (size_t)(row0_) * 6144 + 2048 + hd * 512); \
    _Pragma("unroll") for (int i = 0; i < 4; ++i) rv[i] = *(const u32x4*)(vb_ + (vvoff + (unsigned)(i * 16 * 6144))); }
  f32x4 ghv[2];
  u32x2 pof[4][2], pz[4][2];
  float* const g1sA = g1s; float* const g1sB = (float*)(lds + G_KHS); float* const blv = tot;
  GLA_ISSUE_G1(row_first)
  if (tid < 256) *(f32x4*)(g1sA + (tid >> 2) * 16 + (tid & 3) * 4) = rg1;
  if (nch > 1) GLA_ISSUE_G1(row_first + row_step)
  __syncthreads();
  if (PF) GLA_ISSUE(row_first)
  for (int ci = 0; ci < nch; ++ci) {
    const int row0 = row_first + ci * row_step;
    if (!PF) GLA_ISSUE(row0)
    const float* const g1c = (ci & 1) ? g1sB : g1sA;
    {
      float lav[4][4];
      const int arow = 16 * (l15 >> 2) + (l15 & 3);
#pragma unroll
      for (int mt = 0; mt < 4; ++mt) {
        f32x4 acc4 = {0.f, 0.f, 0.f, 0.f};
#pragma unroll
        for (int ks4 = 0; ks4 < 4; ++ks4) acc4 = __builtin_amdgcn_mfma_f32_16x16x4f32(g1c[(arow + 4 * mt) * 16 + 4 * ks4 + quad], wb[ks4], acc4, 0, 0, 0);
#pragma unroll
        for (int j = 0; j < 4; ++j) {
          const float xg = acc4[j] + bg;
          lav[mt][j] = (fminf(xg, 0.f) - 0.6931471805599453f * __builtin_amdgcn_logf(1.0f + __builtin_amdgcn_exp2f(-1.4426950408889634f * fabsf(xg)))) * (1.0f / 16.0f);
        }
      }
      float run = 0.f;
      if (dir == 0) {
#pragma unroll
        for (int mt = 0; mt < 4; ++mt)
#pragma unroll
          for (int j = 0; j < 4; ++j) { run += lav[mt][j]; lav[mt][j] = run; }
      } else {
#pragma unroll
        for (int mt = 3; mt >= 0; --mt)
#pragma unroll
          for (int j = 3; j >= 0; --j) { run += lav[mt][j]; lav[mt][j] = run; }
      }
      const float t0 = __shfl(run, l15), t1 = __shfl(run, l15 + 16), t2 = __shfl(run, l15 + 32), t3 = __shfl(run, l15 + 48);
      float off;
      if (dir == 0) off = (quad > 0 ? t0 : 0.f) + (quad > 1 ? t1 : 0.f) + (quad > 2 ? t2 : 0.f);
      else off = (quad < 3 ? t3 : 0.f) + (quad < 2 ? t2 : 0.f) + (quad < 1 ? t1 : 0.f);
#pragma unroll
      for (int mt = 0; mt < 4; ++mt)
#pragma unroll
        for (int j = 0; j < 4; ++j) bs[(16 * quad + 4 * mt + j) * 128 + 16 * w + l15] = lav[mt][j] + off;
    }
    __syncthreads();
    if (tid < 128) { const float blt = bs[tl * 128 + tid]; logD += blt; blv[(ci & 1) * 128 + tid] = blt; }
    if (ci + 1 < nch) {
      if (tid < 256) *(f32x4*)(((ci & 1) ? g1sA : g1sB) + (tid >> 2) * 16 + (tid & 3) * 4) = rg1;
      if (ci + 2 < nch) GLA_ISSUE_G1(row0 + 2 * row_step)
    }
#pragma unroll
    for (int i = 0; i < 2; ++i) {
      const int cc = tid + 512 * i, t = cc >> 4, ch = cc & 15;
      const f32x4 b0 = *(const f32x4*)(bs + t * 128 + ch * 8), b1 = *(const f32x4*)(bs + t * 128 + ch * 8 + 4);
      float bv[8] = {b0[0], b0[1], b0[2], b0[3], b1[0], b1[1], b1[2], b1[3]};
      float kf[8], qf[8];
#pragma unroll
      for (int e = 0; e < 4; ++e) { kf[2 * e] = bflo(rk[i][e]); kf[2 * e + 1] = bfhi(rk[i][e]); }
      u32x4 ok;
#pragma unroll
      for (int e = 0; e < 4; ++e) ok[e] = pk2(kf[2 * e] * __expf(-bv[2 * e]), kf[2 * e + 1] * __expf(-bv[2 * e + 1]));
      *(u32x4*)(ks_ + t * QP + ch * 8) = ok;
      if (MODE != 0) {
#pragma unroll
        for (int e = 0; e < 4; ++e) { qf[2 * e] = bflo(rq[i][e]); qf[2 * e + 1] = bfhi(rq[i][e]); }
        u32x4 oq;
        const float qsc = 0.08838834764831845f;
#pragma unroll
        for (int e = 0; e < 4; ++e) oq[e] = pk2(qf[2 * e] * (qsc * __expf(bv[2 * e])), qf[2 * e + 1] * (qsc * __expf(bv[2 * e + 1])));
        *(u32x4*)(qs + t * QP + ch * 8) = oq;
      }
    }
#pragma unroll
    for (int i = 0; i < 4; ++i) {
      const int cc = tid + 512 * i, t = cc >> 5, ch = cc & 31;
      *(u32x4*)(vs + t * VP + ch * 8) = rv[i];
    }
    if (PF && ci + 1 < nch) GLA_ISSUE(row0 + row_step)
    const char* ofb = sb_ptr((const char*)WSP(bf16_t, O_OF) + (size_t)row0 * 2048 + hd * 512);
    if (MODE == 2) {
      __builtin_amdgcn_sched_barrier(0);
#pragma unroll
      for (int it = 0; it < 4; ++it)
#pragma unroll
        for (int et = 0; et < 2; ++et)
          pof[it][et] = *(const u32x2*)(ofb + (eoff + (unsigned)(it * 32768 + et * 32)));
      __builtin_amdgcn_sched_barrier(0);
    }
    __syncthreads();
    if (MODE != 0) {
      const int it = w >> 1;
#pragma unroll
      for (int si = 0; si < 2; ++si) {
        const int st = 2 * (w & 1) + si;
        f32x4 sc = {0.f, 0.f, 0.f, 0.f};
#pragma unroll
        for (int kk = 0; kk < 4; ++kk) {
          const bf16x8 a = *(const bf16x8*)(ks_ + (16 * st + l15) * QP + 32 * kk + 8 * quad);
          const bf16x8 b = *(const bf16x8*)(qs + (16 * it + l15) * QP + 32 * kk + 8 * quad);
          sc = mfma16(a, b, sc);
        }
        const int ii = 16 * it + l15;
#pragma unroll
        for (int j = 0; j < 4; ++j) {
          const int s = 16 * st + 4 * quad + j;
          const bool keep = dir ? (s >= ii) : (s <= ii);
          if (!keep) sc[j] = 0.f;
        }
        u32x2 o; o[0] = pk2(sc[0], sc[1]); o[1] = pk2(sc[2], sc[3]);
        *(u32x2*)(ps + ii * PP + 16 * st + 4 * quad) = o;
      }
      __syncthreads();
    }
    f32x4 o[4][2];
    if (MODE != 0) {
      bf16x8 vf[2][2];
#pragma unroll
      for (int et = 0; et < 2; ++et)
#pragma unroll
        for (int kk = 0; kk < 2; ++kk) vf[et][kk] = frag_tr(vs, VP, 32 * kk, 32 * w + 16 * et, lane);
#pragma unroll
      for (int it = 0; it < 4; ++it)
#pragma unroll
        for (int et = 0; et < 2; ++et) o[it][et] = (f32x4){0.f, 0.f, 0.f, 0.f};
#pragma unroll
      for (int it = 0; it < 4; ++it)
#pragma unroll
        for (int kk = 0; kk < 2; ++kk) {
          const bf16x8 pb = *(const bf16x8*)(ps + (16 * it + l15) * PP + 32 * kk + 8 * quad);
#pragma unroll
          for (int et = 0; et < 2; ++et) o[it][et] = mfma16(vf[et][kk], pb, o[it][et]);
        }
#pragma unroll
      for (int m = 0; m < 4; ++m) {
        bf16x8 sf[2];
#pragma unroll
        for (int et = 0; et < 2; ++et) sf[et] = pack8(S[2 * m][et], S[2 * m + 1][et]);
#pragma unroll
        for (int it = 0; it < 4; ++it) {
          const bf16_t* qp = qs + (16 * it + l15) * QP + 32 * m + 4 * quad;
          const s16x4 q0 = *(const s16x4*)qp, q1 = *(const s16x4*)(qp + 16);
          bf16x8 qb; qb[0] = q0[0]; qb[1] = q0[1]; qb[2] = q0[2]; qb[3] = q0[3]; qb[4] = q1[0]; qb[5] = q1[1]; qb[6] = q1[2]; qb[7] = q1[3];
#pragma unroll
          for (int et = 0; et < 2; ++et) o[it][et] = mfma16(sf[et], qb, o[it][et]);
        }
      }
    }
    if (MODE == 1) {
#pragma unroll
      for (int it = 0; it < 4; ++it)
#pragma unroll
        for (int et = 0; et < 2; ++et) {
          u32x2 ov; ov[0] = pk2(o[it][et][0], o[it][et][1]); ov[1] = pk2(o[it][et][2], o[it][et][3]);
          *(u32x2*)((char*)ofb + (eoff + (unsigned)(it * 32768 + et * 32))) = ov;
        }
    }
    if (MODE == 2) {
#pragma unroll
      for (int it = 0; it < 4; ++it)
#pragma unroll
        for (int et = 0; et < 2; ++et)
          pz[it][et] = *(const u32x2*)(sb_ptr((const char*)WSP(bf16_t, O_PROJ) + (size_t)row0 * 6144 + 4096 + hd * 512) + (zoff + (unsigned)(it * 16 * 6144 + et * 32)));
#pragma unroll
      for (int et = 0; et < 2; ++et) ghv[et] = *(const f32x4*)(p.a_g_head + (size_t)(jl * 4 + hd) * 256 + 32 * w + 16 * et + 4 * quad);
#pragma unroll
      for (int it = 0; it < 4; ++it) {
        float s = 0.f;
#pragma unroll
        for (int et = 0; et < 2; ++et) {
          const u32x2 pv = pof[it][et];
          o[it][et][0] += bflo(pv[0]); o[it][et][1] += bfhi(pv[0]); o[it][et][2] += bflo(pv[1]); o[it][et][3] += bfhi(pv[1]);
#pragma unroll
          for (int j = 0; j < 4; ++j) s += o[it][et][j] * o[it][et][j];
        }
        s += __shfl_xor(s, 16); s += __shfl_xor(s, 32);
        if (quad == 0) red[(16 * it + l15) * 8 + w] = s;
      }
      __syncthreads();
#pragma unroll
      for (int it = 0; it < 4; ++it) {
        const f32x4 r0 = *(const f32x4*)(red + (16 * it + l15) * 8), r1 = *(const f32x4*)(red + (16 * it + l15) * 8 + 4);
        const float tot2 = (r0[0] + r0[1]) + (r0[2] + r0[3]) + (r1[0] + r1[1]) + (r1[2] + r1[3]);
        const float rn = rsqrtf(tot2 * (1.0f / 256.0f) + EPS);
        const size_t row = (size_t)(row0 + 16 * it + l15);
#pragma unroll
        for (int et = 0; et < 2; ++et) {
          const int e = 32 * w + 16 * et + 4 * quad;
          const f32x4 gh = ghv[et];
          const u32x2 zv = pz[it][et];
          const float z0 = bflo(zv[0]), z1 = bfhi(zv[0]), z2 = bflo(zv[1]), z3 = bfhi(zv[1]);
          const float v0 = o[it][et][0] * rn * gh[0] * silu_f(z0), v1 = o[it][et][1] * rn * gh[1] * silu_f(z1);
          const float v2 = o[it][et][2] * rn * gh[2] * silu_f(z2), v3 = o[it][et][3] * rn * gh[3] * silu_f(z3);
          u32x2 ov; ov[0] = pk2(v0, v1); ov[1] = pk2(v2, v3);
          *(u32x2*)(sb_ptr((char*)WSP(bf16_t, O_OG) + (size_t)row0 * 2048 + hd * 512) + (eoff + (unsigned)(it * 32768 + et * 32))) = ov;
        }
      }
    }
    bf16x8 vf2[2][2];
#pragma unroll
    for (int et = 0; et < 2; ++et)
#pragma unroll
      for (int kk = 0; kk < 2; ++kk) vf2[et][kk] = frag_tr(vs, VP, 32 * kk, 32 * w + 16 * et, lane);
#pragma unroll
    for (int dt = 0; dt < 8; ++dt) {
#pragma unroll
      for (int kk = 0; kk < 2; ++kk) {
        const bf16x8 ka = frag_tr(ks_, QP, 32 * kk, 16 * dt, lane);
#pragma unroll
        for (int et = 0; et < 2; ++et) S[dt][et] = mfma16(ka, vf2[et][kk], S[dt][et]);
      }
    }
#pragma unroll
    for (int dt = 0; dt < 8; ++dt) {
      const f32x4 bl = *(const f32x4*)(blv + (ci & 1) * 128 + 16 * dt + 4 * quad);
      f32x4 sc; sc[0] = __expf(bl[0]); sc[1] = __expf(bl[1]); sc[2] = __expf(bl[2]); sc[3] = __expf(bl[3]);
#pragma unroll
      for (int et = 0; et < 2; ++et) S[dt][et] = S[dt][et] * sc;
    }
  }
}

#undef GLA_ISSUE
#undef GLA_ISSUE_G1
__device__ __forceinline__ void gla_p1(const Params& p, int jl, int ctx_out, char* lds) {
  const int tid = threadIdx.x;
  for (int item = blockIdx.x; item < 512; item += gridDim.x) {
    const int u = item & 15, rec = item >> 4;
    const int dir = rec & 1, hd = (rec >> 1) & 3, b = rec >> 3;
    f32x4 S[8][2];
#pragma unroll
    for (int i = 0; i < 8; ++i) { S[i][0] = (f32x4){0.f, 0.f, 0.f, 0.f}; S[i][1] = (f32x4){0.f, 0.f, 0.f, 0.f}; }
    float logD = 0.f;
    int row_first, step, nch;
    if (u == 0) { nch = 4; row_first = ML + b * 256 + (dir ? 192 : 0); step = dir ? -64 : 64; }
    else { const int pp = u - 1; const int ts = dir ? 15 - pp : pp; nch = 8; row_first = b * 8192 + ts * 512 + (dir ? 448 : 0); step = dir ? -64 : 64; }
    gla_run<0>(p, jl, hd, dir, row_first, step, nch, S, logD, lds);
    f32x4* E = (f32x4*)WSP(float, O_SEG_E) + (size_t)item * 16 * 512;
#pragma unroll
    for (int dt = 0; dt < 8; ++dt)
#pragma unroll
      for (int et = 0; et < 2; ++et) E[(dt * 2 + et) * 512 + tid] = S[dt][et];
    if (tid < 128) WSP(float, O_SEG_D)[(size_t)item * 128 + tid] = __expf(logD);
    if (ctx_out && u == 0) {
      const int pi = rec >> 1, want = (pi < 8) ? (pi & 1) : 1 - (pi & 1);
      if (dir == want) {
#pragma unroll
        for (int i = 0; i < 8; ++i) { S[i][0] = (f32x4){0.f, 0.f, 0.f, 0.f}; S[i][1] = (f32x4){0.f, 0.f, 0.f, 0.f}; }
        float dummy = 0.f;
        gla_run<1>(p, jl, hd, 0, ML + b * 256, 64, 4, S, dummy, lds);
      }
    }
  }
}

__device__ __forceinline__ void gla_scan_phase(const Params& p, int jl, int ctx_out, char* lds) {
  const int tid = threadIdx.x;
  const int nskip = ctx_out ? 16 : 0;
  if ((int)blockIdx.x < nskip) {
    const int hd = blockIdx.x & 3, b = blockIdx.x >> 2;
    f32x4 S[8][2];
#pragma unroll
    for (int i = 0; i < 8; ++i) { S[i][0] = (f32x4){0.f, 0.f, 0.f, 0.f}; S[i][1] = (f32x4){0.f, 0.f, 0.f, 0.f}; }
    float dummy = 0.f;
    gla_run<2>(p, jl, hd, 1, ML + b * 256 + 192, -64, 4, S, dummy, lds);
    return;
  }
  f32x4* Eall = (f32x4*)WSP(float, O_SEG_E);
  const float* Dall = WSP(float, O_SEG_D);
  for (int slot = ((int)blockIdx.x - nskip) * NTHR + tid; slot < 32 * 8192; slot += ((int)gridDim.x - nskip) * NTHR) {
    const int rec = slot >> 13, q = slot & 8191;
    const int dt = (q >> 9) >> 1, quad = ((q & 511) & 63) >> 4;
    f32x4* E = Eall + (size_t)(rec * 16) * 8192 + q;
    const float* D = Dall + (size_t)(rec * 16) * 128 + 16 * dt + 4 * quad;
    f32x4 ev[16];
#pragma unroll
    for (int u = 0; u < 16; ++u) ev[u] = E[(size_t)u * 8192];
    f32x4 S = ev[0];
#pragma unroll
    for (int u = 1; u < 16; ++u) {
      const f32x4 dv = *(const f32x4*)(D + (size_t)u * 128);
      S = S * dv + ev[u];
      E[(size_t)u * 8192] = S;
    }
  }
}

__device__ __forceinline__ void gla_fold(const Params& p, int rec, int upto, f32x4 (&S)[8][2]) {
  const int tid = threadIdx.x;
  if (upto < 0) {
#pragma unroll
    for (int dt = 0; dt < 8; ++dt) { S[dt][0] = (f32x4){0.f, 0.f, 0.f, 0.f}; S[dt][1] = (f32x4){0.f, 0.f, 0.f, 0.f}; }
    return;
  }
  const f32x4* E = (const f32x4*)WSP(float, O_SEG_E) + (size_t)(rec * 16 + upto) * 16 * 512;
#pragma unroll
  for (int dt = 0; dt < 8; ++dt)
#pragma unroll
    for (int et = 0; et < 2; ++et) S[dt][et] = E[(dt * 2 + et) * 512 + tid];
}

__device__ __forceinline__ void gla_p2(const Params& p, int jl, int ctx_out, char* lds) {
  const int nitems = 256 + (ctx_out ? 16 : 0);
  for (int item0 = blockIdx.x; item0 < nitems; item0 += gridDim.x) {
    int item = item0;
    bool is_ctx = false;
    if (ctx_out) { if (item0 < 16) is_ctx = true; else item = item0 - 16; }
    int hd, b, ts, nch, nch1, rf0, rf1;
    if (is_ctx) { hd = item & 3; b = item >> 2; ts = 0; nch = 4; nch1 = 0; rf0 = ML + b * 256; rf1 = rf0 + 192; }
    else { ts = item & 15; hd = (item >> 4) & 3; b = item >> 6; nch = 8; nch1 = 8; rf0 = b * 8192 + ts * 512; rf1 = rf0 + 448; }
    const int rec0 = (b * 4 + hd) * 2;
    f32x4 S[8][2];
    float logD = 0.f;
    gla_fold(p, rec0, is_ctx ? -1 : ts, S);
    gla_run<1>(p, jl, hd, 0, rf0, 64, nch1, S, logD, lds);
    gla_fold(p, rec0 + 1, is_ctx ? -1 : 15 - ts, S);
    gla_run<2>(p, jl, hd, 1, rf1, -64, nch, S, logD, lds);
  }
}

constexpr int KP = 72;
constexpr float QSC = 0.125f * 1.4426950408889634f;
__device__ __forceinline__ void attn_phase(const Params& p, int ctx_out, char* lds) {
  const int tid = threadIdx.x, lane = tid & 63, w = tid >> 6, l15 = lane & 15, quad = lane >> 4;
  bf16_t* KVb = (bf16_t*)lds;
  const int nitems = 4096 + (ctx_out ? 128 : 0);
  for (int item = blockIdx.x; item < nitems; item += gridDim.x) {
    int b, h, qrow0, nblk, tix0;
    if (item < 4096) {
      nblk = item & 63; h = (item >> 6) & 15; b = item >> 10;
      qrow0 = b * 8192 + nblk * 128; tix0 = 0;
    } else {
      const int it = item - 4096; const int cb = it & 1; h = (it >> 1) & 15; b = it >> 5;
      qrow0 = ML + b * 256 + cb * 128; nblk = 1; tix0 = 3;
    }
    const int hk = h >> 2;
    const int ii = 16 * w + l15;
    const size_t qrow = (size_t)(qrow0 + ii);
    bf16x8 qf[2];
#pragma unroll
    for (int kk = 0; kk < 2; ++kk) {
      const u32x4 u = *(const u32x4*)(WSP(bf16_t, O_PROJ) + qrow * 2560 + h * 64 + 32 * kk + 8 * quad);
      union { bf16x8 v; unsigned uu[4]; } r;
#pragma unroll
      for (int e = 0; e < 4; ++e) r.uu[e] = pk2(bflo(u[e]) * QSC, bfhi(u[e]) * QSC);
      qf[kk] = r.v;
    }
    float m_run = p.b_sink[h] * 1.4426950408889634f;
    float l_part = (quad == 0) ? 1.f : 0.f;
    f32x4 O[4];
#pragma unroll
    for (int d = 0; d < 4; ++d) O[d] = (f32x4){0.f, 0.f, 0.f, 0.f};
    u32x4 pk0, pk1, pv0, pv1;
#define ATT_ISSUE(tix_) { const int kr_ = ((tix_) < 3) ? b * 8192 + (nblk - 1 + (tix_)) * 128 : ML + b * 256 + ((tix_) - 3) * 128; \
      const bf16_t* src_ = WSP(bf16_t, O_PROJ) + (size_t)(kr_ + (tid >> 3)) * 2560 + 1024 + hk * 64 + (tid & 7) * 8; \
      pk0 = *(const u32x4*)src_; pv0 = *(const u32x4*)(src_ + 256); pk1 = *(const u32x4*)(src_ + (size_t)64 * 2560); pv1 = *(const u32x4*)(src_ + (size_t)64 * 2560 + 256); }
#define ATT_TILE(KS_, VS_, MODE_, KLO_, KHI_) { \
      f32x4 sc[8]; float mx = -INFINITY; \
      const int mlo = ((MODE_) == 1) ? ii : -100000, mhi = ((MODE_) == 2) ? ii : 100000; \
      _Pragma("unroll") for (int kt = 0; kt < 8; ++kt) { \
        if (kt >= (KLO_) && kt <= (KHI_)) { \
          f32x4 s_ = {0.f, 0.f, 0.f, 0.f}; \
          _Pragma("unroll") for (int kk = 0; kk < 2; ++kk) { \
            const bf16x8 a_ = *(const bf16x8*)((KS_) + (16 * kt + l15) * KP + 32 * kk + 8 * quad); \
            s_ = mfma16(a_, qf[kk], s_); } \
          if ((MODE_) != 0 && kt == w) { \
            _Pragma("unroll") for (int j = 0; j < 4; ++j) { \
              const int kkey = 16 * kt + 4 * quad + j; \
              const int dneg = min(kkey - mlo, 0) + min(mhi - kkey, 0); \
              s_[j] += (float)dneg * 1e30f; } } \
          mx = fmaxf(mx, fmaxf(fmaxf(s_[0], s_[1]), fmaxf(s_[2], s_[3]))); \
          sc[kt] = s_; \
        } else sc[kt] = (f32x4){0.f, 0.f, 0.f, 0.f}; } \
      mx = fmaxf(mx, __shfl_xor(mx, 16)); mx = fmaxf(mx, __shfl_xor(mx, 32)); \
      const float m_new = fmaxf(m_run, mx); \
      const float alpha = __builtin_amdgcn_exp2f(m_run - m_new); \
      m_run = m_new; l_part *= alpha; \
      _Pragma("unroll") for (int d = 0; d < 4; ++d) O[d] = O[d] * alpha; \
      _Pragma("unroll") for (int kt = 0; kt < 8; ++kt) { \
        if (kt >= (KLO_) && kt <= (KHI_)) { \
          _Pragma("unroll") for (int j = 0; j < 4; ++j) { const float e_ = __builtin_amdgcn_exp2f(sc[kt][j] - m_new); sc[kt][j] = e_; l_part += e_; } } } \
      _Pragma("unroll") for (int kp = 0; kp < 4; ++kp) { \
        if (2 * kp + 1 >= (KLO_) && 2 * kp <= (KHI_)) { \
          const bf16x8 pb = pack8(sc[2 * kp], sc[2 * kp + 1]); \
          _Pragma("unroll") for (int d = 0; d < 4; ++d) { \
            const int q_ = (lane & 15) >> 2, pp_ = lane & 3; \
            const bf16_t* a0 = (VS_) + (32 * kp + 4 * quad + q_) * KP + 16 * d + 4 * pp_; \
            const s16x4 r0 = tr_read(a0), r1 = tr_read(a0 + 16 * KP); \
            bf16x8 va; va[0] = r0[0]; va[1] = r0[1]; va[2] = r0[2]; va[3] = r0[3]; va[4] = r1[0]; va[5] = r1[1]; va[6] = r1[2]; va[7] = r1[3]; \
            O[d] = mfma16(va, pb, O[d]); } } } }
#define ATT_WRITE(KS_, VS_) { const int r_ = tid >> 3, ch_ = tid & 7; \
      *(u32x4*)((KS_) + r_ * KP + ch_ * 8) = pk0; *(u32x4*)((VS_) + r_ * KP + ch_ * 8) = pv0; \
      *(u32x4*)((KS_) + (r_ + 64) * KP + ch_ * 8) = pk1; *(u32x4*)((VS_) + (r_ + 64) * KP + ch_ * 8) = pv1; }
    bf16_t* const K0 = KVb; bf16_t* const V0 = KVb + 128 * KP; bf16_t* const K1 = KVb + 256 * KP; bf16_t* const V1 = K1 + 128 * KP;
    const bool paired = (tix0 == 0 && nblk > 0 && nblk < 63);
    int tix = (tix0 == 0 && nblk == 0) ? 1 : tix0;
    int par = 0;
    __syncthreads();
    if (paired) {
      ATT_ISSUE(0)
      ATT_WRITE(K0, V0)
      ATT_ISSUE(2)
      ATT_WRITE(K1, V1)
      __syncthreads();
      ATT_ISSUE(1)
      ATT_TILE(K0, V0, 1, w, 7)
      ATT_TILE(K1, V1, 2, 0, w)
      __syncthreads();
      tix = 1;
    } else {
      ATT_ISSUE(tix)
    }
#pragma unroll 1
    while (tix < 5) {
      int nx = tix + 1;
      if (nx == 2 && (nblk == 63 || paired)) nx = 3;
      const int mode = tix == 0 ? 1 : (tix == 2 ? 2 : 0);
      bf16_t* Ks = par ? K1 : K0; bf16_t* Vs = par ? V1 : V0; par ^= 1;
      ATT_WRITE(Ks, Vs)
      __syncthreads();
      if (nx < 5) ATT_ISSUE(nx)
      const int klo = (mode == 1) ? w : 0, khi = (mode == 2) ? w : 7;
      ATT_TILE(Ks, Vs, mode, klo, khi)
      tix = nx;
    }
#undef ATT_TILE
#undef ATT_WRITE
#undef ATT_ISSUE
    float l_tot = l_part; l_tot += __shfl_xor(l_tot, 16); l_tot += __shfl_xor(l_tot, 32);
    const float inv = 1.0f / l_tot;
#pragma unroll
    for (int d = 0; d < 4; ++d) {
      const int dd = 16 * d + 4 * quad;
      const u32x2 zv = *(const u32x2*)(WSP(bf16_t, O_PROJ) + qrow * 2560 + 1536 + h * 64 + dd);
      const float v0 = O[d][0] * inv * silu_f(bflo(zv[0])), v1 = O[d][1] * inv * silu_f(bfhi(zv[0]));
      const float v2 = O[d][2] * inv * silu_f(bflo(zv[1])), v3 = O[d][3] * inv * silu_f(bfhi(zv[1]));
      u32x2 ov; ov[0] = pk2(v0, v1); ov[1] = pk2(v2, v3);
      *(u32x2*)(WSP(bf16_t, O_OG) + qrow * 1024 + h * 64 + dd) = ov;
    }
  }
}

constexpr int R_CW = 0, R_UCF = 4096, R_UCS = 37888, R_US = 55296, R_HS = 126016;
constexpr int UFP = 132, USP = 136;
__device__ __forceinline__ int rho_row(int t) { return 16 * ((t >> 2) & 3) + 4 * (t >> 4) + (t & 3); }

template <bool REV, bool WANT_H>
__device__ __forceinline__ float scan16(float (&a)[4][4], float (&x)[4][4], float cin, int l15, int quad, float& A_tile) {
  float A = 1.f, H = 0.f;
#pragma unroll
  for (int mm = 0; mm < 4; ++mm)
#pragma unroll
    for (int jj = 0; jj < 4; ++jj) {
      const int mi = REV ? 3 - mm : mm, j = REV ? 3 - jj : jj;
      H = a[mi][j] * H + x[mi][j]; A *= a[mi][j];
    }
  const float A0 = __shfl(A, l15), A1 = __shfl(A, l15 + 16), A2 = __shfl(A, l15 + 32), A3 = __shfl(A, l15 + 48);
  const float H0 = __shfl(H, l15), H1 = __shfl(H, l15 + 16), H2 = __shfl(H, l15 + 32), H3 = __shfl(H, l15 + 48);
  A_tile = (A0 * A1) * (A2 * A3);
  float cc = cin, cl = cin;
  if (!REV) {
    if (quad == 0) cl = cc; cc = A0 * cc + H0;
    if (quad == 1) cl = cc; cc = A1 * cc + H1;
    if (quad == 2) cl = cc; cc = A2 * cc + H2;
    if (quad == 3) cl = cc; cc = A3 * cc + H3;
  } else {
    if (quad == 3) cl = cc; cc = A3 * cc + H3;
    if (quad == 2) cl = cc; cc = A2 * cc + H2;
    if (quad == 1) cl = cc; cc = A1 * cc + H1;
    if (quad == 0) cl = cc; cc = A0 * cc + H0;
  }
  if (WANT_H) {
    float h = cl;
#pragma unroll
    for (int mm = 0; mm < 4; ++mm)
#pragma unroll
      for (int jj = 0; jj < 4; ++jj) {
        const int mi = REV ? 3 - mm : mm, j = REV ? 3 - jj : jj;
        h = a[mi][j] * h + x[mi][j]; x[mi][j] = h;
      }
  }
  return cc;
}

template <int PASS>
__device__ __forceinline__ void rglru_phase(const Params& p, char* lds) {
  const int tid = threadIdx.x, lane = tid & 63, w = tid >> 6, l15 = lane & 15, quad = lane >> 4;
  float* cw = (float*)(lds + R_CW); float* ucf = (float*)(lds + R_UCF); bf16_t* ucs = (bf16_t*)(lds + R_UCS); bf16_t* us = (bf16_t*)(lds + R_US);
  const int tg_lo = (int)(((long long)blockIdx.x * 5280) / gridDim.x), tg_hi = (int)(((long long)(blockIdx.x + 1) * 5280) / gridDim.x);
  const int it_lo = tg_lo >> 2, it_hi = (tg_hi + 3) >> 2;
  const int cl = 16 * w + l15;
  bf16x8 wf[4][4];
  float bra[2], bri[2], sp[2];
  int cur_hd = -1;
  for (int item = it_lo; item < it_hi; ++item) {
    const int hd = item / 132, rem = item % 132, b = rem / 33, grp = rem % 33;
    const int ch = hd * 128 + cl;
    int idx0, row_base, seq_lo, seq_hi;
    if (grp == 0) { idx0 = 0; row_base = ML + b * 256; seq_lo = row_base; seq_hi = seq_lo + 256; }
    else { idx0 = 4 + 4 * (grp - 1); row_base = b * 8192 + 256 * (grp - 1); seq_lo = b * 8192; seq_hi = seq_lo + 8192; }
    __syncthreads();
    for (int c = tid; c < 259 * 16; c += NTHR) {
      const int r = c >> 4, c8 = (c & 15) * 8;
      const int grow = row_base - 2 + r;
      u32x4 v = {0u, 0u, 0u, 0u};
      if (grow >= seq_lo && grow < seq_hi) v = *(const u32x4*)(WSP(bf16_t, O_PROJ) + (size_t)grow * 2560 + hd * 128 + c8);
      *(u32x4*)(us + r * USP + c8) = v;
    }
    if (hd != cur_hd) {
      cur_hd = hd;
#pragma unroll
      for (int g4 = 0; g4 < 4; ++g4) {
        const int gt = g4 & 1, d = g4 >> 1;
        const bf16_t* wp = WSP(bf16_t, O_WT_GATE) + ((size_t)((gt * 2 + d) * 10 + hd) * 128 + cl) * 128 + 8 * quad;
#pragma unroll
        for (int kk = 0; kk < 4; ++kk) wf[g4][kk] = *(const bf16x8*)(wp + 32 * kk);
      }
#pragma unroll
      for (int d = 0; d < 2; ++d) {
        bra[d] = -1.4426950408889634f * p.c_b_ra[d * 1280 + ch]; bri[d] = -1.4426950408889634f * p.c_b_ri[d * 1280 + ch];
        const float nl = -p.c_lam[d * 1280 + ch];
        sp[d] = (-8.0f * 1.4426950408889634f) * (fmaxf(nl, 0.f) + log1pf(expf(-fabsf(nl))));
      }
      for (int i = tid; i < 640; i += NTHR) {
        const int r = i >> 7, cc = i & 127;
        cw[i] = (r < 4) ? p.c_conv_w[r * 1280 + hd * 128 + cc] : p.c_conv_b[hd * 128 + cc];
      }
    }
    __syncthreads();
    const int tl0 = max(tg_lo - 4 * item, 0), tl1 = min(tg_hi - 4 * item, 4);
    for (int tile = tl0; tile < tl1; ++tile) {
      const int idx = idx0 + tile, row0 = row_base + 64 * tile;
      const int tt = tid >> 3, c0 = (tid & 7) * 16;
      float cin0 = 0.f, cin1 = 0.f; u32x4 z0 = {0u, 0u, 0u, 0u}, z1 = {0u, 0u, 0u, 0u};
      if (PASS == 2) {
        cin0 = WSP(float, O_CI)[((size_t)((0 * 4 + b) * 132 + idx)) * 1280 + ch];
        cin1 = WSP(float, O_CI)[((size_t)((1 * 4 + b) * 132 + idx)) * 1280 + ch];
        const bf16_t* zp = WSP(bf16_t, O_PROJ) + (size_t)(row0 + tt) * 2560 + 1280 + hd * 128 + c0;
        z0 = *(const u32x4*)zp; z1 = *(const u32x4*)(zp + 8);
      }
      {
        float accv[16];
#pragma unroll
        for (int e = 0; e < 4; ++e) { const f32x4 bv = *(const f32x4*)(cw + 512 + c0 + 4 * e); accv[4 * e] = bv[0]; accv[4 * e + 1] = bv[1]; accv[4 * e + 2] = bv[2]; accv[4 * e + 3] = bv[3]; }
#pragma unroll
        for (int j4 = 0; j4 < 4; ++j4) {
          const bf16_t* up = us + (64 * tile + tt + j4) * USP + c0;
          const u32x4 u0 = *(const u32x4*)up, u1 = *(const u32x4*)(up + 8);
          float wv[16];
#pragma unroll
          for (int e = 0; e < 4; ++e) { const f32x4 t4 = *(const f32x4*)(cw + j4 * 128 + c0 + 4 * e); wv[4 * e] = t4[0]; wv[4 * e + 1] = t4[1]; wv[4 * e + 2] = t4[2]; wv[4 * e + 3] = t4[3]; }
#pragma unroll
          for (int e = 0; e < 4; ++e) {
            accv[2 * e] += bflo(u0[e]) * wv[2 * e]; accv[2 * e + 1] += bfhi(u0[e]) * wv[2 * e + 1];
            accv[8 + 2 * e] += bflo(u1[e]) * wv[8 + 2 * e]; accv[8 + 2 * e + 1] += bfhi(u1[e]) * wv[8 + 2 * e + 1];
          }
        }
        const int rr = rho_row(tt);
#pragma unroll
        for (int e = 0; e < 4; ++e) *(f32x4*)(ucf + rr * UFP + c0 + 4 * e) = (f32x4){accv[4 * e], accv[4 * e + 1], accv[4 * e + 2], accv[4 * e + 3]};
        u32x4 o0, o1;
#pragma unroll
        for (int e = 0; e < 4; ++e) { o0[e] = pk2(accv[2 * e], accv[2 * e + 1]); o1[e] = pk2(accv[8 + 2 * e], accv[8 + 2 * e + 1]); }
        *(u32x4*)(ucs + rr * USP + c0) = o0; *(u32x4*)(ucs + rr * USP + c0 + 8) = o1;
      }
      __syncthreads();
      f32x4 acc[4][4];
#pragma unroll
      for (int mi = 0; mi < 4; ++mi)
#pragma unroll
        for (int g4 = 0; g4 < 4; ++g4) acc[mi][g4] = (f32x4){0.f, 0.f, 0.f, 0.f};
#pragma unroll
      for (int kk = 0; kk < 4; ++kk)
#pragma unroll
        for (int mi = 0; mi < 4; ++mi) {
          const bf16x8 af = *(const bf16x8*)(ucs + (16 * mi + l15) * USP + 32 * kk + 8 * quad);
#pragma unroll
          for (int g4 = 0; g4 < 4; ++g4) acc[mi][g4] = mfma16(af, wf[g4][kk], acc[mi][g4]);
        }
      float ucv[4][4];
#pragma unroll
      for (int mi = 0; mi < 4; ++mi)
#pragma unroll
        for (int j = 0; j < 4; ++j) ucv[mi][j] = ucf[(16 * mi + 4 * quad + j) * UFP + cl];
      float hsum[4][4];
#pragma unroll
      for (int d = 0; d < 2; ++d) {
        float av[4][4], xv[4][4];
#pragma unroll
        for (int mi = 0; mi < 4; ++mi)
#pragma unroll
          for (int j = 0; j < 4; ++j) {
            const float rg = __builtin_amdgcn_rcpf(1.0f + __builtin_amdgcn_exp2f(acc[mi][2 * d][j] + bra[d]));
            const float ig = __builtin_amdgcn_rcpf(1.0f + __builtin_amdgcn_exp2f(acc[mi][2 * d + 1][j] + bri[d]));
            const float aa = __builtin_amdgcn_exp2f(rg * sp[d]);
            av[mi][j] = aa;
            xv[mi][j] = __builtin_amdgcn_sqrtf(fmaxf(1.0f - aa * aa, 0.f)) * ig * ucv[mi][j];
          }
        float at;
        if (PASS == 1) {
          const float hend = d ? scan16<true, false>(av, xv, 0.f, l15, quad, at) : scan16<false, false>(av, xv, 0.f, l15, quad, at);
          const size_t tci = ((size_t)((d * 4 + b) * 132 + idx)) * 1280 + ch;
          if (quad == 0) *(f32x2*)(WSP(float, O_TC) + tci * 2) = (f32x2){at, hend};
        } else {
          if (d) scan16<true, true>(av, xv, cin1, l15, quad, at); else scan16<false, true>(av, xv, cin0, l15, quad, at);
#pragma unroll
          for (int mi = 0; mi < 4; ++mi)
#pragma unroll
            for (int j = 0; j < 4; ++j) hsum[mi][j] = d ? hsum[mi][j] + xv[mi][j] : xv[mi][j];
        }
      }
      if (PASS == 1) __syncthreads();
      if (PASS == 2) {
        float* hsb = (float*)(lds + R_HS);
#pragma unroll
        for (int mi = 0; mi < 4; ++mi)
#pragma unroll
          for (int j = 0; j < 4; ++j) hsb[(16 * mi + 4 * quad + j) * UFP + cl] = hsum[mi][j];
        __syncthreads();
        const size_t row = (size_t)(row0 + tt);
        const int rr = rho_row(tt);
        float hv[16];
#pragma unroll
        for (int e = 0; e < 4; ++e) { const f32x4 t4 = *(const f32x4*)(hsb + rr * UFP + c0 + 4 * e); hv[4 * e] = t4[0]; hv[4 * e + 1] = t4[1]; hv[4 * e + 2] = t4[2]; hv[4 * e + 3] = t4[3]; }
        u32x4 o0, o1;
#pragma unroll
        for (int e = 0; e < 4; ++e) {
          o0[e] = pk2(hv[2 * e] * silu_f(bflo(z0[e])), hv[2 * e + 1] * silu_f(bfhi(z0[e])));
          o1[e] = pk2(hv[8 + 2 * e] * silu_f(bflo(z1[e])), hv[8 + 2 * e + 1] * silu_f(bfhi(z1[e])));
        }
        *(u32x4*)(WSP(bf16_t, O_OG) + row * 1280 + hd * 128 + c0) = o0; *(u32x4*)(WSP(bf16_t, O_OG) + row * 1280 + hd * 128 + c0 + 8) = o1;
      }
    }
  }
}

__device__ __forceinline__ void rglru_scan_phase(const Params& p, char* lds) {
  const int tid = threadIdx.x;
  f32x2* L = (f32x2*)lds;
  float* Cc = (float*)(lds + 132 * 40 * 8);
  for (int blk = blockIdx.x; blk < 256; blk += gridDim.x) {
    const int dir = blk >> 7, b = (blk & 127) >> 5, ch0 = (blk & 31) * 40;
    const size_t base = (size_t)((dir * 4 + b) * 132) * 1280 + ch0;
    __syncthreads();
    for (int e = tid; e < 132 * 40; e += NTHR) {
      const int idx = e / 40, cc = e % 40;
      L[e] = *(const f32x2*)(WSP(float, O_TC) + (base + (size_t)idx * 1280 + cc) * 2);
    }
    __syncthreads();
    if (tid < 40) {
      float carry = 0.f;
      for (int s = 0; s < 132; ++s) {
        int idx;
        if (dir == 0) idx = s; else idx = (s < 4) ? 3 - s : 135 - s;
        const f32x2 v = L[idx * 40 + tid];
        Cc[idx * 40 + tid] = carry;
        carry = v[0] * carry + v[1];
      }
    }
    __syncthreads();
    for (int e = tid; e < 132 * 40; e += NTHR) {
      const int idx = e / 40, cc = e % 40;
      WSP(float, O_CI)[base + (size_t)idx * 1280 + cc] = Cc[e];
    }
  }
}

#define XB_TMO      128
#define XB_XCNT(j)  (256  + 64 * (j))
#define XB_XSUB(j)  (1280 + 64 * (j))
#define XB_XGEN(j)  (2304 + 64 * (j))
#define XB_TOP      3328
#define XB_TOPGEN   3392
#define XCD_BAR_WORDS 3456
#define XB_SPIN_CAP (1u << 18)
#define LAS __attribute__((address_space(3)))

__device__ __forceinline__ unsigned xb_ld(unsigned* p)              { return __hip_atomic_load(p, __ATOMIC_RELAXED, __HIP_MEMORY_SCOPE_AGENT); }
__device__ __forceinline__ unsigned xb_add(unsigned* p, unsigned v) { return __hip_atomic_fetch_add(p, v, __ATOMIC_RELAXED, __HIP_MEMORY_SCOPE_AGENT); }
__device__ __forceinline__ unsigned xb_xcc_id() { return (unsigned)__builtin_amdgcn_s_getreg((3 << 11) | 20) & 0xFu; }
#define XB_SPIN(cond, bar) do { unsigned _sp = 0; while (cond) { __builtin_amdgcn_s_sleep(1); \
    if ((++_sp & 255u) == 0u) { if (xb_ld(&(bar)[XB_TMO])) break; if (_sp > XB_SPIN_CAP) { atomicAdd(&(bar)[XB_TMO], 1u); break; } } } } while (0)

struct XcdBarrier {
    unsigned* bar; unsigned x;
    volatile LAS unsigned* st;
};

__device__ __forceinline__ XcdBarrier xcd_barrier_post(unsigned* bar, volatile LAS unsigned* st) {
    XcdBarrier b; b.bar = bar; b.x = xb_xcc_id(); b.st = st;
    if (threadIdx.x == 0) (void)xb_add(&bar[XB_XCNT(b.x)], 1u);
    return b;
}
__device__ __forceinline__ void xcd_barrier_complete(unsigned* bar, unsigned x, unsigned& nloc, unsigned& nx) {
    const unsigned G = gridDim.x * gridDim.y * gridDim.z;
    unsigned sum, cnt, mine, sp = 0u;
    for (;;) {
        sum = 0u; cnt = 0u; mine = 0u;
#pragma unroll
        for (unsigned j = 0; j < 16; ++j) { const unsigned c = xb_ld(&bar[XB_XCNT(j)]); sum += c; cnt += (c > 0u) ? 1u : 0u; mine = (j == x) ? c : mine; }
        if (sum == G) break;
        __builtin_amdgcn_s_sleep(1);
        if ((++sp & 255u) == 0u) { if (xb_ld(&bar[XB_TMO])) break; if (sp > XB_SPIN_CAP) { atomicAdd(&bar[XB_TMO], 1u); break; } }
    }
    nloc = mine > 0u ? mine : 1u; nx = cnt > 0u ? cnt : 1u;
}

__device__ __forceinline__ void xcd_barrier(const XcdBarrier& b) {
    asm volatile("s_waitcnt vmcnt(0)" ::: "memory");
    __syncthreads();
    if (threadIdx.x == 0) {
        unsigned* bar = b.bar;
        __builtin_amdgcn_s_waitcnt(0);
        unsigned nloc = b.st[0], nx = b.st[1];
        if (nloc == 0u) { xcd_barrier_complete(bar, b.x, nloc, nx); b.st[0] = nloc; b.st[1] = nx; }
        const unsigned old = xb_add(&bar[XB_XSUB(b.x)], 1u);
        const unsigned gen = old / nloc;
        if (old + 1u == (gen + 1u) * nloc) {
            __builtin_amdgcn_fence(__ATOMIC_RELEASE, "agent");
            asm volatile("s_waitcnt vmcnt(0)" ::: "memory");
            const unsigned og = xb_add(&bar[XB_TOP], 1u);
            const unsigned tg = og / nx;
            if (og + 1u == (tg + 1u) * nx) xb_add(&bar[XB_TOPGEN], 1u);
            else XB_SPIN(xb_ld(&bar[XB_TOPGEN]) == tg, bar);
            __builtin_amdgcn_fence(__ATOMIC_ACQUIRE, "agent");
            xb_add(&bar[XB_XGEN(b.x)], 1u);
            asm volatile("s_waitcnt vmcnt(0)" ::: "memory");
        } else {
            XB_SPIN(xb_ld(&bar[XB_XGEN(b.x)]) == gen, bar);
            __builtin_amdgcn_fence(__ATOMIC_ACQUIRE, "agent");
            asm volatile("s_waitcnt vmcnt(0)" ::: "memory");
        }
    }
    __syncthreads();
}


__device__ __forceinline__ void post_phase(const Params& p, int layer) {
  post_rows(p, layer, blockIdx.x * 8 + (threadIdx.x >> 6), gridDim.x * 8, (layer == 3) ? ML : MT);
}
__device__ __forceinline__ void post_phase_ctx_overlap(const Params& p, int layer, const bf16_t* og_ctx, const bf16_t* wt, int K, char* lds, int vb) {
  const int tid = threadIdx.x, w = tid >> 6;
  if (vb < 16) {
    pg8::Gemm g{og_ctx, wt, MC, 1024, K};
    GSched S{4, 16, 16, vb};
    GEpi<0> E{WSP(bf16_t, O_Y) + (size_t)ML * 1024, 1024, WSP(float, O_G1), WSP(float, O_ROPE)};
    pg8::gemm_phase<GEpi<0>, GSched, true, true>((PG8_LAS unsigned char*)lds, g, S, E);
    unsigned* cnt = (unsigned*)(p.ws + O_BAR) + 3584 + 64 * layer;
    asm volatile("s_waitcnt vmcnt(0)" ::: "memory");
    __syncthreads();
    if (tid == 0) {
      __builtin_amdgcn_fence(__ATOMIC_RELEASE, "agent");
      asm volatile("s_waitcnt vmcnt(0)" ::: "memory");
      xb_add(cnt, 1u);
      unsigned spn = 0;
      while (xb_ld(cnt) < 16u) { __builtin_amdgcn_s_sleep(1); if (++spn > (1u << 20)) break; }
      __builtin_amdgcn_fence(__ATOMIC_ACQUIRE, "agent");
      asm volatile("s_waitcnt vmcnt(0)" ::: "memory");
    }
    __syncthreads();
    post_rows(p, layer, ML + vb * 8 + w, 16 * 8, MT);
  } else {
    post_rows(p, layer, (vb - 16) * 8 + w, 240 * 8, ML);
  }
}

template <class T> __device__ __forceinline__ T* uni_ptr(T* v) {
  const unsigned long long u = (unsigned long long)v;
  const unsigned lo = __builtin_amdgcn_readfirstlane((unsigned)u), hi = __builtin_amdgcn_readfirstlane((unsigned)(u >> 32));
  typedef __attribute__((address_space(1))) T GT;
  GT* g = (GT*)(((unsigned long long)hi << 32) | lo);
  return (T*)g;
}
__device__ __forceinline__ Params load_params(const Params& s) {
  Params q;
  q.x = uni_ptr(s.x); q.c = uni_ptr(s.c); q.ctx = uni_ptr(s.ctx); q.c_ctx = uni_ptr(s.c_ctx); q.w_mod = uni_ptr(s.w_mod); q.b_mod = uni_ptr(s.b_mod);
  q.g_pre = uni_ptr(s.g_pre); q.g_post = uni_ptr(s.g_post);
  q.a_w_in = uni_ptr(s.a_w_in); q.a_w_g1 = uni_ptr(s.a_w_g1); q.a_w_g2 = uni_ptr(s.a_w_g2); q.a_b_g = uni_ptr(s.a_b_g); q.a_g_head = uni_ptr(s.a_g_head); q.a_w_out = uni_ptr(s.a_w_out);
  q.b_w_in = uni_ptr(s.b_w_in); q.b_sink = uni_ptr(s.b_sink); q.b_w_out = uni_ptr(s.b_w_out);
  q.c_w_in = uni_ptr(s.c_w_in); q.c_conv_w = uni_ptr(s.c_conv_w); q.c_conv_b = uni_ptr(s.c_conv_b); q.c_w_ra = uni_ptr(s.c_w_ra); q.c_b_ra = uni_ptr(s.c_b_ra);
  q.c_w_ri = uni_ptr(s.c_w_ri); q.c_b_ri = uni_ptr(s.c_b_ri); q.c_lam = uni_ptr(s.c_lam); q.c_w_out = uni_ptr(s.c_w_out);
  q.out = uni_ptr(s.out); q.ws = uni_ptr(s.ws);
  return q;
}
#define PH(k, call) if (ph_lo <= (k) && (k) < ph_hi) { if ((k) > ph_lo) xcd_barrier(xb); { const Params p = load_params(sp); call; } }
#define PHR(k, rep, call) if (ph_lo <= (k) && (k) < ph_hi) { if ((k) > ph_lo) xcd_barrier(xb); { const Params p = load_params(sp); for (int rr_ = 0; rr_ < (rep); ++rr_) { call; } } }
__global__ void __launch_bounds__(512) mega(Params pk, int ph_lo, int ph_hi) {
  extern __shared__ __attribute__((aligned(16))) char lds[];
  __shared__ __attribute__((aligned(16))) Params sp;
  __shared__ uint4 xb_words;
  if (threadIdx.x == 0) { sp = pk; xb_words = make_uint4(0u, 0u, 0u, 0u); }
  __syncthreads();
  XcdBarrier xb; xb.bar = (unsigned*)(pk.ws + O_BAR); xb.x = xb_xcc_id(); xb.st = (volatile LAS unsigned*)&xb_words;
  if (threadIdx.x == 0) xb_words.z = xb_add(&xb.bar[XB_XCNT(xb.x)], 1u);
  __syncthreads();
  int vb = blockIdx.x;
  cg::grid_group grid = cg::this_grid();
  if (ph_hi < 0) grid.sync();
#ifdef DIAG_PHASE
  ph_lo = DIAG_PHASE; ph_hi = DIAG_PHASE + 1;
#endif
  PHR(0, REP_PRO, prologue_phase(p, lds))
  PHR(1, REP_PRO, post_phase(p, -1))
  if (ph_lo < 2) {
    bool uni = (gridDim.x == 256);
    for (int j = 0; j < 16; ++j) { const unsigned cnt = xb_ld(&xb.bar[XB_XCNT(j)]); uni = uni && (cnt == (j < 8 ? 32u : 0u)); }
    const unsigned rk = xb_words.z;
    if (uni && xb.x < 8 && rk < 32) vb = __builtin_amdgcn_readfirstlane((int)(xb.x * 32 + rk));
  }
  PHR(2, REP_G, gemm8<1>(p, WSP(bf16_t, O_H), WSP(bf16_t, O_WT_A_IN), 33792, NA_IN, 1024, WSP(bf16_t, O_PROJ), 3072, lds, vb))
  PHR(3, REP_GLA, gla_p1(p, 0, 1, lds))
  PH(4, gla_scan_phase(p, 0, 1, lds))
  PHR(5, REP_GLA, gla_p2(p, 0, 0, lds))
  PHR(6, REP_G, gemm8<0>(p, WSP(bf16_t, O_OG), WSP(bf16_t, O_WT_A_OUT), 32768, 1024, 1024, WSP(bf16_t, O_Y), 1024, lds, vb))
  PH(7, post_phase_ctx_overlap(p, 0, WSP(bf16_t, O_OG) + (size_t)ML * 1024, WSP(bf16_t, O_WT_A_OUT), 1024, lds, vb))
  PHR(8, REP_G, gemm8<2>(p, WSP(bf16_t, O_H), WSP(bf16_t, O_WT_B_IN), 33792, 2560, 1024, WSP(bf16_t, O_PROJ), 2560, lds, vb))
  PHR(9, REP_ATT, attn_phase(p, 1, lds))
  PHR(10, REP_G, gemm8<0>(p, WSP(bf16_t, O_OG), WSP(bf16_t, O_WT_B_OUT), 32768, 1024, 1024, WSP(bf16_t, O_Y), 1024, lds, vb))
  PH(11, post_phase_ctx_overlap(p, 1, WSP(bf16_t, O_OG) + (size_t)ML * 1024, WSP(bf16_t, O_WT_B_OUT), 1024, lds, vb))
  PHR(12, REP_G, gemm8<0>(p, WSP(bf16_t, O_H), WSP(bf16_t, O_WT_C_IN), 33792, 2560, 1024, WSP(bf16_t, O_PROJ), 2560, lds, vb))
  PHR(13, REP_R, rglru_phase<1>(p, lds))
  PHR(14, REP_R, rglru_scan_phase(p, lds))
  PHR(15, REP_R, rglru_phase<2>(p, lds))
  PHR(16, REP_G, gemm8<0>(p, WSP(bf16_t, O_OG), WSP(bf16_t, O_WT_C_OUT), 32768, 1024, 1280, WSP(bf16_t, O_Y), 1024, lds, vb))
  PH(17, post_phase_ctx_overlap(p, 2, WSP(bf16_t, O_OG) + (size_t)ML * 1280, WSP(bf16_t, O_WT_C_OUT), 1280, lds, vb))
  PHR(18, REP_G, gemm8<1>(p, WSP(bf16_t, O_H), WSP(bf16_t, O_WT_A_IN) + (size_t)NA_IN * 1024, 33792, NA_IN, 1024, WSP(bf16_t, O_PROJ), 3072, lds, vb))
  PHR(19, REP_GLA, gla_p1(p, 1, 0, lds))
  PH(20, gla_scan_phase(p, 1, 0, lds))
  PHR(21, REP_GLA, gla_p2(p, 1, 0, lds))
  PHR(22, REP_G, gemm8<0>(p, WSP(bf16_t, O_OG), WSP(bf16_t, O_WT_A_OUT) + (size_t)1024 * 1024, 32768, 1024, 1024, WSP(bf16_t, O_Y), 1024, lds, vb))
  PH(23, post_phase(p, 3))
}

extern "C" void kernel_launch(void* const* d_in, const int* in_sizes, int n_in, void* d_out, int out_size, void* d_ws, size_t ws_size, hipStream_t stream) {
  Params p{};
  const float* const* in = (const float* const*)d_in;
  p.x = in[0]; p.c = in[1]; p.ctx = in[2]; p.c_ctx = in[3]; p.w_mod = in[4]; p.b_mod = in[5]; p.g_pre = in[6]; p.g_post = in[7];
  p.a_w_in = in[8]; p.a_w_g1 = in[9]; p.a_w_g2 = in[10]; p.a_b_g = in[11]; p.a_g_head = in[12]; p.a_w_out = in[13];
  p.b_w_in = in[14]; p.b_sink = in[15]; p.b_w_out = in[16];
  p.c_w_in = in[17]; p.c_conv_w = in[18]; p.c_conv_b = in[19]; p.c_w_ra = in[20]; p.c_b_ra = in[21]; p.c_w_ri = in[22]; p.c_b_ri = in[23]; p.c_lam = in[24]; p.c_w_out = in[25];
  p.out = (float*)d_out;
  p.ws = (char*)d_ws;
  if (WS_NEED > ws_size) { fprintf(stderr, "workspace too small: need %zu have %zu\n", (size_t)WS_NEED, ws_size); return; }

  hipMemsetAsync((char*)d_ws + O_BAR, 0, 16384, stream);
  hipFuncSetAttribute((const void*)mega, hipFuncAttributeMaxDynamicSharedMemorySize, LDS_BYTES);
  int dev = 0, cus = 0, per_cu = 0;
  hipGetDevice(&dev);
  hipDeviceGetAttribute(&cus, hipDeviceAttributeMultiprocessorCount, dev);
  hipOccupancyMaxActiveBlocksPerMultiprocessor(&per_cu, mega, NTHR, LDS_BYTES);
  if (per_cu < 1) per_cu = 1;
  if (per_cu > 1) per_cu = 1;
  int grid = cus * per_cu;
#if ONE_LAUNCH
  int lo = 0, hi = NPH;
  void* args[] = {&p, &lo, &hi};
  hipError_t e = hipLaunchCooperativeKernel((const void*)mega, dim3(grid), dim3(NTHR), args, LDS_BYTES, stream);
  if (e != hipSuccess) fprintf(stderr, "cooperative launch failed: %s (grid %d)\n", hipGetErrorString(e), grid);
#else
  for (int ph = 0; ph < NPH; ++ph) {
    hipLaunchKernelGGL(mega, dim3(grid), dim3(NTHR), LDS_BYTES, stream, p, ph, ph + 1);
  }
#endif
}
```

```cpp
#include <hip/hip_runtime.h>
#include <hip/hip_cooperative_groups.h>
#include <cstdio>
namespace cg = cooperative_groups;

typedef unsigned short bf16_t;
typedef short bf16x8 __attribute__((ext_vector_type(8)));
typedef short s16x4 __attribute__((ext_vector_type(4)));
typedef float f32x4 __attribute__((ext_vector_type(4)));
typedef float f32x2 __attribute__((ext_vector_type(2)));
typedef unsigned u32x2 __attribute__((ext_vector_type(2)));
typedef unsigned u32x4 __attribute__((ext_vector_type(4)));

#ifndef REP_G
#define REP_G 1
#endif
#ifndef REP_GLA
#define REP_GLA 1
#endif
#ifndef REP_ATT
#define REP_ATT 1
#endif
#ifndef REP_R
#define REP_R 1
#endif
#ifndef REP_PRO
#define REP_PRO 1
#endif
#ifndef ONE_LAUNCH
#define ONE_LAUNCH 1
#endif

constexpr int NTHR = 512;
constexpr int DM = 1024;
constexpr int ML = 32768;
constexpr int MC = 1024;
constexpr int MT = ML + MC;
constexpr int NA_IN = 3328;
constexpr int LDS_BYTES = 159808;
constexpr int NPH = 24;
constexpr float EPS = 1e-6f;

struct Params {
  const float *x, *c, *ctx, *c_ctx, *w_mod, *b_mod, *g_pre, *g_post;
  const float *a_w_in, *a_w_g1, *a_w_g2, *a_b_g, *a_g_head, *a_w_out;
  const float *b_w_in, *b_sink, *b_w_out;
  const float *c_w_in, *c_conv_w, *c_conv_b, *c_w_ra, *c_b_ra, *c_w_ri, *c_b_ri, *c_lam, *c_w_out;
  float* out;
  char* ws;
};


constexpr size_t al256(size_t x) { return (x + 255) & ~(size_t)255; }
constexpr size_t O_WT_A_IN = 0;
constexpr size_t O_WT_A_OUT = O_WT_A_IN + al256((size_t)2 * NA_IN * 1024 * 2);
constexpr size_t O_WT_B_IN = O_WT_A_OUT + al256((size_t)2 * 1024 * 1024 * 2);
constexpr size_t O_WT_B_OUT = O_WT_B_IN + al256((size_t)2560 * 1024 * 2);
constexpr size_t O_WT_C_IN = O_WT_B_OUT + al256((size_t)1024 * 1024 * 2);
constexpr size_t O_WT_C_OUT = O_WT_C_IN + al256((size_t)2560 * 1024 * 2);
constexpr size_t O_WT_GATE = O_WT_C_OUT + al256((size_t)1024 * 1280 * 2);
constexpr size_t O_MOD = O_WT_GATE + al256((size_t)40 * 128 * 128 * 2);
constexpr size_t O_ROPE = O_MOD + al256((size_t)4 * 5 * 3072 * 4);
constexpr size_t O_G1 = O_ROPE + al256((size_t)128 * 16 * 2 * 4);
constexpr size_t O_XC = O_G1 + al256((size_t)MT * 32 * 4);
constexpr size_t O_H = O_XC + al256((size_t)MC * 1024 * 4);
constexpr size_t O_Y = O_H + al256((size_t)MT * 1024 * 2);
constexpr size_t O_PROJ = O_Y + al256((size_t)MT * 1024 * 2);
constexpr size_t O_OG = O_PROJ + al256((size_t)MT * 3072 * 2);
constexpr size_t O_BAR = O_OG + al256((size_t)MT * 1280 * 2);
constexpr size_t WS_NEED = O_BAR + 16384;
constexpr size_t O_OF = O_H;
constexpr size_t O_SEG_E = O_Y;
constexpr size_t O_SEG_D = O_Y + (size_t)512 * 16 * 512 * 16;
constexpr size_t O_TC = O_Y;
constexpr size_t O_CI = O_Y + (size_t)16 * 1024 * 1024;
static_assert(WS_NEED <= (size_t)512 * 1024 * 1024, "workspace map exceeds 512 MiB");
#define WSP(T, off) ((T*)(p.ws + (off)))

__device__ __forceinline__ unsigned short f2bf(float f) { unsigned u = __float_as_uint(f); u += 0x7fffu + ((u >> 16) & 1u); return (unsigned short)(u >> 16); }
__device__ __forceinline__ float bf2f(unsigned short h) { return __uint_as_float(((unsigned)h) << 16); }
typedef __bf16 bf16v2_t __attribute__((ext_vector_type(2)));
__device__ __forceinline__ unsigned pk2(float a, float b) {
  f32x2 v = {a, b}; bf16v2_t r = __builtin_convertvector(v, bf16v2_t); return __builtin_bit_cast(unsigned, r);
}
__device__ __forceinline__ float bflo(unsigned u) { return __uint_as_float(u << 16); }
__device__ __forceinline__ float bfhi(unsigned u) { return __uint_as_float(u & 0xffff0000u); }
__device__ __forceinline__ float silu_f(float x) { return x * __builtin_amdgcn_rcpf(1.f + __expf(-x)); }
__device__ __forceinline__ float sigm_f(float x) { return __builtin_amdgcn_rcpf(1.f + __expf(-x)); }
__device__ __forceinline__ f32x4 mfma16(bf16x8 a, bf16x8 b, f32x4 c) { return __builtin_amdgcn_mfma_f32_16x16x32_bf16(a, b, c, 0, 0, 0); }
__device__ __forceinline__ s16x4 tr_read(const bf16_t* p) {
  return __builtin_amdgcn_ds_read_tr16_b64_v4i16((__attribute__((address_space(3))) s16x4*)p);
}
__device__ __forceinline__ bf16x8 frag_tr(const bf16_t* tile, int pitch, int krow0, int col0, int lane) {
  const int g = lane >> 4, q = (lane & 15) >> 2, pp = lane & 3;
  const bf16_t* a = tile + (krow0 + 8 * g + q) * pitch + col0 + 4 * pp;
  s16x4 r0 = tr_read(a), r1 = tr_read(a + 4 * pitch);
  bf16x8 o; o[0] = r0[0]; o[1] = r0[1]; o[2] = r0[2]; o[3] = r0[3]; o[4] = r1[0]; o[5] = r1[1]; o[6] = r1[2]; o[7] = r1[3];
  return o;
}
__device__ __forceinline__ bf16x8 pack8(f32x4 a, f32x4 b) {
  union { bf16x8 v; unsigned u[4]; } r;
  r.u[0] = pk2(a[0], a[1]); r.u[1] = pk2(a[2], a[3]); r.u[2] = pk2(b[0], b[1]); r.u[3] = pk2(b[2], b[3]);
  return r.v;
}
template <class T> __device__ __forceinline__ T* sb_ptr(T* v) {
  const unsigned long long u = (unsigned long long)v;
  const unsigned lo = __builtin_amdgcn_readfirstlane((unsigned)u), hi = __builtin_amdgcn_readfirstlane((unsigned)(u >> 32));
  typedef __attribute__((address_space(1))) T GT;
  GT* g = (GT*)(((unsigned long long)hi << 32) | lo);
  return (T*)g;
}
__device__ __forceinline__ float wave_sum(float v) {
#pragma unroll
  for (int o = 32; o > 0; o >>= 1) v += __shfl_xor(v, o);
  return v;
}

__device__ __forceinline__ void conv_tile_wave(const float* __restrict__ src, int K, int N, bf16_t* __restrict__ dst, int ldk, int tk, int tn, float* T, int lane, float wscale) {
  const int k0 = tk * 64, n0 = tn * 64;
  const int c4 = (lane & 15) * 4, r0 = lane >> 4;
  f32x4 v[16];
#pragma unroll
  for (int i = 0; i < 16; ++i) {
    const int k = k0 + r0 + 4 * i, n = n0 + c4;
    v[i] = (f32x4){0.f, 0.f, 0.f, 0.f};
    if (n + 3 < N) v[i] = *(const f32x4*)(src + (size_t)k * N + n);
  }
#pragma unroll
  for (int i = 0; i < 16; ++i) { float* t = T + (r0 + 4 * i) * 65 + c4; t[0] = v[i][0] * wscale; t[1] = v[i][1] * wscale; t[2] = v[i][2] * wscale; t[3] = v[i][3] * wscale; }
  const int k8 = (lane & 7) * 8;
#pragma unroll
  for (int i = 0; i < 8; ++i) {
    const int n = (lane >> 3) + 8 * i;
    if (n0 + n < N) {
      u32x4 o;
      o[0] = pk2(T[(k8 + 0) * 65 + n], T[(k8 + 1) * 65 + n]);
      o[1] = pk2(T[(k8 + 2) * 65 + n], T[(k8 + 3) * 65 + n]);
      o[2] = pk2(T[(k8 + 4) * 65 + n], T[(k8 + 5) * 65 + n]);
      o[3] = pk2(T[(k8 + 6) * 65 + n], T[(k8 + 7) * 65 + n]);
      *(u32x4*)(dst + (size_t)(n0 + n) * ldk + k0 + k8) = o;
    }
  }
}

__device__ __forceinline__ void prologue_phase(const Params& p, char* lds) {
  const int tid = threadIdx.x;
  constexpr int NJ = 12 + 40;
  float* Tw = (float*)lds + (tid >> 6) * (64 * 65);
  for (int t = blockIdx.x * 8 + (tid >> 6); t < 4128; t += gridDim.x * 8) {
    int r = t;
    const float* src; bf16_t* dst; int K, N, ldk; float wscale = 1.0f;
    if (r < 1536) { int j = r / 768; r %= 768; K = 1024; N = 3072; src = p.a_w_in + (size_t)j * 1024 * 3072; dst = WSP(bf16_t, O_WT_A_IN) + (size_t)j * NA_IN * 1024; ldk = 1024; }
    else if ((r -= 1536) < 64) { int jd = r / 16; r %= 16; K = 1024; N = 16; src = p.a_w_g1 + (size_t)jd * 1024 * 16; dst = WSP(bf16_t, O_WT_A_IN) + (size_t)(jd >> 1) * NA_IN * 1024 + (size_t)(3072 + 16 * (jd & 1)) * 1024; ldk = 1024; }
    else if ((r -= 64) < 512) { int j = r / 256; r %= 256; K = 1024; N = 1024; src = p.a_w_out + (size_t)j * 1024 * 1024; dst = WSP(bf16_t, O_WT_A_OUT) + (size_t)j * 1024 * 1024; ldk = 1024; }
    else if ((r -= 512) < 640) { K = 1024; N = 2560; src = p.b_w_in; dst = WSP(bf16_t, O_WT_B_IN); ldk = 1024; }
    else if ((r -= 640) < 256) { K = 1024; N = 1024; src = p.b_w_out; dst = WSP(bf16_t, O_WT_B_OUT); ldk = 1024; }
    else if ((r -= 256) < 640) { K = 1024; N = 2560; src = p.c_w_in; dst = WSP(bf16_t, O_WT_C_IN); ldk = 1024; }
    else if ((r -= 640) < 320) { K = 1280; N = 1024; src = p.c_w_out; dst = WSP(bf16_t, O_WT_C_OUT); ldk = 1280; }
    else { r -= 320; int m = r / 4; r %= 4; K = 128; N = 128; ldk = 128; wscale = -1.4426950408889634f;
      src = (m < 20 ? p.c_w_ra + (size_t)m * 16384 : p.c_w_ri + (size_t)(m - 20) * 16384); dst = WSP(bf16_t, O_WT_GATE) + (size_t)m * 16384; }
    const int tnn = (N + 63) / 64;
    conv_tile_wave(src, K, N, dst, ldk, r / tnn, r % tnn, Tw, tid & 63, wscale);
  }
  (void)NJ;
  for (int i = blockIdx.x * NTHR + tid; i < 2 * 224 * 1024 / 8; i += gridDim.x * NTHR) {
    const int j = i / (224 * 128), r = i % (224 * 128);
    *(u32x4*)(WSP(bf16_t, O_WT_A_IN) + (size_t)j * NA_IN * 1024 + (size_t)3104 * 1024 + (size_t)r * 8) = (u32x4){0u, 0u, 0u, 0u};
  }
  for (int i = blockIdx.x * NTHR + tid; i < 2048; i += gridDim.x * NTHR) {
    const int pos = i >> 4, k = i & 15;
    const float f = powf(10000.0f, -(float)k / 16.0f);
    const float ang = (float)pos * f;
    float s, c; sincosf(ang, &s, &c);
    WSP(float, O_ROPE)[2 * i] = c; WSP(float, O_ROPE)[2 * i + 1] = s;
  }
  {
    float* sv = (float*)lds;
    float* red = (float*)(lds + 20480);
    __syncthreads();
    for (int i = tid; i < 5 * 1024; i += NTHR) {
      const int r = i >> 10, k = i & 1023;
      const float v = (r < 4) ? p.c[r * 1024 + k] : p.c_ctx[k];
      sv[i] = silu_f(v);
    }
    __syncthreads();
    const int lane = tid & 63, w = tid >> 6;
    for (int it = blockIdx.x; it < 4 * 48; it += gridDim.x) {
      const int layer = it / 48, n0 = (it % 48) * 64;
      const float* W = p.w_mod + (size_t)layer * 1024 * 3072 + n0 + lane;
      float a0 = 0.f, a1 = 0.f, a2 = 0.f, a3 = 0.f, a4 = 0.f;
#pragma unroll 8
      for (int k = w * 128; k < w * 128 + 128; ++k) {
        const float wv = W[(size_t)k * 3072];
        a0 += sv[k] * wv; a1 += sv[1024 + k] * wv; a2 += sv[2048 + k] * wv; a3 += sv[3072 + k] * wv; a4 += sv[4096 + k] * wv;
      }
      red[(w * 5 + 0) * 64 + lane] = a0; red[(w * 5 + 1) * 64 + lane] = a1; red[(w * 5 + 2) * 64 + lane] = a2;
      red[(w * 5 + 3) * 64 + lane] = a3; red[(w * 5 + 4) * 64 + lane] = a4;
      __syncthreads();
      if (tid < 320) {
        const int r = tid >> 6, l = tid & 63;
        float s = p.b_mod[layer * 3072 + n0 + l];
#pragma unroll
        for (int ww = 0; ww < 8; ++ww) s += red[(ww * 5 + r) * 64 + l];
        WSP(float, O_MOD)[((size_t)layer * 5 + r) * 3072 + n0 + l] = s;
      }
      __syncthreads();
    }
  }
}

__device__ __forceinline__ void post_rows(const Params& p, int layer, int m_first, int stride, int nrows) {
  const int tid = threadIdx.x, lane = tid & 63;
  const int nl = layer + 1;
  float gpv[16], gprev[16], gatev[16], scv[16], shv[16];
#pragma unroll
  for (int hh = 0; hh < 2; ++hh)
#pragma unroll
    for (int q4 = 0; q4 < 2; ++q4) {
      const int e0 = hh * 512 + lane * 8 + 4 * q4;
      if (layer >= 0) { const f32x4 t = *(const f32x4*)(p.g_post + layer * DM + e0); gpv[hh * 8 + 4 * q4] = t[0]; gpv[hh * 8 + 4 * q4 + 1] = t[1]; gpv[hh * 8 + 4 * q4 + 2] = t[2]; gpv[hh * 8 + 4 * q4 + 3] = t[3]; }
      if (layer < 3) { const f32x4 t = *(const f32x4*)(p.g_pre + nl * DM + e0); gprev[hh * 8 + 4 * q4] = t[0]; gprev[hh * 8 + 4 * q4 + 1] = t[1]; gprev[hh * 8 + 4 * q4 + 2] = t[2]; gprev[hh * 8 + 4 * q4 + 3] = t[3]; }
    }
  int cur_mb = -1;
  f32x4 xr[4]; u32x4 yr[2];
#define POST_LOAD(mm) { const float* xin_ = ((mm) < ML) ? ((layer <= 0) ? p.x + (size_t)(mm) * DM : p.out + (size_t)(mm) * DM) \
                                                     : ((layer <= 0) ? p.ctx + (size_t)((mm) - ML) * DM : WSP(float, O_XC) + (size_t)((mm) - ML) * DM); \
    xr[0] = *(const f32x4*)(xin_ + lane * 8); xr[1] = *(const f32x4*)(xin_ + lane * 8 + 4); xr[2] = *(const f32x4*)(xin_ + 512 + lane * 8); xr[3] = *(const f32x4*)(xin_ + 512 + lane * 8 + 4); \
    if (layer >= 0) { yr[0] = __builtin_nontemporal_load((const u32x4*)(WSP(bf16_t, O_Y) + (size_t)(mm) * DM + lane * 8)); yr[1] = __builtin_nontemporal_load((const u32x4*)(WSP(bf16_t, O_Y) + (size_t)(mm) * DM + 512 + lane * 8)); } }
  int m = m_first;
  if (m < nrows) POST_LOAD(m)
  while (m < nrows) {
    const int mn = m + stride;
    float xv[16], yv[16];
#pragma unroll
    for (int hh = 0; hh < 2; ++hh)
#pragma unroll
      for (int i = 0; i < 4; ++i) {
        xv[hh * 8 + i] = xr[2 * hh][i]; xv[hh * 8 + 4 + i] = xr[2 * hh + 1][i];
        if (layer >= 0) { yv[hh * 8 + 2 * i] = bflo(yr[hh][i]); yv[hh * 8 + 2 * i + 1] = bfhi(yr[hh][i]); }
      }
    if (mn < nrows) POST_LOAD(mn)
    const int mb = (m < ML) ? (m >> 13) : 4;
    if (mb != cur_mb) {
      cur_mb = mb;
#pragma unroll
      for (int hh = 0; hh < 2; ++hh)
#pragma unroll
        for (int q4 = 0; q4 < 2; ++q4) {
          const int e0 = hh * 512 + lane * 8 + 4 * q4, o = hh * 8 + 4 * q4;
          if (layer >= 0) { const f32x4 t = *(const f32x4*)(WSP(float, O_MOD) + ((size_t)layer * 5 + mb) * 3072 + 2048 + e0); gatev[o] = t[0]; gatev[o + 1] = t[1]; gatev[o + 2] = t[2]; gatev[o + 3] = t[3]; }
          if (layer < 3) {
            const float* sh = WSP(float, O_MOD) + ((size_t)nl * 5 + mb) * 3072 + e0;
            const f32x4 t = *(const f32x4*)sh, u = *(const f32x4*)(sh + 1024);
            shv[o] = t[0]; shv[o + 1] = t[1]; shv[o + 2] = t[2]; shv[o + 3] = t[3];
            scv[o] = 1.0f + u[0]; scv[o + 1] = 1.0f + u[1]; scv[o + 2] = 1.0f + u[2]; scv[o + 3] = 1.0f + u[3];
          }
        }
    }
    float* xout = (m < ML) ? p.out + (size_t)m * DM : WSP(float, O_XC) + (size_t)(m - ML) * DM;
    if (layer >= 0) {
      float ss = 0.f;
#pragma unroll
      for (int i = 0; i < 16; ++i) ss += yv[i] * yv[i];
      ss = wave_sum(ss);
      const float r = rsqrtf(ss * (1.0f / 1024.0f) + EPS);
#pragma unroll
      for (int hh = 0; hh < 2; ++hh) {
        const int e0 = hh * 512 + lane * 8;
        f32x4 o0, o1;
#pragma unroll
        for (int i = 0; i < 8; ++i) {
          const float v = xv[hh * 8 + i] + gatev[hh * 8 + i] * (yv[hh * 8 + i] * r * gpv[hh * 8 + i]);
          xv[hh * 8 + i] = v;
          if (i < 4) o0[i] = v; else o1[i - 4] = v;
        }
        __builtin_nontemporal_store(o0, (f32x4*)(xout + e0)); __builtin_nontemporal_store(o1, (f32x4*)(xout + e0 + 4));
      }
    }
    if (layer < 3) {
      float ss = 0.f;
#pragma unroll
      for (int i = 0; i < 16; ++i) ss += xv[i] * xv[i];
      ss = wave_sum(ss);
      const float r = rsqrtf(ss * (1.0f / 1024.0f) + EPS);
#pragma unroll
      for (int hh = 0; hh < 2; ++hh) {
        const int e0 = hh * 512 + lane * 8;
        float hv[8];
#pragma unroll
        for (int i = 0; i < 8; ++i) hv[i] = xv[hh * 8 + i] * r * gprev[hh * 8 + i] * scv[hh * 8 + i] + shv[hh * 8 + i];
        u32x4 o; o[0] = pk2(hv[0], hv[1]); o[1] = pk2(hv[2], hv[3]); o[2] = pk2(hv[4], hv[5]); o[3] = pk2(hv[6], hv[7]);
        *(u32x4*)(WSP(bf16_t, O_H) + (size_t)m * DM + e0) = o;
      }
    }
    m = mn;
  }
#undef POST_LOAD
}

template <int EPI>
__device__ __forceinline__ void gemm_phase(const Params& p, const bf16_t* __restrict__ A, int lda, const bf16_t* __restrict__ Bt, int N, int K,
                           bf16_t* __restrict__ C, int ldc, int mtiles, char* lds, int vb) {
  const int tid = threadIdx.x, lane = tid & 63, w = tid >> 6, l15 = lane & 15, quad = lane >> 4;
  const int wm = w >> 1, wn = w & 1;
  const int ntn = N / 128, ntiles = mtiles * ntn, nk = K / 64;
  bf16_t* As0 = (bf16_t*)lds; bf16_t* Bs0 = As0 + 256 * 64;
  bf16_t* As1 = (bf16_t*)(lds + 49152); bf16_t* Bs1 = As1 + 256 * 64;
  const int lrow = tid >> 3, lch = (tid & 7) * 8;
  const int wsw = (((tid & 7) ^ (lrow & 7)) * 8);
  const int rsw = l15 & 7;
  u32x4 s0a0, s0a1, s0a2, s0a3, s0b0, s0b1, s1a0, s1a1, s1a2, s1a3, s1b0, s1b1, s2a0, s2a1, s2a2, s2a3, s2b0, s2b1;
  const bf16_t* Ag = A; const bf16_t* Bg = Bt;
  int m0 = 0, n0 = 0;
#define G_TILE_PTRS(t_) { const int band_ = (t_) / (4 * ntn), qq_ = (t_) % (4 * ntn); \
      m0 = (4 * band_ + (qq_ & 3)) * 256; n0 = (qq_ >> 2) * 128; \
      Ag = A + (size_t)(m0 + lrow) * lda + lch; Bg = Bt + (size_t)(n0 + lrow) * K + lch; }
#define G_LOAD(S, kt_) { const int ko_ = (kt_) * 64; \
      S##a0 = *(const u32x4*)(Ag + ko_); S##a1 = *(const u32x4*)(Ag + (size_t)64 * lda + ko_); S##a2 = *(const u32x4*)(Ag + (size_t)128 * lda + ko_); S##a3 = *(const u32x4*)(Ag + (size_t)192 * lda + ko_); \
      S##b0 = *(const u32x4*)(Bg + ko_); S##b1 = *(const u32x4*)(Bg + (size_t)64 * K + ko_); }
#define G_WRITE(S, buf_) { bf16_t* a_ = ((buf_) ? As1 : As0) + lrow * 64 + wsw; bf16_t* b_ = ((buf_) ? Bs1 : Bs0) + lrow * 64 + wsw; \
      *(u32x4*)a_ = S##a0; *(u32x4*)(a_ + 64 * 64) = S##a1; *(u32x4*)(a_ + 128 * 64) = S##a2; *(u32x4*)(a_ + 192 * 64) = S##a3; \
      *(u32x4*)b_ = S##b0; *(u32x4*)(b_ + 64 * 64) = S##b1; }
#define G_COMP(ks) { \
        bf16x8 xf[4], wf[4]; \
        _Pragma("unroll") for (int i = 0; i < 4; ++i) { \
          xf[i] = *(const bf16x8*)(as + (wm * 64 + i * 16 + l15) * 64 + ((((ks) * 4 + quad) ^ rsw) * 8)); \
          wf[i] = *(const bf16x8*)(bs + (wn * 64 + i * 16 + l15) * 64 + ((((ks) * 4 + quad) ^ rsw) * 8)); } \
        _Pragma("unroll") for (int mi = 0; mi < 4; ++mi) \
          _Pragma("unroll") for (int ni = 0; ni < 4; ++ni) acc[mi][ni] = mfma16(wf[ni], xf[mi], acc[mi][ni]); }
#define G_BODY(kt_, S) { \
      if ((kt_) + 1 < nk) { G_WRITE(S, ((kt_) + 1) & 1) if ((kt_) + 4 < nk) G_LOAD(S, (kt_) + 4) } \
      const bf16_t* as = ((kt_) & 1) ? As1 : As0; const bf16_t* bs = ((kt_) & 1) ? Bs1 : Bs0; \
      G_COMP(0) \
      G_COMP(1) \
      __syncthreads(); }
  int t = vb;
  if (t < ntiles) { G_TILE_PTRS(t) G_LOAD(s0, 0) G_LOAD(s1, 1) G_LOAD(s2, 2) }
  while (t < ntiles) {
    f32x4 acc[4][4];
#pragma unroll
    for (int i = 0; i < 4; ++i)
#pragma unroll
      for (int j = 0; j < 4; ++j) acc[i][j] = (f32x4){0.f, 0.f, 0.f, 0.f};
    G_WRITE(s0, 0)
    G_LOAD(s0, 3)
    __syncthreads();
    for (int kt = 0; kt < nk; kt += 3) {
      G_BODY(kt, s1)
      if (kt + 1 < nk) G_BODY(kt + 1, s2)
      if (kt + 2 < nk) G_BODY(kt + 2, s0)
    }
    const int m0c = m0, n0c = n0;
    t += gridDim.x;
    if (t < ntiles) { G_TILE_PTRS(t) G_LOAD(s0, 0) G_LOAD(s1, 1) G_LOAD(s2, 2) }
    const int nw = n0c + wn * 64;
    if (EPI == 2) {
      if (nw < 1280 && m0c < ML) {
#pragma unroll
        for (int mi = 0; mi < 4; ++mi) {
          const int m = m0c + wm * 64 + mi * 16 + l15;
          const int tt = m & 8191;
#pragma unroll
          for (int pr = 0; pr < 2; ++pr) {
            const int pos = pr ? (tt & 63) : (tt >> 6);
            const float* rp = WSP(float, O_ROPE) + (size_t)(pos * 16 + quad * 4) * 2;
            const f32x4 r0 = *(const f32x4*)rp, r1 = *(const f32x4*)(rp + 4);
            const float cs[4] = {r0[0], r0[2], r1[0], r1[2]}, sn[4] = {r0[1], r0[3], r1[1], r1[3]};
#pragma unroll
            for (int j = 0; j < 4; ++j) {
              const float x1 = acc[mi][2 * pr][j], x2 = acc[mi][2 * pr + 1][j];
              acc[mi][2 * pr][j] = x1 * cs[j] - x2 * sn[j];
              acc[mi][2 * pr + 1][j] = x2 * cs[j] + x1 * sn[j];
            }
          }
        }
      }
    }
#pragma unroll
    for (int mi = 0; mi < 4; ++mi) {
      const int m = m0c + wm * 64 + mi * 16 + l15;
#pragma unroll
      for (int ni = 0; ni < 4; ++ni) {
        const int n = nw + ni * 16 + quad * 4;
        const f32x4 v = acc[mi][ni];
        if (EPI == 1) {
          if (n < 3072) { u32x2 o; o[0] = pk2(v[0], v[1]); o[1] = pk2(v[2], v[3]); *(u32x2*)(C + (size_t)m * ldc + n) = o; }
          else if (n < 3104) { *(f32x4*)(WSP(float, O_G1) + (size_t)m * 32 + (n - 3072)) = v; }
        } else {
          u32x2 o; o[0] = pk2(v[0], v[1]); o[1] = pk2(v[2], v[3]); *(u32x2*)(C + (size_t)m * ldc + n) = o;
        }
      }
    }
  }
}

#undef G_LOAD
#undef G_WRITE
#undef G_BODY
#undef G_COMP
#undef G_TILE_PTRS
namespace pg8 {
#define PG8_LAS __attribute__((address_space(3)))
typedef unsigned short bf16_t;
typedef short bf16x8 __attribute__((ext_vector_type(8)));
typedef float f32x4 __attribute__((ext_vector_type(4)));
typedef unsigned u32x4 __attribute__((ext_vector_type(4)));
constexpr int BM = 256, BK = 64, HALF = 128, HTB = HALF * BK * 2  , STAGE_BYTES = 8 * HTB, NXCD = 8, WGM = 8;

__host__ __device__ __forceinline__ int lds_byte(int r, int c) { const int st = (r >> 4) * 2 + (c >> 5), rr = r & 15, cc = c & 31, ob = rr * 64 + cc * 2; return st * 1024 + (ob ^ (((ob >> 9) & 1) << 5)); }
__host__ __device__ __forceinline__ void stage_rc(int b, int& R, int& C) { const int st = b / 1024, sb = b % 1024, swz = sb ^ (((sb >> 9) & 1) << 5); R = (st >> 1) * 16 + swz / 64; C = (st & 1) * 32 + (swz % 64) / 2; }
__host__ __device__ __forceinline__ int perm32(int rho) { const int n = rho >> 4, i = rho & 15; return 8 * (i >> 2) + 4 * n + (i & 3); }

struct Unit { int pm, pn; };
struct Gemm { const bf16_t* A; const bf16_t* Bt; int M, N, K; };

struct StaticOrder {
    int nM, nN, nwg, G, c;
    __host__ __device__ void init(int M, int N, int G_, int c_) { nM = M / BM; nN = N / BM; nwg = nM * nN; G = G_; c = c_; }
    __host__ __device__ bool next(int i, Unit& u) const {
        const long L = (long)i * G + c; if (L >= nwg) return false;
        int wgid = (int)L; { const int q = nwg / NXCD, r = nwg % NXCD, xcd = wgid % NXCD, off = wgid / NXCD; wgid = (xcd < r ? xcd * (q + 1) : r * (q + 1) + (xcd - r) * q) + off; }
        const int nig = WGM * nN, gid = wgid / nig, fm = gid * WGM, gsz = (nM - fm) < WGM ? (nM - fm) : WGM;
        u.pm = fm + ((wgid % nig) % gsz); u.pn = (wgid % nig) / gsz; return true;
    }
    __device__ __forceinline__ void a_ready(const Unit&) const {}
    __device__ __forceinline__ void done(const Unit&) const {}
};
template <class Epi, class Sched, bool ALIGN_EPI = false, bool SP2 = false>
__device__ __forceinline__ void gemm_phase(PG8_LAS unsigned char* lds, const Gemm g, const Sched& S, const Epi& E) {
    const int tid = threadIdx.x, wid = __builtin_amdgcn_readfirstlane(tid >> 6), lane = tid & 63, wr = wid >> 2, wc = wid & 3, fr = lane & 15, fq = lane >> 4;
    const int K = g.K, nt = K / BK;
    unsigned voffA[2], voffB[2];
#pragma unroll
    for (int i = 0; i < 2; ++i) { int R, C; stage_rc(tid * 16 + i * 8192, R, C); const int Rb = Epi::PERM ? ((R & ~31) + perm32(R & 31)) : R;
        voffA[i] = (unsigned)(R * K + C) * 2u; voffB[i] = (unsigned)(Rb * K + C) * 2u; }
    const size_t kstep = (size_t)(BK * 2);
    const size_t hstep = (size_t)HALF * K * 2;
    const size_t tstep = 2 * hstep;
    const unsigned ldsw = (unsigned)wid * 1024u;
    const int aoff = lds_byte(wr * 64 + fr, fq * 8), boff = lds_byte(wc * 32 + fr, fq * 8);
#define PG8_SA(b, h) (((b) * 2 + (h)) * HTB)
#define PG8_SB(b, h) ((4 + (b) * 2 + (h)) * HTB)
#define PG8_STAGE(bufoff, gbase, voff) do { _Pragma("unroll") for (int _i = 0; _i < 2; ++_i) \
        __builtin_amdgcn_global_load_lds((const unsigned*)((const char*)(gbase) + (voff)[_i]), (PG8_LAS unsigned*)(lds + (bufoff) + ldsw + _i * 8192), 16, 0, 0); } while (0)
#define PG8_LDA(dst, b, h) do { _Pragma("unroll") for (int m = 0; m < 4; ++m) _Pragma("unroll") for (int k = 0; k < 2; ++k) dst[m][k] = *(const PG8_LAS bf16x8*)(lds + PG8_SA(b, h) + aoff + m * 2048 + k * 1024); } while (0)
#define PG8_LDB(dst, b, h) do { _Pragma("unroll") for (int n = 0; n < 2; ++n) _Pragma("unroll") for (int k = 0; k < 2; ++k) dst[n][k] = *(const PG8_LAS bf16x8*)(lds + PG8_SB(b, h) + boff + n * 2048 + k * 1024); } while (0)
#define PG8_MMA(ai, bj, At, Bt) do { __builtin_amdgcn_s_setprio(1); _Pragma("unroll") for (int m = 0; m < 4; ++m) _Pragma("unroll") for (int n = 0; n < 2; ++n) _Pragma("unroll") for (int k = 0; k < 2; ++k) \
        acc[ai][bj][m][n] = __builtin_amdgcn_mfma_f32_16x16x32_bf16(Bt[n][k], At[m][k], acc[ai][bj][m][n], 0, 0, 0); __builtin_amdgcn_s_setprio(0); } while (0)
#define PG8_WAIT_V(n) asm volatile("s_waitcnt vmcnt(" #n ")" ::: "memory")
#define PG8_WAIT_L(n) asm volatile("s_waitcnt lgkmcnt(" #n ")" ::: "memory")
#define PG8_BAR __builtin_amdgcn_s_barrier()
#define PG8_SCHED __builtin_amdgcn_sched_barrier(0)
    Unit cur, nxt; int ui = 0;
    if (!S.next(0, cur)) return;
    f32x4 acc[2][2][4][2];
#pragma unroll
    for (int a = 0; a < 2; ++a)
#pragma unroll
        for (int b = 0; b < 2; ++b)
#pragma unroll
            for (int m = 0; m < 4; ++m)
#pragma unroll
                for (int n = 0; n < 2; ++n) acc[a][b][m][n] = (f32x4){0.f, 0.f, 0.f, 0.f};
    bf16x8 At[4][2], B0[2][2], B1[2][2];
    const char* cA = (const char*)g.A + (size_t)cur.pm * tstep; const char* cB = (const char*)g.Bt + (size_t)cur.pn * tstep;
    S.a_ready(cur);
    if constexpr (SP2) {
        PG8_STAGE(PG8_SB(0, 0), cB, voffB); PG8_STAGE(PG8_SB(0, 1), cB + hstep, voffB); PG8_STAGE(PG8_SA(0, 0), cA, voffA); PG8_STAGE(PG8_SA(0, 1), cA + hstep, voffA);
        if (wr == 1) PG8_BAR;
        PG8_WAIT_V(2); PG8_BAR;
        PG8_STAGE(PG8_SB(1, 0), cB + kstep, voffB); PG8_STAGE(PG8_SA(1, 0), cA + kstep, voffA); PG8_STAGE(PG8_SB(1, 1), cB + hstep + kstep, voffB);
        PG8_WAIT_V(6); PG8_BAR;
    } else {
        PG8_STAGE(PG8_SB(0, 0), cB, voffB); PG8_STAGE(PG8_SA(0, 0), cA, voffA); PG8_STAGE(PG8_SB(0, 1), cB + hstep, voffB); PG8_STAGE(PG8_SA(0, 1), cA + hstep, voffA);
        if (wr == 1) PG8_BAR;
        PG8_WAIT_V(4); PG8_BAR;
        PG8_STAGE(PG8_SB(1, 0), cB + kstep, voffB); PG8_STAGE(PG8_SA(1, 0), cA + kstep, voffA); PG8_STAGE(PG8_SB(1, 1), cB + hstep + kstep, voffB);
        PG8_WAIT_V(6); PG8_BAR;
    }
    for (;;) {
        const bool has_next = S.next(ui + 1, nxt);
        const char* nA = has_next ? (const char*)g.A + (size_t)nxt.pm * tstep : cA; const char* nB = has_next ? (const char*)g.Bt + (size_t)nxt.pn * tstep : cB;
        for (int t = 0; t < nt; t += 2) {
            const bool last = (t == nt - 2);
            const char* a1 = cA + (size_t)(t + 1) * kstep;
            const char* a2 = last ? nA : cA + (size_t)(t + 2) * kstep; const char* b2 = last ? nB : cB + (size_t)(t + 2) * kstep;
            const char* a3 = a2 + kstep; const char* b3 = b2 + kstep;
            if (last && has_next) S.a_ready(nxt);
            if constexpr (SP2) {
            PG8_LDB(B0, 0, 0); PG8_LDB(B1, 0, 1); PG8_SCHED; PG8_LDA(At, 0, 0); PG8_STAGE(PG8_SA(1, 1), a1 + hstep, voffA);
            PG8_WAIT_V(8); PG8_WAIT_L(0); PG8_BAR; PG8_MMA(0, 0, At, B0); PG8_MMA(0, 1, At, B1); PG8_BAR; PG8_SCHED;
            PG8_LDA(At, 0, 1); PG8_STAGE(PG8_SB(0, 0), b2, voffB); PG8_STAGE(PG8_SB(0, 1), b2 + hstep, voffB); PG8_STAGE(PG8_SA(0, 0), a2, voffA);
            PG8_WAIT_V(8); PG8_WAIT_L(0); PG8_BAR; PG8_MMA(1, 0, At, B0); PG8_MMA(1, 1, At, B1); PG8_BAR; PG8_SCHED;
            PG8_LDB(B0, 1, 0); PG8_LDB(B1, 1, 1); PG8_SCHED; PG8_LDA(At, 1, 0); PG8_STAGE(PG8_SA(0, 1), a2 + hstep, voffA);
            PG8_WAIT_V(8); PG8_WAIT_L(0); PG8_BAR; PG8_MMA(0, 0, At, B0); PG8_MMA(0, 1, At, B1); PG8_BAR; PG8_SCHED;
            PG8_LDA(At, 1, 1); PG8_STAGE(PG8_SB(1, 0), b3, voffB); PG8_STAGE(PG8_SB(1, 1), b3 + hstep, voffB); PG8_STAGE(PG8_SA(1, 0), a3, voffA);
            PG8_WAIT_V(8); PG8_WAIT_L(0); PG8_BAR; PG8_MMA(1, 0, At, B0); PG8_MMA(1, 1, At, B1); PG8_BAR; PG8_SCHED;
            } else {
            PG8_LDB(B0, 0, 0); PG8_SCHED; PG8_LDA(At, 0, 0); PG8_STAGE(PG8_SA(1, 1), a1 + hstep, voffA);
            PG8_WAIT_L(8); PG8_BAR; PG8_WAIT_L(0); PG8_MMA(0, 0, At, B0); PG8_BAR; PG8_SCHED;
            PG8_LDB(B1, 0, 1); PG8_STAGE(PG8_SB(0, 0), b2, voffB);
            PG8_BAR; PG8_WAIT_L(0); PG8_MMA(0, 1, At, B1); PG8_BAR;
            PG8_LDA(At, 0, 1); PG8_STAGE(PG8_SA(0, 0), a2, voffA);
            PG8_BAR; PG8_WAIT_L(0); PG8_MMA(1, 0, At, B0); PG8_BAR; PG8_SCHED;
            PG8_STAGE(PG8_SB(0, 1), b2 + hstep, voffB);
            PG8_WAIT_V(6); PG8_BAR; PG8_MMA(1, 1, At, B1); PG8_BAR;
            PG8_LDB(B0, 1, 0); PG8_SCHED; PG8_LDA(At, 1, 0); PG8_STAGE(PG8_SA(0, 1), a2 + hstep, voffA);
            PG8_WAIT_L(8); PG8_BAR; PG8_WAIT_L(0); PG8_MMA(0, 0, At, B0); PG8_BAR; PG8_SCHED;
            PG8_LDB(B1, 1, 1); PG8_STAGE(PG8_SB(1, 0), b3, voffB);
            PG8_BAR; PG8_WAIT_L(0); PG8_MMA(0, 1, At, B1); PG8_BAR;
            PG8_LDA(At, 1, 1); PG8_STAGE(PG8_SA(1, 0), a3, voffA);
            PG8_BAR; PG8_WAIT_L(0); PG8_MMA(1, 0, At, B0); PG8_BAR; PG8_SCHED;
            PG8_STAGE(PG8_SB(1, 1), b3 + hstep, voffB);
            PG8_WAIT_V(6); PG8_BAR; PG8_MMA(1, 1, At, B1); PG8_BAR;
            }
        }
        if constexpr (ALIGN_EPI) { if (wr == 0) PG8_BAR; }
        if constexpr (!Epi::AFTER_DRAIN) { E(acc, cur, wr, wc, fr, fq); S.done(cur); }
        if (!has_next) break;
#pragma unroll
        for (int a = 0; a < 2; ++a)
#pragma unroll
            for (int b = 0; b < 2; ++b)
#pragma unroll
                for (int m = 0; m < 4; ++m)
#pragma unroll
                    for (int n = 0; n < 2; ++n) acc[a][b][m][n] = (f32x4){0.f, 0.f, 0.f, 0.f};
        cur = nxt; cA = nA; cB = nB; ++ui;
        if constexpr (ALIGN_EPI) { if (wr == 1) PG8_BAR; }
    }
    PG8_WAIT_V(0);
    if constexpr (!ALIGN_EPI) { if (wr == 0) PG8_BAR; }
    PG8_BAR;
    if constexpr (Epi::AFTER_DRAIN) { E.fused(acc, cur, wr, wc, fr, fq, lds, wid, lane); S.done(cur); }
#undef PG8_SA
#undef PG8_SB
#undef PG8_STAGE
#undef PG8_LDA
#undef PG8_LDB
#undef PG8_MMA
#undef PG8_WAIT_V
#undef PG8_WAIT_L
#undef PG8_BAR
#undef PG8_SCHED
}
}

struct GSched {
  int ntn, nunits, G, c;
  __device__ __forceinline__ bool next(int i, pg8::Unit& u) const {
    const long L = (long)i * G + c; if (L >= nunits) return false;
    const int band = (int)(L / (4 * ntn)), q = (int)(L % (4 * ntn)); u.pm = 4 * band + (q & 3); u.pn = q >> 2; return true;
  }
  __device__ __forceinline__ void a_ready(const pg8::Unit&) const {}
  __device__ __forceinline__ void done(const pg8::Unit&) const {}
};
template <int EPI> struct GEpi {
  static constexpr bool PERM = (EPI != 2), AFTER_DRAIN = false;
  bf16_t* C; int ldc; float* g1; const float* rope;
  __device__ __forceinline__ void operator()(f32x4 (&acc)[2][2][4][2], const pg8::Unit& u, int wr, int wc, int fr, int fq) const {
#pragma unroll
    for (int ai = 0; ai < 2; ++ai)
#pragma unroll
      for (int m = 0; m < 4; ++m) {
        const int row = u.pm * 256 + ai * 128 + wr * 64 + m * 16 + fr;
#pragma unroll
        for (int bj = 0; bj < 2; ++bj) {
          const int cb = u.pn * 256 + bj * 128 + wc * 32;
          if (EPI == 2) {
            f32x4 v0 = acc[ai][bj][m][0], v1 = acc[ai][bj][m][1];
            if (cb < 1280 && row < ML) {
              const int tt = row & 8191;
              const int pos = (wc & 1) ? (tt & 63) : (tt >> 6);
              const float* rp = rope + (size_t)(pos * 16 + fq * 4) * 2;
              const f32x4 r0 = *(const f32x4*)rp, r1 = *(const f32x4*)(rp + 4);
              const float cs[4] = {r0[0], r0[2], r1[0], r1[2]}, sn[4] = {r0[1], r0[3], r1[1], r1[3]};
#pragma unroll
              for (int j = 0; j < 4; ++j) { const float x1 = v0[j], x2 = v1[j]; v0[j] = x1 * cs[j] - x2 * sn[j]; v1[j] = x2 * cs[j] + x1 * sn[j]; }
            }
            u32x2 o0, o1; o0[0] = pk2(v0[0], v0[1]); o0[1] = pk2(v0[2], v0[3]); o1[0] = pk2(v1[0], v1[1]); o1[1] = pk2(v1[2], v1[3]);
            bf16_t* cp = C + (size_t)row * ldc + cb + 4 * fq;
            *(u32x2*)cp = o0; *(u32x2*)(cp + 16) = o1;
          } else {
            const int col = cb + 8 * fq;
            const f32x4 v0 = acc[ai][bj][m][0], v1 = acc[ai][bj][m][1];
            if (EPI == 1 && col >= 3072) {
              if (col < 3104) { float* gp = g1 + (size_t)row * 32 + (col - 3072); *(f32x4*)gp = v0; *(f32x4*)(gp + 4) = v1; }
            } else {
              u32x4 o; o[0] = pk2(v0[0], v0[1]); o[1] = pk2(v0[2], v0[3]); o[2] = pk2(v1[0], v1[1]); o[3] = pk2(v1[2], v1[3]);
              *(u32x4*)(C + (size_t)row * ldc + col) = o;
            }
          }
        }
      }
  }
};
template <int EPI>
__device__ __forceinline__ void gemm8(const Params& p, const bf16_t* A, const bf16_t* Bt, int M, int N, int K, bf16_t* C, int ldc, char* lds, int vb) {
  pg8::Gemm g{A, Bt, M, N, K};
  GSched S{N / 256, (M / 256) * (N / 256), (int)gridDim.x, vb};
  GEpi<EPI> E{C, ldc, WSP(float, O_G1), WSP(float, O_ROPE)};
  pg8::gemm_phase<GEpi<EPI>, GSched, true, true>((PG8_LAS unsigned char*)lds, g, S, E);
}

constexpr int G_G1S = 0, G_TOT = 4096, G_BS = 6144, G_QS = 38912, G_KS = 56320, G_KHS = 73728, G_VS = 91136, G_PS = 124928, G_RED = 134144, G_WG2 = 136192;
constexpr int QP = 136, VP = 264, PP = 72;

template <int MODE>
__device__ __forceinline__ void gla_run(const Params& p, int jl, int hd, int dir, int row_first, int row_step, int nch, f32x4 (&S)[8][2], float& logD, char* lds) {
  const int tid = threadIdx.x, lane = tid & 63, w = tid >> 6, l15 = lane & 15, quad = lane >> 4;
  float* g1s = (float*)(lds + G_G1S); float* tot = (float*)(lds + G_TOT); float* bs = (float*)(lds + G_BS);
  bf16_t* qs = (bf16_t*)(lds + G_QS); bf16_t* ks_ = (bf16_t*)(lds + G_KS); bf16_t* khs = (bf16_t*)(lds + G_KHS);
  bf16_t* vs = (bf16_t*)(lds + G_VS); bf16_t* ps = (bf16_t*)(lds + G_PS); float* red = (float*)(lds + G_RED);
  float wb[4];
#pragma unroll
  for (int ks4 = 0; ks4 < 4; ++ks4) wb[ks4] = p.a_w_g2[((size_t)(jl * 2 + dir) * 16 + 4 * ks4 + quad) * 512 + hd * 128 + 16 * w + l15];
  const float bg = p.a_b_g[(jl * 2 + dir) * 512 + hd * 128 + 16 * w + l15];
  const int tl = dir ? 0 : 63;
  constexpr bool PF = (MODE == 0);
  u32x4 rq[2], rk[2], rv[4];
  f32x4 rg1 = {0.f, 0.f, 0.f, 0.f};
  const unsigned g1off = (unsigned)((tid >> 2) * 128 + (tid & 3) * 16);
  const unsigned qkoff = (unsigned)((tid >> 4) * 6144 + (tid & 15) * 16);
  const unsigned vvoff = (unsigned)((tid >> 5) * 6144 + (tid & 31) * 16);
  const unsigned eoff = (unsigned)(l15 * 2048 + (32 * w + 4 * quad) * 2);
  const unsigned zoff = (unsigned)(l15 * 6144 + (32 * w + 4 * quad) * 2);
#define GLA_ISSUE_G1(row0_) { \
    const char* g1b_ = sb_ptr((const char*)WSP(float, O_G1) + (size_t)(row0_) * 128 + dir * 64); \
    if (tid < 256) rg1 = *(const f32x4*)(g1b_ + g1off); }
#define GLA_ISSUE(row0_) { \
    const char* qb_ = sb_ptr((const char*)WSP(bf16_t, O_PROJ) + (size_t)(row0_) * 6144 + hd * 256); \
    _Pragma("unroll") for (int i = 0; i < 2; ++i) { \
      if (MODE != 0) rq[i] = *(const u32x4*)(qb_ + (qkoff + (unsigned)(i * 32 * 6144))); \
      rk[i] = *(const u32x4*)(qb_ + 1024 + (qkoff + (unsigned)(i * 32 * 6144))); } \
    const char* vb_ = sb_ptr((const char*)WSP(bf16_t, O_PROJ) + (size_t)(row0_) * 6144 + 2048 + hd * 512); \
    _Pragma("unroll") for (int i = 0; i < 4; ++i) rv[i] = *(const u32x4*)(vb_ + (vvoff + (unsigned)(i * 16 * 6144))); }
  f32x4 ghv[2];
  u32x2 pof[4][2], pz[4][2];
  float* const g1sA = g1s; float* const g1sB = (float*)(lds + G_KHS); float* const blv = tot;
  GLA_ISSUE_G1(row_first)
  if (tid < 256) *(f32x4*)(g1sA + (tid >> 2) * 16 + (tid & 3) * 4) = rg1;
  if (nch > 1) GLA_ISSUE_G1(row_first + row_step)
  __syncthreads();
  if (PF) GLA_ISSUE(row_first)
  for (int ci = 0; ci < nch; ++ci) {
    const int row0 = row_first + ci * row_step;
    if (!PF) GLA_ISSUE(row0)
    const float* const g1c = (ci & 1) ? g1sB : g1sA;
    {
      float lav[4][4];
      const int arow = 16 * (l15 >> 2) + (l15 & 3);
#pragma unroll
      for (int mt = 0; mt < 4; ++mt) {
        f32x4 acc4 = {0.f, 0.f, 0.f, 0.f};
#pragma unroll
        for (int ks4 = 0; ks4 < 4; ++ks4) acc4 = __builtin_amdgcn_mfma_f32_16x16x4f32(g1c[(arow + 4 * mt) * 16 + 4 * ks4 + quad], wb[ks4], acc4, 0, 0, 0);
#pragma unroll
        for (int j = 0; j < 4; ++j) {
          const float xg = acc4[j] + bg;
          lav[mt][j] = (fminf(xg, 0.f) - 0.6931471805599453f * __builtin_amdgcn_logf(1.0f + __builtin_amdgcn_exp2f(-1.4426950408889634f * fabsf(xg)))) * (1.0f / 16.0f);
        }
      }
      float run = 0.f;
      if (dir == 0) {
#pragma unroll
        for (int mt = 0; mt < 4; ++mt)
#pragma unroll
          for (int j = 0; j < 4; ++j) { run += lav[mt][j]; lav[mt][j] = run; }
      } else {
#pragma unroll
        for (int mt = 3; mt >= 0; --mt)
#pragma unroll
          for (int j = 3; j >= 0; --j) { run += lav[mt][j]; lav[mt][j] = run; }
      }
      const float t0 = __shfl(run, l15), t1 = __shfl(run, l15 + 16), t2 = __shfl(run, l15 + 32), t3 = __shfl(run, l15 + 48);
      float off;
      if (dir == 0) off = (quad > 0 ? t0 : 0.f) + (quad > 1 ? t1 : 0.f) + (quad > 2 ? t2 : 0.f);
      else off = (quad < 3 ? t3 : 0.f) + (quad < 2 ? t2 : 0.f) + (quad < 1 ? t1 : 0.f);
#pragma unroll
      for (int mt = 0; mt < 4; ++mt)
#pragma unroll
        for (int j = 0; j < 4; ++j) bs[(16 * quad + 4 * mt + j) * 128 + 16 * w + l15] = lav[mt][j] + off;
    }
    __syncthreads();
    if (tid < 128) { const float blt = bs[tl * 128 + tid]; logD += blt; blv[(ci & 1) * 128 + tid] = blt; }
    if (ci + 1 < nch) {
      if (tid < 256) *(f32x4*)(((ci & 1) ? g1sA : g1sB) + (tid >> 2) * 16 + (tid & 3) * 4) = rg1;
      if (ci + 2 < nch) GLA_ISSUE_G1(row0 + 2 * row_step)
    }
#pragma unroll
    for (int i = 0; i < 2; ++i) {
      const int cc = tid + 512 * i, t = cc >> 4, ch = cc & 15;
      const f32x4 b0 = *(const f32x4*)(bs + t * 128 + ch * 8), b1 = *(const f32x4*)(bs + t * 128 + ch * 8 + 4);
      float bv[8] = {b0[0], b0[1], b0[2], b0[3], b1[0], b1[1], b1[2], b1[3]};
      float kf[8], qf[8];
#pragma unroll
      for (int e = 0; e < 4; ++e) { kf[2 * e] = bflo(rk[i][e]); kf[2 * e + 1] = bfhi(rk[i][e]); }
      u32x4 ok;
#pragma unroll
      for (int e = 0; e < 4; ++e) ok[e] = pk2(kf[2 * e] * __expf(-bv[2 * e]), kf[2 * e + 1] * __expf(-bv[2 * e + 1]));
      *(u32x4*)(ks_ + t * QP + ch * 8) = ok;
      if (MODE != 0) {
#pragma unroll
        for (int e = 0; e < 4; ++e) { qf[2 * e] = bflo(rq[i][e]); qf[2 * e + 1] = bfhi(rq[i][e]); }
        u32x4 oq;
        const float qsc = 0.08838834764831845f;
#pragma unroll
        for (int e = 0; e < 4; ++e) oq[e] = pk2(qf[2 * e] * (qsc * __expf(bv[2 * e])), qf[2 * e + 1] * (qsc * __expf(bv[2 * e + 1])));
        *(u32x4*)(qs + t * QP + ch * 8) = oq;
      }
    }
#pragma unroll
    for (int i = 0; i < 4; ++i) {
      const int cc = tid + 512 * i, t = cc >> 5, ch = cc & 31;
      *(u32x4*)(vs + t * VP + ch * 8) = rv[i];
    }
    if (PF && ci + 1 < nch) GLA_ISSUE(row0 + row_step)
    const char* ofb = sb_ptr((const char*)WSP(bf16_t, O_OF) + (size_t)row0 * 2048 + hd * 512);
    if (MODE == 2) {
      __builtin_amdgcn_sched_barrier(0);
#pragma unroll
      for (int it = 0; it < 4; ++it)
#pragma unroll
        for (int et = 0; et < 2; ++et)
          pof[it][et] = *(const u32x2*)(ofb + (eoff + (unsigned)(it * 32768 + et * 32)));
      __builtin_amdgcn_sched_barrier(0);
    }
    __syncthreads();
    if (MODE != 0) {
      const int it = w >> 1;
#pragma unroll
      for (int si = 0; si < 2; ++si) {
        const int st = 2 * (w & 1) + si;
        f32x4 sc = {0.f, 0.f, 0.f, 0.f};
#pragma unroll
        for (int kk = 0; kk < 4; ++kk) {
          const bf16x8 a = *(const bf16x8*)(ks_ + (16 * st + l15) * QP + 32 * kk + 8 * quad);
          const bf16x8 b = *(const bf16x8*)(qs + (16 * it + l15) * QP + 32 * kk + 8 * quad);
          sc = mfma16(a, b, sc);
        }
        const int ii = 16 * it + l15;
#pragma unroll
        for (int j = 0; j < 4; ++j) {
          const int s = 16 * st + 4 * quad + j;
          const bool keep = dir ? (s >= ii) : (s <= ii);
          if (!keep) sc[j] = 0.f;
        }
        u32x2 o; o[0] = pk2(sc[0], sc[1]); o[1] = pk2(sc[2], sc[3]);
        *(u32x2*)(ps + ii * PP + 16 * st + 4 * quad) = o;
      }
      __syncthreads();
    }
    f32x4 o[4][2];
    if (MODE != 0) {
      bf16x8 vf[2][2];
#pragma unroll
      for (int et = 0; et < 2; ++et)
#pragma unroll
        for (int kk = 0; kk < 2; ++kk) vf[et][kk] = frag_tr(vs, VP, 32 * kk, 32 * w + 16 * et, lane);
#pragma unroll
      for (int it = 0; it < 4; ++it)
#pragma unroll
        for (int et = 0; et < 2; ++et) o[it][et] = (f32x4){0.f, 0.f, 0.f, 0.f};
#pragma unroll
      for (int it = 0; it < 4; ++it)
#pragma unroll
        for (int kk = 0; kk < 2; ++kk) {
          const bf16x8 pb = *(const bf16x8*)(ps + (16 * it + l15) * PP + 32 * kk + 8 * quad);
#pragma unroll
          for (int et = 0; et < 2; ++et) o[it][et] = mfma16(vf[et][kk], pb, o[it][et]);
        }
#pragma unroll
      for (int m = 0; m < 4; ++m) {
        bf16x8 sf[2];
#pragma unroll
        for (int et = 0; et < 2; ++et) sf[et] = pack8(S[2 * m][et], S[2 * m + 1][et]);
#pragma unroll
        for (int it = 0; it < 4; ++it) {
          const bf16_t* qp = qs + (16 * it + l15) * QP + 32 * m + 4 * quad;
          const s16x4 q0 = *(const s16x4*)qp, q1 = *(const s16x4*)(qp + 16);
          bf16x8 qb; qb[0] = q0[0]; qb[1] = q0[1]; qb[2] = q0[2]; qb[3] = q0[3]; qb[4] = q1[0]; qb[5] = q1[1]; qb[6] = q1[2]; qb[7] = q1[3];
#pragma unroll
          for (int et = 0; et < 2; ++et) o[it][et] = mfma16(sf[et], qb, o[it][et]);
        }
      }
    }
    if (MODE == 1) {
#pragma unroll
      for (int it = 0; it < 4; ++it)
#pragma unroll
        for (int et = 0; et < 2; ++et) {
          u32x2 ov; ov[0] = pk2(o[it][et][0], o[it][et][1]); ov[1] = pk2(o[it][et][2], o[it][et][3]);
          *(u32x2*)((char*)ofb + (eoff + (unsigned)(it * 32768 + et * 32))) = ov;
        }
    }
    if (MODE == 2) {
#pragma unroll
      for (int it = 0; it < 4; ++it)
#pragma unroll
        for (int et = 0; et < 2; ++et)
          pz[it][et] = *(const u32x2*)(sb_ptr((const char*)WSP(bf16_t, O_PROJ) + (size_t)row0 * 6144 + 4096 + hd * 512) + (zoff + (unsigned)(it * 16 * 6144 + et * 32)));
#pragma unroll
      for (int et = 0; et < 2; ++et) ghv[et] = *(const f32x4*)(p.a_g_head + (size_t)(jl * 4 + hd) * 256 + 32 * w + 16 * et + 4 * quad);
#pragma unroll
      for (int it = 0; it < 4; ++it) {
        float s = 0.f;
#pragma unroll
        for (int et = 0; et < 2; ++et) {
          const u32x2 pv = pof[it][et];
          o[it][et][0] += bflo(pv[0]); o[it][et][1] += bfhi(pv[0]); o[it][et][2] += bflo(pv[1]); o[it][et][3] += bfhi(pv[1]);
#pragma unroll
          for (int j = 0; j < 4; ++j) s += o[it][et][j] * o[it][et][j];
        }
        s += __shfl_xor(s, 16); s += __shfl_xor(s, 32);
        if (quad == 0) red[(16 * it + l15) * 8 + w] = s;
      }
      __syncthreads();
#pragma unroll
      for (int it = 0; it < 4; ++it) {
        const f32x4 r0 = *(const f32x4*)(red + (16 * it + l15) * 8), r1 = *(const f32x4*)(red + (16 * it + l15) * 8 + 4);
        const float tot2 = (r0[0] + r0[1]) + (r0[2] + r0[3]) + (r1[0] + r1[1]) + (r1[2] + r1[3]);
        const float rn = rsqrtf(tot2 * (1.0f / 256.0f) + EPS);
        const size_t row = (size_t)(row0 + 16 * it + l15);
#pragma unroll
        for (int et = 0; et < 2; ++et) {
          const int e = 32 * w + 16 * et + 4 * quad;
          const f32x4 gh = ghv[et];
          const u32x2 zv = pz[it][et];
          const float z0 = bflo(zv[0]), z1 = bfhi(zv[0]), z2 = bflo(zv[1]), z3 = bfhi(zv[1]);
          const float v0 = o[it][et][0] * rn * gh[0] * silu_f(z0), v1 = o[it][et][1] * rn * gh[1] * silu_f(z1);
          const float v2 = o[it][et][2] * rn * gh[2] * silu_f(z2), v3 = o[it][et][3] * rn * gh[3] * silu_f(z3);
          u32x2 ov; ov[0] = pk2(v0, v1); ov[1] = pk2(v2, v3);
          *(u32x2*)(sb_ptr((char*)WSP(bf16_t, O_OG) + (size_t)row0 * 2048 + hd * 512) + (eoff + (unsigned)(it * 32768 + et * 32))) = ov;
        }
      }
    }
    bf16x8 vf2[2][2];
#pragma unroll
    for (int et = 0; et < 2; ++et)
#pragma unroll
      for (int kk = 0; kk < 2; ++kk) vf2[et][kk] = frag_tr(vs, VP, 32 * kk, 32 * w + 16 * et, lane);
#pragma unroll
    for (int dt = 0; dt < 8; ++dt) {
#pragma unroll
      for (int kk = 0; kk < 2; ++kk) {
        const bf16x8 ka = frag_tr(ks_, QP, 32 * kk, 16 * dt, lane);
#pragma unroll
        for (int et = 0; et < 2; ++et) S[dt][et] = mfma16(ka, vf2[et][kk], S[dt][et]);
      }
    }
#pragma unroll
    for (int dt = 0; dt < 8; ++dt) {
      const f32x4 bl = *(const f32x4*)(blv + (ci & 1) * 128 + 16 * dt + 4 * quad);
      f32x4 sc; sc[0] = __expf(bl[0]); sc[1] = __expf(bl[1]); sc[2] = __expf(bl[2]); sc[3] = __expf(bl[3]);
#pragma unroll
      for (int et = 0; et < 2; ++et) S[dt][et] = S[dt][et] * sc;
    }
  }
}

#undef GLA_ISSUE
#undef GLA_ISSUE_G1
__device__ __forceinline__ void gla_p1(const Params& p, int jl, int ctx_out, char* lds) {
  const int tid = threadIdx.x;
  for (int item = blockIdx.x; item < 512; item += gridDim.x) {
    const int u = item & 15, rec = item >> 4;
    const int dir = rec & 1, hd = (rec >> 1) & 3, b = rec >> 3;
    f32x4 S[8][2];
#pragma unroll
    for (int i = 0; i < 8; ++i) { S[i][0] = (f32x4){0.f, 0.f, 0.f, 0.f}; S[i][1] = (f32x4){0.f, 0.f, 0.f, 0.f}; }
    float logD = 0.f;
    int row_first, step, nch;
    if (u == 0) { nch = 4; row_first = ML + b * 256 + (dir ? 192 : 0); step = dir ? -64 : 64; }
    else { const int pp = u - 1; const int ts = dir ? 15 - pp : pp; nch = 8; row_first = b * 8192 + ts * 512 + (dir ? 448 : 0); step = dir ? -64 : 64; }
    gla_run<0>(p, jl, hd, dir, row_first, step, nch, S, logD, lds);
    f32x4* E = (f32x4*)WSP(float, O_SEG_E) + (size_t)item * 16 * 512;
#pragma unroll
    for (int dt = 0; dt < 8; ++dt)
#pragma unroll
      for (int et = 0; et < 2; ++et) E[(dt * 2 + et) * 512 + tid] = S[dt][et];
    if (tid < 128) WSP(float, O_SEG_D)[(size_t)item * 128 + tid] = __expf(logD);
    if (ctx_out && u == 0) {
      const int pi = rec >> 1, want = (pi < 8) ? (pi & 1) : 1 - (pi & 1);
      if (dir == want) {
#pragma unroll
        for (int i = 0; i < 8; ++i) { S[i][0] = (f32x4){0.f, 0.f, 0.f, 0.f}; S[i][1] = (f32x4){0.f, 0.f, 0.f, 0.f}; }
        float dummy = 0.f;
        gla_run<1>(p, jl, hd, 0, ML + b * 256, 64, 4, S, dummy, lds);
      }
    }
  }
}

__device__ __forceinline__ void gla_scan_phase(const Params& p, int jl, int ctx_out, char* lds) {
  const int tid = threadIdx.x;
  const int nskip = ctx_out ? 16 : 0;
  if ((int)blockIdx.x < nskip) {
    const int hd = blockIdx.x & 3, b = blockIdx.x >> 2;
    f32x4 S[8][2];
#pragma unroll
    for (int i = 0; i < 8; ++i) { S[i][0] = (f32x4){0.f, 0.f, 0.f, 0.f}; S[i][1] = (f32x4){0.f, 0.f, 0.f, 0.f}; }
    float dummy = 0.f;
    gla_run<2>(p, jl, hd, 1, ML + b * 256 + 192, -64, 4, S, dummy, lds);
    return;
  }
  f32x4* Eall = (f32x4*)WSP(float, O_SEG_E);
  const float* Dall = WSP(float, O_SEG_D);
  for (int slot = ((int)blockIdx.x - nskip) * NTHR + tid; slot < 32 * 8192; slot += ((int)gridDim.x - nskip) * NTHR) {
    const int rec = slot >> 13, q = slot & 8191;
    const int dt = (q >> 9) >> 1, quad = ((q & 511) & 63) >> 4;
    f32x4* E = Eall + (size_t)(rec * 16) * 8192 + q;
    const float* D = Dall + (size_t)(rec * 16) * 128 + 16 * dt + 4 * quad;
    f32x4 ev[16];
#pragma unroll
    for (int u = 0; u < 16; ++u) ev[u] = E[(size_t)u * 8192];
    f32x4 S = ev[0];
#pragma unroll
    for (int u = 1; u < 16; ++u) {
      const f32x4 dv = *(const f32x4*)(D + (size_t)u * 128);
      S = S * dv + ev[u];
      E[(size_t)u * 8192] = S;
    }
  }
}

__device__ __forceinline__ void gla_fold(const Params& p, int rec, int upto, f32x4 (&S)[8][2]) {
  const int tid = threadIdx.x;
  if (upto < 0) {
#pragma unroll
    for (int dt = 0; dt < 8; ++dt) { S[dt][0] = (f32x4){0.f, 0.f, 0.f, 0.f}; S[dt][1] = (f32x4){0.f, 0.f, 0.f, 0.f}; }
    return;
  }
  const f32x4* E = (const f32x4*)WSP(float, O_SEG_E) + (size_t)(rec * 16 + upto) * 16 * 512;
#pragma unroll
  for (int dt = 0; dt < 8; ++dt)
#pragma unroll
    for (int et = 0; et < 2; ++et) S[dt][et] = E[(dt * 2 + et) * 512 + tid];
}

__device__ __forceinline__ void gla_p2(const Params& p, int jl, int ctx_out, char* lds) {
  const int nitems = 256 + (ctx_out ? 16 : 0);
  for (int item0 = blockIdx.x; item0 < nitems; item0 += gridDim.x) {
    int item = item0;
    bool is_ctx = false;
    if (ctx_out) { if (item0 < 16) is_ctx = true; else item = item0 - 16; }
    int hd, b, ts, nch, nch1, rf0, rf1;
    if (is_ctx) { hd = item & 3; b = item >> 2; ts = 0; nch = 4; nch1 = 0; rf0 = ML + b * 256; rf1 = rf0 + 192; }
    else { ts = item & 15; hd = (item >> 4) & 3; b = item >> 6; nch = 8; nch1 = 8; rf0 = b * 8192 + ts * 512; rf1 = rf0 + 448; }
    const int rec0 = (b * 4 + hd) * 2;
    f32x4 S[8][2];
    float logD = 0.f;
    gla_fold(p, rec0, is_ctx ? -1 : ts, S);
    gla_run<1>(p, jl, hd, 0, rf0, 64, nch1, S, logD, lds);
    gla_fold(p, rec0 + 1, is_ctx ? -1 : 15 - ts, S);
    gla_run<2>(p, jl, hd, 1, rf1, -64, nch, S, logD, lds);
  }
}

constexpr int KP = 72;
constexpr float QSC = 0.125f * 1.4426950408889634f;
__device__ __forceinline__ void attn_phase(const Params& p, int ctx_out, char* lds) {
  const int tid = threadIdx.x, lane = tid & 63, w = tid >> 6, l15 = lane & 15, quad = lane >> 4;
  bf16_t* KVb = (bf16_t*)lds;
  const int nitems = 4096 + (ctx_out ? 128 : 0);
  for (int item = blockIdx.x; item < nitems; item += gridDim.x) {
    int b, h, qrow0, nblk, tix0;
    if (item < 4096) {
      nblk = item & 63; h = (item >> 6) & 15; b = item >> 10;
      qrow0 = b * 8192 + nblk * 128; tix0 = 0;
    } else {
      const int it = item - 4096; const int cb = it & 1; h = (it >> 1) & 15; b = it >> 5;
      qrow0 = ML + b * 256 + cb * 128; nblk = 1; tix0 = 3;
    }
    const int hk = h >> 2;
    const int ii = 16 * w + l15;
    const size_t qrow = (size_t)(qrow0 + ii);
    bf16x8 qf[2];
#pragma unroll
    for (int kk = 0; kk < 2; ++kk) {
      const u32x4 u = *(const u32x4*)(WSP(bf16_t, O_PROJ) + qrow * 2560 + h * 64 + 32 * kk + 8 * quad);
      union { bf16x8 v; unsigned uu[4]; } r;
#pragma unroll
      for (int e = 0; e < 4; ++e) r.uu[e] = pk2(bflo(u[e]) * QSC, bfhi(u[e]) * QSC);
      qf[kk] = r.v;
    }
    float m_run = p.b_sink[h] * 1.4426950408889634f;
    float l_part = (quad == 0) ? 1.f : 0.f;
    f32x4 O[4];
#pragma unroll
    for (int d = 0; d < 4; ++d) O[d] = (f32x4){0.f, 0.f, 0.f, 0.f};
    u32x4 pk0, pk1, pv0, pv1;
#define ATT_ISSUE(tix_) { const int kr_ = ((tix_) < 3) ? b * 8192 + (nblk - 1 + (tix_)) * 128 : ML + b * 256 + ((tix_) - 3) * 128; \
      const bf16_t* src_ = WSP(bf16_t, O_PROJ) + (size_t)(kr_ + (tid >> 3)) * 2560 + 1024 + hk * 64 + (tid & 7) * 8; \
      pk0 = *(const u32x4*)src_; pv0 = *(const u32x4*)(src_ + 256); pk1 = *(const u32x4*)(src_ + (size_t)64 * 2560); pv1 = *(const u32x4*)(src_ + (size_t)64 * 2560 + 256); }
#define ATT_TILE(KS_, VS_, MODE_, KLO_, KHI_) { \
      f32x4 sc[8]; float mx = -INFINITY; \
      const int mlo = ((MODE_) == 1) ? ii : -100000, mhi = ((MODE_) == 2) ? ii : 100000; \
      _Pragma("unroll") for (int kt = 0; kt < 8; ++kt) { \
        if (kt >= (KLO_) && kt <= (KHI_)) { \
          f32x4 s_ = {0.f, 0.f, 0.f, 0.f}; \
          _Pragma("unroll") for (int kk = 0; kk < 2; ++kk) { \
            const bf16x8 a_ = *(const bf16x8*)((KS_) + (16 * kt + l15) * KP + 32 * kk + 8 * quad); \
            s_ = mfma16(a_, qf[kk], s_); } \
          if ((MODE_) != 0 && kt == w) { \
            _Pragma("unroll") for (int j = 0; j < 4; ++j) { \
              const int kkey = 16 * kt + 4 * quad + j; \
              const int dneg = min(kkey - mlo, 0) + min(mhi - kkey, 0); \
              s_[j] += (float)dneg * 1e30f; } } \
          mx = fmaxf(mx, fmaxf(fmaxf(s_[0], s_[1]), fmaxf(s_[2], s_[3]))); \
          sc[kt] = s_; \
        } else sc[kt] = (f32x4){0.f, 0.f, 0.f, 0.f}; } \
      mx = fmaxf(mx, __shfl_xor(mx, 16)); mx = fmaxf(mx, __shfl_xor(mx, 32)); \
      const float m_new = fmaxf(m_run, mx); \
      const float alpha = __builtin_amdgcn_exp2f(m_run - m_new); \
      m_run = m_new; l_part *= alpha; \
      _Pragma("unroll") for (int d = 0; d < 4; ++d) O[d] = O[d] * alpha; \
      _Pragma("unroll") for (int kt = 0; kt < 8; ++kt) { \
        if (kt >= (KLO_) && kt <= (KHI_)) { \
          _Pragma("unroll") for (int j = 0; j < 4; ++j) { const float e_ = __builtin_amdgcn_exp2f(sc[kt][j] - m_new); sc[kt][j] = e_; l_part += e_; } } } \
      _Pragma("unroll") for (int kp = 0; kp < 4; ++kp) { \
        if (2 * kp + 1 >= (KLO_) && 2 * kp <= (KHI_)) { \
          const bf16x8 pb = pack8(sc[2 * kp], sc[2 * kp + 1]); \
          _Pragma("unroll") for (int d = 0; d < 4; ++d) { \
            const int q_ = (lane & 15) >> 2, pp_ = lane & 3; \
            const bf16_t* a0 = (VS_) + (32 * kp + 4 * quad + q_) * KP + 16 * d + 4 * pp_; \
            const s16x4 r0 = tr_read(a0), r1 = tr_read(a0 + 16 * KP); \
            bf16x8 va; va[0] = r0[0]; va[1] = r0[1]; va[2] = r0[2]; va[3] = r0[3]; va[4] = r1[0]; va[5] = r1[1]; va[6] = r1[2]; va[7] = r1[3]; \
            O[d] = mfma16(va, pb, O[d]); } } } }
#define ATT_WRITE(KS_, VS_) { const int r_ = tid >> 3, ch_ = tid & 7; \
      *(u32x4*)((KS_) + r_ * KP + ch_ * 8) = pk0; *(u32x4*)((VS_) + r_ * KP + ch_ * 8) = pv0; \
      *(u32x4*)((KS_) + (r_ + 64) * KP + ch_ * 8) = pk1; *(u32x4*)((VS_) + (r_ + 64) * KP + ch_ * 8) = pv1; }
    bf16_t* const K0 = KVb; bf16_t* const V0 = KVb + 128 * KP; bf16_t* const K1 = KVb + 256 * KP; bf16_t* const V1 = K1 + 128 * KP;
    const bool paired = (tix0 == 0 && nblk > 0 && nblk < 63);
    int tix = (tix0 == 0 && nblk == 0) ? 1 : tix0;
    int par = 0;
    __syncthreads();
    if (paired) {
      ATT_ISSUE(0)
      ATT_WRITE(K0, V0)
      ATT_ISSUE(2)
      ATT_WRITE(K1, V1)
      __syncthreads();
      ATT_ISSUE(1)
      ATT_TILE(K0, V0, 1, w, 7)
      ATT_TILE(K1, V1, 2, 0, w)
      __syncthreads();
      tix = 1;
    } else {
      ATT_ISSUE(tix)
    }
#pragma unroll 1
    while (tix < 5) {
      int nx = tix + 1;
      if (nx == 2 && (nblk == 63 || paired)) nx = 3;
      const int mode = tix == 0 ? 1 : (tix == 2 ? 2 : 0);
      bf16_t* Ks = par ? K1 : K0; bf16_t* Vs = par ? V1 : V0; par ^= 1;
      ATT_WRITE(Ks, Vs)
      __syncthreads();
      if (nx < 5) ATT_ISSUE(nx)
      const int klo = (mode == 1) ? w : 0, khi = (mode == 2) ? w : 7;
      ATT_TILE(Ks, Vs, mode, klo, khi)
      tix = nx;
    }
#undef ATT_TILE
#undef ATT_WRITE
#undef ATT_ISSUE
    float l_tot = l_part; l_tot += __shfl_xor(l_tot, 16); l_tot += __shfl_xor(l_tot, 32);
    const float inv = 1.0f / l_tot;
#pragma unroll
    for (int d = 0; d < 4; ++d) {
      const int dd = 16 * d + 4 * quad;
      const u32x2 zv = *(const u32x2*)(WSP(bf16_t, O_PROJ) + qrow * 2560 + 1536 + h * 64 + dd);
      const float v0 = O[d][0] * inv * silu_f(bflo(zv[0])), v1 = O[d][1] * inv * silu_f(bfhi(zv[0]));
      const float v2 = O[d][2] * inv * silu_f(bflo(zv[1])), v3 = O[d][3] * inv * silu_f(bfhi(zv[1]));
      u32x2 ov; ov[0] = pk2(v0, v1); ov[1] = pk2(v2, v3);
      *(u32x2*)(WSP(bf16_t, O_OG) + qrow * 1024 + h * 64 + dd) = ov;
    }
  }
}

constexpr int R_CW = 0, R_UCF = 4096, R_UCS = 37888, R_US = 55296, R_HS = 126016;
constexpr int UFP = 132, USP = 136;
__device__ __forceinline__ int rho_row(int t) { return 16 * ((t >> 2) & 3) + 4 * (t >> 4) + (t & 3); }

template <bool REV, bool WANT_H>
__device__ __forceinline__ float scan16(float (&a)[4][4], float (&x)[4][4], float cin, int l15, int quad, float& A_tile) {
  float A = 1.f, H = 0.f;
#pragma unroll
  for (int mm = 0; mm < 4; ++mm)
#pragma unroll
    for (int jj = 0; jj < 4; ++jj) {
      const int mi = REV ? 3 - mm : mm, j = REV ? 3 - jj : jj;
      H = a[mi][j] * H + x[mi][j]; A *= a[mi][j];
    }
  const float A0 = __shfl(A, l15), A1 = __shfl(A, l15 + 16), A2 = __shfl(A, l15 + 32), A3 = __shfl(A, l15 + 48);
  const float H0 = __shfl(H, l15), H1 = __shfl(H, l15 + 16), H2 = __shfl(H, l15 + 32), H3 = __shfl(H, l15 + 48);
  A_tile = (A0 * A1) * (A2 * A3);
  float cc = cin, cl = cin;
  if (!REV) {
    if (quad == 0) cl = cc; cc = A0 * cc + H0;
    if (quad == 1) cl = cc; cc = A1 * cc + H1;
    if (quad == 2) cl = cc; cc = A2 * cc + H2;
    if (quad == 3) cl = cc; cc = A3 * cc + H3;
  } else {
    if (quad == 3) cl = cc; cc = A3 * cc + H3;
    if (quad == 2) cl = cc; cc = A2 * cc + H2;
    if (quad == 1) cl = cc; cc = A1 * cc + H1;
    if (quad == 0) cl = cc; cc = A0 * cc + H0;
  }
  if (WANT_H) {
    float h = cl;
#pragma unroll
    for (int mm = 0; mm < 4; ++mm)
#pragma unroll
      for (int jj = 0; jj < 4; ++jj) {
        const int mi = REV ? 3 - mm : mm, j = REV ? 3 - jj : jj;
        h = a[mi][j] * h + x[mi][j]; x[mi][j] = h;
      }
  }
  return cc;
}

template <int PASS>
__device__ __forceinline__ void rglru_phase(const Params& p, char* lds) {
  const int tid = threadIdx.x, lane = tid & 63, w = tid >> 6, l15 = lane & 15, quad = lane >> 4;
  float* cw = (float*)(lds + R_CW); float* ucf = (float*)(lds + R_UCF); bf16_t* ucs = (bf16_t*)(lds + R_UCS); bf16_t* us = (bf16_t*)(lds + R_US);
  const int tg_lo = (int)(((long long)blockIdx.x * 5280) / gridDim.x), tg_hi = (int)(((long long)(blockIdx.x + 1) * 5280) / gridDim.x);
  const int it_lo = tg_lo >> 2, it_hi = (tg_hi + 3) >> 2;
  const int cl = 16 * w + l15;
  bf16x8 wf[4][4];
  float bra[2], bri[2], sp[2];
  int cur_hd = -1;
  for (int item = it_lo; item < it_hi; ++item) {
    const int hd = item / 132, rem = item % 132, b = rem / 33, grp = rem % 33;
    const int ch = hd * 128 + cl;
    int idx0, row_base, seq_lo, seq_hi;
    if (grp == 0) { idx0 = 0; row_base = ML + b * 256; seq_lo = row_base; seq_hi = seq_lo + 256; }
    else { idx0 = 4 + 4 * (grp - 1); row_base = b * 8192 + 256 * (grp - 1); seq_lo = b * 8192; seq_hi = seq_lo + 8192; }
    __syncthreads();
    for (int c = tid; c < 259 * 16; c += NTHR) {
      const int r = c >> 4, c8 = (c & 15) * 8;
      const int grow = row_base - 2 + r;
      u32x4 v = {0u, 0u, 0u, 0u};
      if (grow >= seq_lo && grow < seq_hi) v = *(const u32x4*)(WSP(bf16_t, O_PROJ) + (size_t)grow * 2560 + hd * 128 + c8);
      *(u32x4*)(us + r * USP + c8) = v;
    }
    if (hd != cur_hd) {
      cur_hd = hd;
#pragma unroll
      for (int g4 = 0; g4 < 4; ++g4) {
        const int gt = g4 & 1, d = g4 >> 1;
        const bf16_t* wp = WSP(bf16_t, O_WT_GATE) + ((size_t)((gt * 2 + d) * 10 + hd) * 128 + cl) * 128 + 8 * quad;
#pragma unroll
        for (int kk = 0; kk < 4; ++kk) wf[g4][kk] = *(const bf16x8*)(wp + 32 * kk);
      }
#pragma unroll
      for (int d = 0; d < 2; ++d) {
        bra[d] = -1.4426950408889634f * p.c_b_ra[d * 1280 + ch]; bri[d] = -1.4426950408889634f * p.c_b_ri[d * 1280 + ch];
        const float nl = -p.c_lam[d * 1280 + ch];
        sp[d] = (-8.0f * 1.4426950408889634f) * (fmaxf(nl, 0.f) + log1pf(expf(-fabsf(nl))));
      }
      for (int i = tid; i < 640; i += NTHR) {
        const int r = i >> 7, cc = i & 127;
        cw[i] = (r < 4) ? p.c_conv_w[r * 1280 + hd * 128 + cc] : p.c_conv_b[hd * 128 + cc];
      }
    }
    __syncthreads();
    const int tl0 = max(tg_lo - 4 * item, 0), tl1 = min(tg_hi - 4 * item, 4);
    for (int tile = tl0; tile < tl1; ++tile) {
      const int idx = idx0 + tile, row0 = row_base + 64 * tile;
      const int tt = tid >> 3, c0 = (tid & 7) * 16;
      float cin0 = 0.f, cin1 = 0.f; u32x4 z0 = {0u, 0u, 0u, 0u}, z1 = {0u, 0u, 0u, 0u};
      if (PASS == 2) {
        cin0 = WSP(float, O_CI)[((size_t)((0 * 4 + b) * 132 + idx)) * 1280 + ch];
        cin1 = WSP(float, O_CI)[((size_t)((1 * 4 + b) * 132 + idx)) * 1280 + ch];
        const bf16_t* zp = WSP(bf16_t, O_PROJ) + (size_t)(row0 + tt) * 2560 + 1280 + hd * 128 + c0;
        z0 = *(const u32x4*)zp; z1 = *(const u32x4*)(zp + 8);
      }
      {
        float accv[16];
#pragma unroll
        for (int e = 0; e < 4; ++e) { const f32x4 bv = *(const f32x4*)(cw + 512 + c0 + 4 * e); accv[4 * e] = bv[0]; accv[4 * e + 1] = bv[1]; accv[4 * e + 2] = bv[2]; accv[4 * e + 3] = bv[3]; }
#pragma unroll
        for (int j4 = 0; j4 < 4; ++j4) {
          const bf16_t* up = us + (64 * tile + tt + j4) * USP + c0;
          const u32x4 u0 = *(const u32x4*)up, u1 = *(const u32x4*)(up + 8);
          float wv[16];
#pragma unroll
          for (int e = 0; e < 4; ++e) { const f32x4 t4 = *(const f32x4*)(cw + j4 * 128 + c0 + 4 * e); wv[4 * e] = t4[0]; wv[4 * e + 1] = t4[1]; wv[4 * e + 2] = t4[2]; wv[4 * e + 3] = t4[3]; }
#pragma unroll
          for (int e = 0; e < 4; ++e) {
            accv[2 * e] += bflo(u0[e]) * wv[2 * e]; accv[2 * e + 1] += bfhi(u0[e]) * wv[2 * e + 1];
            accv[8 + 2 * e] += bflo(u1[e]) * wv[8 + 2 * e]; accv[8 + 2 * e + 1] += bfhi(u1[e]) * wv[8 + 2 * e + 1];
          }
        }
        const int rr = rho_row(tt);
#pragma unroll
        for (int e = 0; e < 4; ++e) *(f32x4*)(ucf + rr * UFP + c0 + 4 * e) = (f32x4){accv[4 * e], accv[4 * e + 1], accv[4 * e + 2], accv[4 * e + 3]};
        u32x4 o0, o1;
#pragma unroll
        for (int e = 0; e < 4; ++e) { o0[e] = pk2(accv[2 * e], accv[2 * e + 1]); o1[e] = pk2(accv[8 + 2 * e], accv[8 + 2 * e + 1]); }
        *(u32x4*)(ucs + rr * USP + c0) = o0; *(u32x4*)(ucs + rr * USP + c0 + 8) = o1;
      }
      __syncthreads();
      f32x4 acc[4][4];
#pragma unroll
      for (int mi = 0; mi < 4; ++mi)
#pragma unroll
        for (int g4 = 0; g4 < 4; ++g4) acc[mi][g4] = (f32x4){0.f, 0.f, 0.f, 0.f};
#pragma unroll
      for (int kk = 0; kk < 4; ++kk)
#pragma unroll
        for (int mi = 0; mi < 4; ++mi) {
          const bf16x8 af = *(const bf16x8*)(ucs + (16 * mi + l15) * USP + 32 * kk + 8 * quad);
#pragma unroll
          for (int g4 = 0; g4 < 4; ++g4) acc[mi][g4] = mfma16(af, wf[g4][kk], acc[mi][g4]);
        }
      float ucv[4][4];
#pragma unroll
      for (int mi = 0; mi < 4; ++mi)
#pragma unroll
        for (int j = 0; j < 4; ++j) ucv[mi][j] = ucf[(16 * mi + 4 * quad + j) * UFP + cl];
      float hsum[4][4];
#pragma unroll
      for (int d = 0; d < 2; ++d) {
        float av[4][4], xv[4][4];
#pragma unroll
        for (int mi = 0; mi < 4; ++mi)
#pragma unroll
          for (int j = 0; j < 4; ++j) {
            const float rg = __builtin_amdgcn_rcpf(1.0f + __builtin_amdgcn_exp2f(acc[mi][2 * d][j] + bra[d]));
            const float ig = __builtin_amdgcn_rcpf(1.0f + __builtin_amdgcn_exp2f(acc[mi][2 * d + 1][j] + bri[d]));
            const float aa = __builtin_amdgcn_exp2f(rg * sp[d]);
            av[mi][j] = aa;
            xv[mi][j] = __builtin_amdgcn_sqrtf(fmaxf(1.0f - aa * aa, 0.f)) * ig * ucv[mi][j];
          }
        float at;
        if (PASS == 1) {
          const float hend = d ? scan16<true, false>(av, xv, 0.f, l15, quad, at) : scan16<false, false>(av, xv, 0.f, l15, quad, at);
          const size_t tci = ((size_t)((d * 4 + b) * 132 + idx)) * 1280 + ch;
          if (quad == 0) *(f32x2*)(WSP(float, O_TC) + tci * 2) = (f32x2){at, hend};
        } else {
          if (d) scan16<true, true>(av, xv, cin1, l15, quad, at); else scan16<false, true>(av, xv, cin0, l15, quad, at);
#pragma unroll
          for (int mi = 0; mi < 4; ++mi)
#pragma unroll
            for (int j = 0; j < 4; ++j) hsum[mi][j] = d ? hsum[mi][j] + xv[mi][j] : xv[mi][j];
        }
      }
      if (PASS == 1) __syncthreads();
      if (PASS == 2) {
        float* hsb = (float*)(lds + R_HS);
#pragma unroll
        for (int mi = 0; mi < 4; ++mi)
#pragma unroll
          for (int j = 0; j < 4; ++j) hsb[(16 * mi + 4 * quad + j) * UFP + cl] = hsum[mi][j];
        __syncthreads();
        const size_t row = (size_t)(row0 + tt);
        const int rr = rho_row(tt);
        float hv[16];
#pragma unroll
        for (int e = 0; e < 4; ++e) { const f32x4 t4 = *(const f32x4*)(hsb + rr * UFP + c0 + 4 * e); hv[4 * e] = t4[0]; hv[4 * e + 1] = t4[1]; hv[4 * e + 2] = t4[2]; hv[4 * e + 3] = t4[3]; }
        u32x4 o0, o1;
#pragma unroll
        for (int e = 0; e < 4; ++e) {
          o0[e] = pk2(hv[2 * e] * silu_f(bflo(z0[e])), hv[2 * e + 1] * silu_f(bfhi(z0[e])));
          o1[e] = pk2(hv[8 + 2 * e] * silu_f(bflo(z1[e])), hv[8 + 2 * e + 1] * silu_f(bfhi(z1[e])));
        }
        *(u32x4*)(WSP(bf16_t, O_OG) + row * 1280 + hd * 128 + c0) = o0; *(u32x4*)(WSP(bf16_t, O_OG) + row * 1280 + hd * 128 + c0 + 8) = o1;
      }
    }
  }
}

__device__ __forceinline__ void rglru_scan_phase(const Params& p, char* lds) {
  const int tid = threadIdx.x;
  f32x2* L = (f32x2*)lds;
  float* Cc = (float*)(lds + 132 * 40 * 8);
  for (int blk = blockIdx.x; blk < 256; blk += gridDim.x) {
    const int dir = blk >> 7, b = (blk & 127) >> 5, ch0 = (blk & 31) * 40;
    const size_t base = (size_t)((dir * 4 + b) * 132) * 1280 + ch0;
    __syncthreads();
    for (int e = tid; e < 132 * 40; e += NTHR) {
      const int idx = e / 40, cc = e % 40;
      L[e] = *(const f32x2*)(WSP(float, O_TC) + (base + (size_t)idx * 1280 + cc) * 2);
    }
    __syncthreads();
    if (tid < 40) {
      float carry = 0.f;
      for (int s = 0; s < 132; ++s) {
        int idx;
        if (dir == 0) idx = s; else idx = (s < 4) ? 3 - s : 135 - s;
        const f32x2 v = L[idx * 40 + tid];
        Cc[idx * 40 + tid] = carry;
        carry = v[0] * carry + v[1];
      }
    }
    __syncthreads();
    for (int e = tid; e < 132 * 40; e += NTHR) {
      const int idx = e / 40, cc = e % 40;
      WSP(float, O_CI)[base + (size_t)idx * 1280 + cc] = Cc[e];
    }
  }
}

#define XB_TMO      128
#define XB_XCNT(j)  (256  + 64 * (j))
#define XB_XSUB(j)  (1280 + 64 * (j))
#define XB_XGEN(j)  (2304 + 64 * (j))
#define XB_TOP      3328
#define XB_TOPGEN   3392
#define XCD_BAR_WORDS 3456
#define XB_SPIN_CAP (1u << 18)
#define LAS __attribute__((address_space(3)))

__device__ __forceinline__ unsigned xb_ld(unsigned* p)              { return __hip_atomic_load(p, __ATOMIC_RELAXED, __HIP_MEMORY_SCOPE_AGENT); }
__device__ __forceinline__ unsigned xb_add(unsigned* p, unsigned v) { return __hip_atomic_fetch_add(p, v, __ATOMIC_RELAXED, __HIP_MEMORY_SCOPE_AGENT); }
__device__ __forceinline__ unsigned xb_xcc_id() { return (unsigned)__builtin_amdgcn_s_getreg((3 << 11) | 20) & 0xFu; }
#define XB_SPIN(cond, bar) do { unsigned _sp = 0; while (cond) { __builtin_amdgcn_s_sleep(1); \
    if ((++_sp & 255u) == 0u) { if (xb_ld(&(bar)[XB_TMO])) break; if (_sp > XB_SPIN_CAP) { atomicAdd(&(bar)[XB_TMO], 1u); break; } } } } while (0)

struct XcdBarrier {
    unsigned* bar; unsigned x;
    volatile LAS unsigned* st;
};

__device__ __forceinline__ XcdBarrier xcd_barrier_post(unsigned* bar, volatile LAS unsigned* st) {
    XcdBarrier b; b.bar = bar; b.x = xb_xcc_id(); b.st = st;
    if (threadIdx.x == 0) (void)xb_add(&bar[XB_XCNT(b.x)], 1u);
    return b;
}
__device__ __forceinline__ void xcd_barrier_complete(unsigned* bar, unsigned x, unsigned& nloc, unsigned& nx) {
    const unsigned G = gridDim.x * gridDim.y * gridDim.z;
    unsigned sum, cnt, mine, sp = 0u;
    for (;;) {
        sum = 0u; cnt = 0u; mine = 0u;
#pragma unroll
        for (unsigned j = 0; j < 16; ++j) { const unsigned c = xb_ld(&bar[XB_XCNT(j)]); sum += c; cnt += (c > 0u) ? 1u : 0u; mine = (j == x) ? c : mine; }
        if (sum == G) break;
        __builtin_amdgcn_s_sleep(1);
        if ((++sp & 255u) == 0u) { if (xb_ld(&bar[XB_TMO])) break; if (sp > XB_SPIN_CAP) { atomicAdd(&bar[XB_TMO], 1u); break; } }
    }
    nloc = mine > 0u ? mine : 1u; nx = cnt > 0u ? cnt : 1u;
}

__device__ __forceinline__ void xcd_barrier(const XcdBarrier& b) {
    asm volatile("s_waitcnt vmcnt(0)" ::: "memory");
    __syncthreads();
    if (threadIdx.x == 0) {
        unsigned* bar = b.bar;
        __builtin_amdgcn_s_waitcnt(0);
        unsigned nloc = b.st[0], nx = b.st[1];
        if (nloc == 0u) { xcd_barrier_complete(bar, b.x, nloc, nx); b.st[0] = nloc; b.st[1] = nx; }
        const unsigned old = xb_add(&bar[XB_XSUB(b.x)], 1u);
        const unsigned gen = old / nloc;
        if (old + 1u == (gen + 1u) * nloc) {
            __builtin_amdgcn_fence(__ATOMIC_RELEASE, "agent");
            asm volatile("s_waitcnt vmcnt(0)" ::: "memory");
            const unsigned og = xb_add(&bar[XB_TOP], 1u);
            const unsigned tg = og / nx;
            if (og + 1u == (tg + 1u) * nx) xb_add(&bar[XB_TOPGEN], 1u);
            else XB_SPIN(xb_ld(&bar[XB_TOPGEN]) == tg, bar);
            __builtin_amdgcn_fence(__ATOMIC_ACQUIRE, "agent");
            xb_add(&bar[XB_XGEN(b.x)], 1u);
            asm volatile("s_waitcnt vmcnt(0)" ::: "memory");
        } else {
            XB_SPIN(xb_ld(&bar[XB_XGEN(b.x)]) == gen, bar);
            __builtin_amdgcn_fence(__ATOMIC_ACQUIRE, "agent");
            asm volatile("s_waitcnt vmcnt(0)" ::: "memory");
        }
    }
    __syncthreads();
}


__device__ __forceinline__ void post_phase(const Params& p, int layer) {
  post_rows(p, layer, blockIdx.x * 8 + (threadIdx.x >> 6), gridDim.x * 8, (layer == 3) ? ML : MT);
}
__device__ __forceinline__ void post_phase_ctx_overlap(const Params& p, int layer, const bf16_t* og_ctx, const bf16_t* wt, int K, char* lds, int vb) {
  const int tid = threadIdx.x, w = tid >> 6;
  if (vb < 16) {
    pg8::Gemm g{og_ctx, wt, MC, 1024, K};
    GSched S{4, 16, 16, vb};
    GEpi<0> E{WSP(bf16_t, O_Y) + (size_t)ML * 1024, 1024, WSP(float, O_G1), WSP(float, O_ROPE)};
    pg8::gemm_phase<GEpi<0>, GSched, true, true>((PG8_LAS unsigned char*)lds, g, S, E);
    unsigned* cnt = (unsigned*)(p.ws + O_BAR) + 3584 + 64 * layer;
    asm volatile("s_waitcnt vmcnt(0)" ::: "memory");
    __syncthreads();
    if (tid == 0) {
      __builtin_amdgcn_fence(__ATOMIC_RELEASE, "agent");
      asm volatile("s_waitcnt vmcnt(0)" ::: "memory");
      xb_add(cnt, 1u);
      unsigned spn = 0;
      while (xb_ld(cnt) < 16u) { __builtin_amdgcn_s_sleep(1); if (++spn > (1u << 20)) break; }
      __builtin_amdgcn_fence(__ATOMIC_ACQUIRE, "agent");
      asm volatile("s_waitcnt vmcnt(0)" ::: "memory");
    }
    __syncthreads();
    post_rows(p, layer, ML + vb * 8 + w, 16 * 8, MT);
  } else {
    post_rows(p, layer, (vb - 16) * 8 + w, 240 * 8, ML);
  }
}

template <class T> __device__ __forceinline__ T* uni_ptr(T* v) {
  const unsigned long long u = (unsigned long long)v;
  const unsigned lo = __builtin_amdgcn_readfirstlane((unsigned)u), hi = __builtin_amdgcn_readfirstlane((unsigned)(u >> 32));
  typedef __attribute__((address_space(1))) T GT;
  GT* g = (GT*)(((unsigned long long)hi << 32) | lo);
  return (T*)g;
}
__device__ __forceinline__ Params load_params(const Params& s) {
  Params q;
  q.x = uni_ptr(s.x); q.c = uni_ptr(s.c); q.ctx = uni_ptr(s.ctx); q.c_ctx = uni_ptr(s.c_ctx); q.w_mod = uni_ptr(s.w_mod); q.b_mod = uni_ptr(s.b_mod);
  q.g_pre = uni_ptr(s.g_pre); q.g_post = uni_ptr(s.g_post);
  q.a_w_in = uni_ptr(s.a_w_in); q.a_w_g1 = uni_ptr(s.a_w_g1); q.a_w_g2 = uni_ptr(s.a_w_g2); q.a_b_g = uni_ptr(s.a_b_g); q.a_g_head = uni_ptr(s.a_g_head); q.a_w_out = uni_ptr(s.a_w_out);
  q.b_w_in = uni_ptr(s.b_w_in); q.b_sink = uni_ptr(s.b_sink); q.b_w_out = uni_ptr(s.b_w_out);
  q.c_w_in = uni_ptr(s.c_w_in); q.c_conv_w = uni_ptr(s.c_conv_w); q.c_conv_b = uni_ptr(s.c_conv_b); q.c_w_ra = uni_ptr(s.c_w_ra); q.c_b_ra = uni_ptr(s.c_b_ra);
  q.c_w_ri = uni_ptr(s.c_w_ri); q.c_b_ri = uni_ptr(s.c_b_ri); q.c_lam = uni_ptr(s.c_lam); q.c_w_out = uni_ptr(s.c_w_out);
  q.out = uni_ptr(s.out); q.ws = uni_ptr(s.ws);
  return q;
}
#define PH(k, call) if (ph_lo <= (k) && (k) < ph_hi) { if ((k) > ph_lo) xcd_barrier(xb); { const Params p = load_params(sp); call; } }
#define PHR(k, rep, call) if (ph_lo <= (k) && (k) < ph_hi) { if ((k) > ph_lo) xcd_barrier(xb); { const Params p = load_params(sp); for (int rr_ = 0; rr_ < (rep); ++rr_) { call; } } }
__global__ void __launch_bounds__(512) mega(Params pk, int ph_lo, int ph_hi) {
  extern __shared__ __attribute__((aligned(16))) char lds[];
  __shared__ __attribute__((aligned(16))) Params sp;
  __shared__ uint4 xb_words;
  if (threadIdx.x == 0) { sp = pk; xb_words = make_uint4(0u, 0u, 0u, 0u); }
  __syncthreads();
  XcdBarrier xb; xb.bar = (unsigned*)(pk.ws + O_BAR); xb.x = xb_xcc_id(); xb.st = (volatile LAS unsigned*)&xb_words;
  if (threadIdx.x == 0) xb_words.z = xb_add(&xb.bar[XB_XCNT(xb.x)], 1u);
  __syncthreads();
  int vb = blockIdx.x;
  cg::grid_group grid = cg::this_grid();
  if (ph_hi < 0) grid.sync();
#ifdef DIAG_PHASE
  ph_lo = DIAG_PHASE; ph_hi = DIAG_PHASE + 1;
#endif
  PHR(0, REP_PRO, prologue_phase(p, lds))
  PHR(1, REP_PRO, post_phase(p, -1))
  if (ph_lo < 2) {
    bool uni = (gridDim.x == 256);
    for (int j = 0; j < 16; ++j) { const unsigned cnt = xb_ld(&xb.bar[XB_XCNT(j)]); uni = uni && (cnt == (j < 8 ? 32u : 0u)); }
    const unsigned rk = xb_words.z;
    if (uni && xb.x < 8 && rk < 32) vb = __builtin_amdgcn_readfirstlane((int)(xb.x * 32 + rk));
  }
  PHR(2, REP_G, gemm8<1>(p, WSP(bf16_t, O_H), WSP(bf16_t, O_WT_A_IN), 33792, NA_IN, 1024, WSP(bf16_t, O_PROJ), 3072, lds, vb))
  PHR(3, REP_GLA, gla_p1(p, 0, 1, lds))
  PH(4, gla_scan_phase(p, 0, 1, lds))
  PHR(5, REP_GLA, gla_p2(p, 0, 0, lds))
  PHR(6, REP_G, gemm8<0>(p, WSP(bf16_t, O_OG), WSP(bf16_t, O_WT_A_OUT), 32768, 1024, 1024, WSP(bf16_t, O_Y), 1024, lds, vb))
  PH(7, post_phase_ctx_overlap(p, 0, WSP(bf16_t, O_OG) + (size_t)ML * 1024, WSP(bf16_t, O_WT_A_OUT), 1024, lds, vb))
  PHR(8, REP_G, gemm8<2>(p, WSP(bf16_t, O_H), WSP(bf16_t, O_WT_B_IN), 33792, 2560, 1024, WSP(bf16_t, O_PROJ), 2560, lds, vb))
  PHR(9, REP_ATT, attn_phase(p, 1, lds))
  PHR(10, REP_G, gemm8<0>(p, WSP(bf16_t, O_OG), WSP(bf16_t, O_WT_B_OUT), 32768, 1024, 1024, WSP(bf16_t, O_Y), 1024, lds, vb))
  PH(11, post_phase_ctx_overlap(p, 1, WSP(bf16_t, O_OG) + (size_t)ML * 1024, WSP(bf16_t, O_WT_B_OUT), 1024, lds, vb))
  PHR(12, REP_G, gemm8<0>(p, WSP(bf16_t, O_H), WSP(bf16_t, O_WT_C_IN), 33792, 2560, 1024, WSP(bf16_t, O_PROJ), 2560, lds, vb))
  PHR(13, REP_R, rglru_phase<1>(p, lds))
  PHR(14, REP_R, rglru_scan_phase(p, lds))
  PHR(15, REP_R, rglru_phase<2>(p, lds))
  PHR(16, REP_G, gemm8<0>(p, WSP(bf16_t, O_OG), WSP(bf16_t, O_WT_C_OUT), 32768, 1024, 1280, WSP(bf16_t, O_Y), 1024, lds, vb))
  PH(17, post_phase_ctx_overlap(p, 2, WSP(bf16_t, O_OG) + (size_t)ML * 1280, WSP(bf16_t, O_WT_C_OUT), 1280, lds, vb))
  PHR(18, REP_G, gemm8<1>(p, WSP(bf16_t, O_H), WSP(bf16_t, O_WT_A_IN) + (size_t)NA_IN * 1024, 33792, NA_IN, 1024, WSP(bf16_t, O_PROJ), 3072, lds, vb))
  PHR(19, REP_GLA, gla_p1(p, 1, 0, lds))
  PH(20, gla_scan_phase(p, 1, 0, lds))
  PHR(21, REP_GLA, gla_p2(p, 1, 0, lds))
  PHR(22, REP_G, gemm8<0>(p, WSP(bf16_t, O_OG), WSP(bf16_t, O_WT_A_OUT) + (size_t)1024 * 1024, 32768, 1024, 1024, WSP(bf16_t, O_Y), 1024, lds, vb))
  PH(23, post_phase(p, 3))
}

extern "C" void kernel_launch(void* const* d_in, const int* in_sizes, int n_in, void* d_out, int out_size, void* d_ws, size_t ws_size, hipStream_t stream) {
  Params p{};
  const float* const* in = (const float* const*)d_in;
  p.x = in[0]; p.c = in[1]; p.ctx = in[2]; p.c_ctx = in[3]; p.w_mod = in[4]; p.b_mod = in[5]; p.g_pre = in[6]; p.g_post = in[7];
  p.a_w_in = in[8]; p.a_w_g1 = in[9]; p.a_w_g2 = in[10]; p.a_b_g = in[11]; p.a_g_head = in[12]; p.a_w_out = in[13];
  p.b_w_in = in[14]; p.b_sink = in[15]; p.b_w_out = in[16];
  p.c_w_in = in[17]; p.c_conv_w = in[18]; p.c_conv_b = in[19]; p.c_w_ra = in[20]; p.c_b_ra = in[21]; p.c_w_ri = in[22]; p.c_b_ri = in[23]; p.c_lam = in[24]; p.c_w_out = in[25];
  p.out = (float*)d_out;
  p.ws = (char*)d_ws;
  if (WS_NEED > ws_size) { fprintf(stderr, "workspace too small: need %zu have %zu\n", (size_t)WS_NEED, ws_size); return; }

  hipMemsetAsync((char*)d_ws + O_BAR, 0, 16384, stream);
  hipFuncSetAttribute((const void*)mega, hipFuncAttributeMaxDynamicSharedMemorySize, LDS_BYTES);
  int dev = 0, cus = 0, per_cu = 0;
  hipGetDevice(&dev);
  hipDeviceGetAttribute(&cus, hipDeviceAttributeMultiprocessorCount, dev);
  hipOccupancyMaxActiveBlocksPerMultiprocessor(&per_cu, mega, NTHR, LDS_BYTES);
  if (per_cu < 1) per_cu = 1;
  if (per_cu > 1) per_cu = 1;
  int grid = cus * per_cu;
#if ONE_LAUNCH
  int lo = 0, hi = NPH;
  void* args[] = {&p, &lo, &hi};
  hipError_t e = hipLaunchCooperativeKernel((const void*)mega, dim3(grid), dim3(NTHR), args, LDS_BYTES, stream);
  if (e != hipSuccess) fprintf(stderr, "cooperative launch failed: %s (grid %d)\n", hipGetErrorString(e), grid);
#else
  for (int ph = 0; ph < NPH; ++ph) {
    hipLaunchKernelGGL(mega, dim3(grid), dim3(NTHR), LDS_BYTES, stream, p, ph, ph + 1);
  }
#endif
}
```
